# Optimizing an MI355X kernel written in HIP

```python
import jax, jax.numpy as jnp
from jax import lax
import numpy as np

D_MODEL = 4096
BATCH = 2
SEQ = 4096
DEPTH = 1
DEC_BATCH = 128
DEC_SEQ = 8
PAST_LEN = 8192
PAGE_SIZE = 128

WIDTH_A = D_MODEL // 2
HEAD_DIM = 64
N_HEADS_A = WIDTH_A // HEAD_DIM
N_KV = N_HEADS_A // 8
GROUP = N_HEADS_A // N_KV
WINDOW = 128
ATTN_BLOCK = 128
WIDTH_B = D_MODEL // 2
N_HEADS_B = 4
DV_B = WIDTH_B // N_HEADS_B
KEY_B = WIDTH_B // 2
DK_B = KEY_B // N_HEADS_B
GATE_RANK = 16
GLA_TAU = 16.0
GLA_CHUNK = 64
EPS = 1e-6
NEG_INF = -1e30
PROJ_SIZES = (WIDTH_A, N_KV * HEAD_DIM, N_KV * HEAD_DIM, WIDTH_A, KEY_B, KEY_B, WIDTH_B, WIDTH_B, GATE_RANK, D_MODEL, D_MODEL)
PROJ_DIM = sum(PROJ_SIZES)

kernel_name = "hybrid_swa_sink_gla_adaln_step"

F32 = jnp.float32


def rms_norm(x, g):
    xf = x.astype(F32)
    y = xf * lax.rsqrt(jnp.mean(xf * xf, axis=-1, keepdims=True) + EPS)
    return (y * g.astype(F32)).astype(x.dtype)


def split_columns(p):
    idx = np.cumsum(PROJ_SIZES)[:-1].tolist()
    return jnp.split(p, idx, axis=-1)


def mixer_input(x, c, w_ada, b_ada, norm_gain, w_in):
    mod = jax.nn.silu(c) @ w_ada + b_ada
    shift, scale, gate = jnp.split(mod, 3, axis=-1)
    h = rms_norm(x, norm_gain) * (1 + scale[:, None, :]) + shift[:, None, :]
    return split_columns(h @ w_in), gate


def branch_tensors(parts, w_alpha2, b_alpha):
    qa, ka, va, za, qb, kb, vb, zb, r, ga, gb = parts
    N, L = qa.shape[:2]
    qa = qa.reshape(N, L, N_KV, GROUP, HEAD_DIM)
    ka = ka.reshape(N, L, N_KV, HEAD_DIM)
    va = va.reshape(N, L, N_KV, HEAD_DIM)
    qb = qb.reshape(N, L, N_HEADS_B, DK_B)
    kb = kb.reshape(N, L, N_HEADS_B, DK_B)
    vb = vb.reshape(N, L, N_HEADS_B, DV_B)
    log_a = (jax.nn.log_sigmoid((r @ w_alpha2 + b_alpha).astype(F32)) / GLA_TAU).reshape(N, L, N_HEADS_B, DK_B)
    return qa, ka, va, za, qb, kb, vb, zb, log_a, ga, gb


def window_mask(qpos, kpos):
    d = qpos[..., :, None] - kpos[..., None, :]
    return (d >= 0) & (d <= WINDOW) & (kpos[..., None, :] >= 0)


def sink_softmax(scores, mask, sink):
    s = jnp.where(mask, scores, NEG_INF)
    sink_col = jnp.broadcast_to(sink.astype(F32).reshape(N_KV, GROUP, 1, 1), s.shape[:-1] + (1,))
    p = jax.nn.softmax(jnp.concatenate([s, sink_col], axis=-1), axis=-1)
    return p[..., :-1]


def swa_prompt(q, k, v, sink):
    B, L = q.shape[:2]
    nb = L // ATTN_BLOCK
    qb = q.reshape(B, nb, ATTN_BLOCK, N_KV, GROUP, HEAD_DIM)

    def band(t):
        tb = t.reshape(B, nb, ATTN_BLOCK, N_KV, HEAD_DIM)
        prev = jnp.concatenate([jnp.zeros_like(tb[:, :1]), tb[:, :-1]], axis=1)
        return jnp.concatenate([prev, tb], axis=2)

    kb, vb = band(k), band(v)
    start = jnp.arange(nb)[:, None] * ATTN_BLOCK
    qpos = start + jnp.arange(ATTN_BLOCK)
    kpos = start - ATTN_BLOCK + jnp.arange(2 * ATTN_BLOCK)
    mask = window_mask(qpos, kpos)[None, :, None, None]
    scores = jnp.einsum('bnqhgd,bnkhd->bnhgqk', qb, kb, preferred_element_type=F32) * (HEAD_DIM ** -0.5)
    p = sink_softmax(scores, mask, sink).astype(v.dtype)
    o = jnp.einsum('bnhgqk,bnkhd->bnqhgd', p, vb)
    w = min(WINDOW, L)
    return o.reshape(B, L, WIDTH_A), k[:, -w:], v[:, -w:]


def swa_sample(q, k, v, k_cache, v_cache, sink):
    N, T = q.shape[:2]
    w = k_cache.shape[1]
    k_all = jnp.concatenate([k_cache.astype(k.dtype), k], axis=1)
    v_all = jnp.concatenate([v_cache.astype(v.dtype), v], axis=1)
    qpos = PAST_LEN + jnp.arange(T)
    kpos = PAST_LEN - w + jnp.arange(w + T)
    mask = window_mask(qpos, kpos)
    scores = jnp.einsum('bqhgd,bkhd->bhgqk', q, k_all, preferred_element_type=F32) * (HEAD_DIM ** -0.5)
    p = sink_softmax(scores, mask, sink).astype(v.dtype)
    o = jnp.einsum('bhgqk,bkhd->bqhgd', p, v_all)
    return o.reshape(N, T, WIDTH_A), k_all[:, -w:], v_all[:, -w:]


def gla_recurrent(q, k, v, log_a, s0, chunk):
    N, L = q.shape[:2]
    n = L // chunk

    def blocks(t):
        return jnp.moveaxis(t.astype(F32).reshape((N, n, chunk) + t.shape[2:]), 1, 0)

    qc, kc, vc, ac = blocks(q), blocks(k), blocks(v), blocks(log_a)
    causal = jnp.tril(jnp.ones((chunk, chunk), dtype=bool))

    def step(S, inp):
        qn, kn, vn, an = inp
        b = jnp.cumsum(an, axis=1)
        b_last = b[:, -1]
        q_t = qn * jnp.exp(b) * (DK_B ** -0.5)
        k_t = kn * jnp.exp(-b)
        k_d = kn * jnp.exp(b_last[:, None] - b)
        att = jnp.where(causal, jnp.einsum('nthd,nshd->nhts', q_t, k_t), 0.0)
        o = jnp.einsum('nhts,nshv->nthv', att, vn) + jnp.einsum('nthd,nhdv->nthv', q_t, S)
        S = jnp.exp(b_last)[..., None] * S + jnp.einsum('nshd,nshv->nhdv', k_d, vn)
        return S, o

    S, o = lax.scan(step, s0.astype(F32), (qc, kc, vc, ac))
    o = jnp.moveaxis(o, 0, 1).reshape(N, L, N_HEADS_B, DV_B)
    return o, S


def mixer_output(x, gate, o_a, za, o_b, zb, ga, gb, gla_gain, w_pa, w_pb, w_o):
    N, L = x.shape[:2]
    u_a = (o_a * jax.nn.silu(za)) @ w_pa
    on = o_b * lax.rsqrt(jnp.mean(o_b * o_b, axis=-1, keepdims=True) + EPS) * gla_gain.astype(F32).reshape(N_HEADS_B, DV_B)
    u_b = (on.reshape(N, L, WIDTH_B).astype(x.dtype) * jax.nn.silu(zb)) @ w_pb
    merged = jax.nn.sigmoid(ga) * u_a + jax.nn.sigmoid(gb) * u_b
    return x + gate[:, None, :] * (merged @ w_o)


def setup_inputs(seed: int = 0) -> dict:
    key = jax.random.key(seed)
    ks = jax.random.split(key, 20)
    w_buf = min(WINDOW, PAST_LEN)
    nrm = jax.random.normal
    return {
        "x_prompt": nrm(ks[0], (BATCH, SEQ, D_MODEL), F32),
        "x_sample": nrm(ks[1], (DEC_BATCH, DEC_SEQ, D_MODEL), F32),
        "cache_k_win": nrm(ks[2], (DEPTH, DEC_BATCH, w_buf, N_KV, HEAD_DIM), F32),
        "cache_v_win": nrm(ks[3], (DEPTH, DEC_BATCH, w_buf, N_KV, HEAD_DIM), F32),
        "state_gla": nrm(ks[4], (DEPTH, DEC_BATCH, N_HEADS_B, DK_B, DV_B), F32),
        "c_prompt": nrm(ks[5], (BATCH, D_MODEL), F32),
        "c_sample": nrm(ks[6], (DEC_BATCH, D_MODEL), F32),
        "w_ada": nrm(ks[7], (DEPTH, D_MODEL, 3 * D_MODEL), F32) * (0.5 * D_MODEL ** -0.5),
        "b_ada": nrm(ks[8], (DEPTH, 3 * D_MODEL), F32) * 0.01,
        "norm_gain": 1.0 + 0.01 * nrm(ks[9], (DEPTH, D_MODEL), F32),
        "w_in": nrm(ks[10], (DEPTH, D_MODEL, PROJ_DIM), F32) * (D_MODEL ** -0.5),
        "attn_sink": nrm(ks[11], (DEPTH, N_HEADS_A), F32),
        "w_alpha2": nrm(ks[12], (DEPTH, GATE_RANK, KEY_B), F32) * (GATE_RANK ** -0.5),
        "b_alpha": nrm(ks[13], (DEPTH, KEY_B), F32) * 0.1,
        "gla_norm_gain": 1.0 + 0.01 * nrm(ks[14], (DEPTH, WIDTH_B), F32),
        "w_proj_a": nrm(ks[15], (DEPTH, WIDTH_A, D_MODEL), F32) * (WIDTH_A ** -0.5),
        "w_proj_b": nrm(ks[16], (DEPTH, WIDTH_B, D_MODEL), F32) * (WIDTH_B ** -0.5),
        "w_out": nrm(ks[17], (DEPTH, D_MODEL, D_MODEL), F32) * (D_MODEL ** -0.5),
        "final_norm_gain": 1.0 + 0.01 * nrm(ks[18], (D_MODEL,), F32),
    }


def reference(x_prompt, x_sample, cache_k_win, cache_v_win, state_gla, c_prompt, c_sample,
              w_ada, b_ada, norm_gain, w_in, attn_sink, w_alpha2, b_alpha, gla_norm_gain,
              w_proj_a, w_proj_b, w_out, final_norm_gain):
    xp, xs = x_prompt, x_sample
    kp_l, vp_l, sp_l, ks_l, vs_l, ss_l = [], [], [], [], [], []
    for l in range(DEPTH):
        parts, gate = mixer_input(xp, c_prompt, w_ada[l], b_ada[l], norm_gain[l], w_in[l])
        qa, ka, va, za, qb, kb, vb, zb, log_a, ga, gb = branch_tensors(parts, w_alpha2[l], b_alpha[l])
        o_a, k_win, v_win = swa_prompt(qa, ka, va, attn_sink[l])
        s0 = jnp.zeros((xp.shape[0], N_HEADS_B, DK_B, DV_B), F32)
        o_b, s_fin = gla_recurrent(qb, kb, vb, log_a, s0, GLA_CHUNK)
        xp = mixer_output(xp, gate, o_a, za, o_b, zb, ga, gb, gla_norm_gain[l], w_proj_a[l], w_proj_b[l], w_out[l])
        kp_l.append(k_win)
        vp_l.append(v_win)
        sp_l.append(s_fin.astype(x_prompt.dtype))
        parts, gate = mixer_input(xs, c_sample, w_ada[l], b_ada[l], norm_gain[l], w_in[l])
        qa, ka, va, za, qb, kb, vb, zb, log_a, ga, gb = branch_tensors(parts, w_alpha2[l], b_alpha[l])
        o_a, k_win, v_win = swa_sample(qa, ka, va, cache_k_win[l], cache_v_win[l], attn_sink[l])
        o_b, s_fin = gla_recurrent(qb, kb, vb, log_a, state_gla[l], xs.shape[1])
        xs = mixer_output(xs, gate, o_a, za, o_b, zb, ga, gb, gla_norm_gain[l], w_proj_a[l], w_proj_b[l], w_out[l])
        ks_l.append(k_win)
        vs_l.append(v_win)
        ss_l.append(s_fin.astype(state_gla.dtype))
    y_prompt = rms_norm(xp, final_norm_gain)
    y_sample = rms_norm(xs, final_norm_gain)
    k_win_prompt = jnp.stack(kp_l, axis=0)
    v_win_prompt = jnp.stack(vp_l, axis=0)
    gla_state_prompt = jnp.stack(sp_l, axis=0)
    k_win_sample = jnp.stack(ks_l, axis=0)
    v_win_sample = jnp.stack(vs_l, axis=0)
    gla_state_sample = jnp.stack(ss_l, axis=0)
    return (y_prompt, y_sample, k_win_prompt, v_win_prompt, gla_state_prompt, k_win_sample, v_win_sample, gla_state_sample)
```

```cpp
#include <hip/hip_runtime.h>
#include <cstdio>
#include <cstdint>

#ifndef MK_N_LAUNCHES
#define MK_N_LAUNCHES 10
#endif

#define GAS __attribute__((address_space(1)))
#define LAS __attribute__((address_space(3)))
typedef unsigned short bf16;
typedef unsigned v4u __attribute__((ext_vector_type(4)));
typedef unsigned v2u __attribute__((ext_vector_type(2)));
typedef float f32x2 __attribute__((ext_vector_type(2)));
typedef float f32x4 __attribute__((ext_vector_type(4)));
typedef float f32x16 __attribute__((ext_vector_type(16)));
typedef short bf16x8 __attribute__((ext_vector_type(8)));
typedef __bf16 bf16x2_t __attribute__((ext_vector_type(2)));
#define LDS_WAIT() asm volatile("s_waitcnt lgkmcnt(0)" ::: "memory")
#define VM_WAIT() asm volatile("s_waitcnt vmcnt(0)" ::: "memory")

__device__ __forceinline__ unsigned pk2(float lo, float hi) { f32x2 v = {lo, hi}; bf16x2_t b = __builtin_convertvector(v, bf16x2_t); return __builtin_bit_cast(unsigned, b); }
__device__ __forceinline__ bf16 f2bf(float f) { return (bf16)(pk2(f, 0.f) & 0xffffu); }
__device__ __forceinline__ float bf2f(bf16 b) { return __uint_as_float(((unsigned)b) << 16); }
__device__ __forceinline__ float bflo(unsigned w) { return __uint_as_float(w << 16); }
__device__ __forceinline__ float bfhi(unsigned w) { return __uint_as_float(w & 0xffff0000u); }
__device__ __forceinline__ float wave_sum(float v) {
#pragma unroll
    for (int o = 1; o < 64; o <<= 1) v += __shfl_xor(v, o);
    return v;
}
__device__ __forceinline__ float sigmoidf_(float x) { return 1.0f / (1.0f + __expf(-x)); }

#define XB_TMO      128
#define XB_XCNT(j)  (256  + 64 * (j))
#define XB_XSUB(j)  (1280 + 64 * (j))
#define XB_XGEN(j)  (2304 + 64 * (j))
#define XB_TOP      3328
#define XB_TOPGEN   3392
#define XCD_BAR_WORDS 3456
#define XB_SPIN_CAP (1u << 18)

__device__ __forceinline__ unsigned xb_ld(unsigned* p)              { return __hip_atomic_load(p, __ATOMIC_RELAXED, __HIP_MEMORY_SCOPE_AGENT); }
__device__ __forceinline__ unsigned xb_add(unsigned* p, unsigned v) { return __hip_atomic_fetch_add(p, v, __ATOMIC_RELAXED, __HIP_MEMORY_SCOPE_AGENT); }
__device__ __forceinline__ unsigned xb_xcc_id() { return (unsigned)__builtin_amdgcn_s_getreg((3 << 11) | 20) & 0xFu; }
#define XB_SPIN(cond, bar) do { unsigned _sp = 0; while (cond) { __builtin_amdgcn_s_sleep(1); \
    if ((++_sp & 255u) == 0u) { if (xb_ld(&(bar)[XB_TMO])) break; if (_sp > XB_SPIN_CAP) { atomicAdd(&(bar)[XB_TMO], 1u); break; } } } } while (0)

struct XcdBarrier { unsigned* bar; unsigned x; volatile LAS unsigned* st; };

__device__ __forceinline__ XcdBarrier xcd_barrier_post(unsigned* bar, volatile LAS unsigned* st) {
    XcdBarrier b; b.bar = bar; b.x = xb_xcc_id(); b.st = st;
    if (threadIdx.x == 0) (void)xb_add(&bar[XB_XCNT(b.x)], 1u);
    return b;
}
__device__ __forceinline__ void xcd_barrier_complete(unsigned* bar, unsigned x, unsigned& nloc, unsigned& nx) {
    const unsigned G = gridDim.x * gridDim.y * gridDim.z;
    unsigned sum, cnt, mine, sp = 0u;
    for (;;) {
        sum = 0u; cnt = 0u; mine = 0u;
#pragma unroll
        for (unsigned j = 0; j < 16; ++j) { const unsigned c = xb_ld(&bar[XB_XCNT(j)]); sum += c; cnt += (c > 0u) ? 1u : 0u; mine = (j == x) ? c : mine; }
        if (sum == G) break;
        __builtin_amdgcn_s_sleep(1);
        if ((++sp & 255u) == 0u) { if (xb_ld(&bar[XB_TMO])) break; if (sp > XB_SPIN_CAP) { atomicAdd(&bar[XB_TMO], 1u); break; } }
    }
    nloc = mine > 0u ? mine : 1u; nx = cnt > 0u ? cnt : 1u;
}
__device__ __forceinline__ void xcd_barrier(const XcdBarrier& b) {
    asm volatile("s_waitcnt vmcnt(0)" ::: "memory");
    __syncthreads();
    if (threadIdx.x == 0) {
        unsigned* bar = b.bar;
        __builtin_amdgcn_s_waitcnt(0);
        unsigned nloc = b.st[0], nx = b.st[1];
        if (nloc == 0u) { xcd_barrier_complete(bar, b.x, nloc, nx); b.st[0] = nloc; b.st[1] = nx; }
        const unsigned old = xb_add(&bar[XB_XSUB(b.x)], 1u);
        const unsigned gen = old / nloc;
        if (old + 1u == (gen + 1u) * nloc) {
            __builtin_amdgcn_fence(__ATOMIC_RELEASE, "agent");
            asm volatile("s_waitcnt vmcnt(0)" ::: "memory");
            const unsigned og = xb_add(&bar[XB_TOP], 1u);
            const unsigned tg = og / nx;
            if (og + 1u == (tg + 1u) * nx) xb_add(&bar[XB_TOPGEN], 1u);
            else XB_SPIN(xb_ld(&bar[XB_TOPGEN]) == tg, bar);
            __builtin_amdgcn_fence(__ATOMIC_ACQUIRE, "agent");
            xb_add(&bar[XB_XGEN(b.x)], 1u);
            asm volatile("s_waitcnt vmcnt(0)" ::: "memory");
        } else {
            XB_SPIN(xb_ld(&bar[XB_XGEN(b.x)]) == gen, bar);
            __builtin_amdgcn_fence(__ATOMIC_ACQUIRE, "agent");
            asm volatile("s_waitcnt vmcnt(0)" ::: "memory");
        }
    }
    __syncthreads();
}

constexpr int DM = 4096;
constexpr int NPR = 8192, NSR = 1024, NROW = NPR + NSR;
constexpr int SEQ = 4096, NSEQ_S = 128, TS = 8;
constexpr int N1 = 19200, NT1 = 75;
constexpr int PROJ = 18960;
constexpr int NMOD = 130;
constexpr float EPS = 1e-6f;

constexpr size_t MiB = 1u << 20;
constexpr size_t WS_CTL = 0, CTL_ZERO_BYTES = 1 * MiB;
constexpr size_t WS_WB1 = 1 * MiB;
constexpr size_t WS_WB2 = WS_WB1 + (size_t)N1 * DM * 2;
constexpr size_t WS_WB3 = WS_WB2 + (size_t)DM * DM * 2;
constexpr size_t WS_CS  = WS_WB3 + (size_t)DM * DM * 2;
constexpr size_t WS_MOD = WS_CS + (size_t)160 * DM * 2;
constexpr size_t WS_H   = WS_MOD + (size_t)132 * 12288 * 4;
constexpr size_t WS_QA  = WS_H + (size_t)NROW * DM * 2;
constexpr size_t WS_KA  = WS_QA + (size_t)NROW * 2048 * 2;
constexpr size_t WS_VA  = WS_KA + (size_t)NROW * 256 * 2;
constexpr size_t WS_ZA  = WS_VA + (size_t)NROW * 256 * 2;
constexpr size_t WS_QB  = WS_ZA + (size_t)NROW * 2048 * 2;
constexpr size_t WS_KB  = WS_QB + (size_t)NROW * 1024 * 2;
constexpr size_t WS_VB  = WS_KB + (size_t)NROW * 1024 * 2;
constexpr size_t WS_ZB  = WS_VB + (size_t)NROW * 2048 * 2;
constexpr size_t WS_SGA = WS_ZB + (size_t)NROW * 2048 * 2;
constexpr size_t WS_SGB = WS_SGA + (size_t)NROW * DM * 2;
constexpr size_t WS_R   = WS_SGB + (size_t)NROW * DM * 2;
constexpr size_t WS_QT  = WS_R + (size_t)NROW * 16 * 4;
constexpr size_t WS_KDT = WS_QT + (size_t)512 * 64 * 256 * 2;
constexpr size_t WS_ATT = WS_KDT + (size_t)512 * 64 * 256 * 2;
constexpr size_t WS_VT  = WS_ATT + (size_t)512 * 64 * 64 * 2;
constexpr size_t WS_DEC = WS_VT + (size_t)512 * 512 * 64 * 2;
constexpr size_t WS_OB  = WS_DEC + (size_t)512 * 256 * 4;
constexpr size_t WS_AB  = WS_OB + (size_t)NPR * 2048 * 4;
constexpr size_t WS_SSQ = WS_AB + (size_t)NROW * DM * 2;
constexpr size_t WS_END = WS_SSQ + (size_t)NROW * 64 * 4;
constexpr size_t WS_MERGED = WS_H;
constexpr int CW_BAR = 4096;

constexpr size_t OUT_Y = 0;
constexpr size_t OUT_KWP = (size_t)NROW * DM;
constexpr size_t OUT_VWP = OUT_KWP + 65536;
constexpr size_t OUT_GSP = OUT_VWP + 65536;
constexpr size_t OUT_KWS = OUT_GSP + 1048576;
constexpr size_t OUT_VWS = OUT_KWS + 4194304;
constexpr size_t OUT_GSS = OUT_VWS + 4194304;
constexpr size_t OUT_TOTAL = OUT_GSS + 67108864;

constexpr int RING_BYTES = 131072;
constexpr int MISC_OFF = RING_BYTES + 320;
constexpr int LDS_BYTES = 147456;
constexpr int NWAVES = 8;

namespace pg8 {
constexpr int BM = 256, BK = 64, HALF = 128, HTB = HALF * BK * 2, STAGE_BYTES = 8 * HTB, NXCD = 8, WGM = 8;
__host__ __device__ __forceinline__ int lds_byte(int r, int c) { const int st = (r >> 4) * 2 + (c >> 5), rr = r & 15, cc = c & 31, ob = rr * 64 + cc * 2; return st * 1024 + (ob ^ (((ob >> 9) & 1) << 5)); }
__host__ __device__ __forceinline__ void stage_rc(int b, int& R, int& C) { const int st = b / 1024, sb = b % 1024, swz = sb ^ (((sb >> 9) & 1) << 5); R = (st >> 1) * 16 + swz / 64; C = (st & 1) * 32 + (swz % 64) / 2; }
__host__ __device__ __forceinline__ int perm32(int rho) { const int n = rho >> 4, i = rho & 15; return 8 * (i >> 2) + 4 * n + (i & 3); }

struct Unit { int pm, pn; };
struct Gemm { const bf16* A; const bf16* Bt; int M, N, K; };

struct StaticOrder {
    int nM, nN, nwg, G, c;
    __host__ __device__ void init(int M, int N, int G_, int c_) { nM = M / BM; nN = N / BM; nwg = nM * nN; G = G_; c = c_; }
    __host__ __device__ bool next(int i, Unit& u) const {
        const long L = (long)i * G + c; if (L >= nwg) return false;
        int wgid = (int)L; { const int q = nwg / NXCD, r = nwg % NXCD, xcd = wgid % NXCD, off = wgid / NXCD; wgid = (xcd < r ? xcd * (q + 1) : r * (q + 1) + (xcd - r) * q) + off; }
        const int nig = WGM * nN, gid = wgid / nig, fm = gid * WGM, gsz = (nM - fm) < WGM ? (nM - fm) : WGM;
        u.pm = fm + ((wgid % nig) % gsz); u.pn = (wgid % nig) / gsz; return true;
    }
};

template <class Epi>
__device__ __forceinline__ void gemm_phase(LAS unsigned char* lds, const Gemm g, const StaticOrder& S, const Epi& E) {
    const int tid = threadIdx.x, wid = __builtin_amdgcn_readfirstlane(tid >> 6), lane = tid & 63, wr = wid >> 2, wc = wid & 3, fr = lane & 15, fq = lane >> 4;
    const int K = g.K, nt = K / BK;
    unsigned voffA[2], voffB[2];
#pragma unroll
    for (int i = 0; i < 2; ++i) { int R, C; stage_rc(tid * 16 + i * 8192, R, C); const int Rb = Epi::PERM ? ((R & ~31) + perm32(R & 31)) : R;
        voffA[i] = (unsigned)(R * K + C) * 2u; voffB[i] = (unsigned)(Rb * K + C) * 2u; }
    const size_t kstep = (size_t)(BK * 2);
    const size_t hstep = (size_t)HALF * K * 2;
    const size_t tstep = 2 * hstep;
    const unsigned ldsw = (unsigned)wid * 1024u;
    const int aoff = lds_byte(wr * 64 + fr, fq * 8), boff = lds_byte(wc * 32 + fr, fq * 8);
#define PG8_SA(b, h) (((b) * 2 + (h)) * HTB)
#define PG8_SB(b, h) ((4 + (b) * 2 + (h)) * HTB)
#define PG8_STAGE(bufoff, gbase, voff) do { _Pragma("unroll") for (int _i = 0; _i < 2; ++_i) \
        __builtin_amdgcn_global_load_lds((const unsigned*)((const char*)(gbase) + (voff)[_i]), (LAS unsigned*)(lds + (bufoff) + ldsw + _i * 8192), 16, 0, 0); } while (0)
#define PG8_LDA(dst, b, h) do { _Pragma("unroll") for (int m = 0; m < 4; ++m) _Pragma("unroll") for (int k = 0; k < 2; ++k) dst[m][k] = *(const LAS bf16x8*)(lds + PG8_SA(b, h) + aoff + m * 2048 + k * 1024); } while (0)
#define PG8_LDB(dst, b, h) do { _Pragma("unroll") for (int n = 0; n < 2; ++n) _Pragma("unroll") for (int k = 0; k < 2; ++k) dst[n][k] = *(const LAS bf16x8*)(lds + PG8_SB(b, h) + boff + n * 2048 + k * 1024); } while (0)
#define PG8_MMA(ai, bj, At, Bt) do { __builtin_amdgcn_s_setprio(1); _Pragma("unroll") for (int m = 0; m < 4; ++m) _Pragma("unroll") for (int n = 0; n < 2; ++n) _Pragma("unroll") for (int k = 0; k < 2; ++k) \
        acc[ai][bj][m][n] = __builtin_amdgcn_mfma_f32_16x16x32_bf16(Bt[n][k], At[m][k], acc[ai][bj][m][n], 0, 0, 0); __builtin_amdgcn_s_setprio(0); } while (0)
#define PG8_WAIT_V(n) asm volatile("s_waitcnt vmcnt(" #n ")" ::: "memory")
#define PG8_WAIT_L(n) asm volatile("s_waitcnt lgkmcnt(" #n ")" ::: "memory")
#define PG8_BAR __builtin_amdgcn_s_barrier()
#define PG8_SCHED __builtin_amdgcn_sched_barrier(0)
    Unit cur, nxt; int ui = 0;
    if (!S.next(0, cur)) return;
    f32x4 acc[2][2][4][2];
#pragma unroll
    for (int a = 0; a < 2; ++a)
#pragma unroll
        for (int b = 0; b < 2; ++b)
#pragma unroll
            for (int m = 0; m < 4; ++m)
#pragma unroll
                for (int n = 0; n < 2; ++n) acc[a][b][m][n] = (f32x4){0.f, 0.f, 0.f, 0.f};
    bf16x8 At[4][2], B0[2][2], B1[2][2];
    const char* cA = (const char*)g.A + (size_t)cur.pm * tstep; const char* cB = (const char*)g.Bt + (size_t)cur.pn * tstep;
    PG8_STAGE(PG8_SB(0, 0), cB, voffB); PG8_STAGE(PG8_SB(0, 1), cB + hstep, voffB); PG8_STAGE(PG8_SA(0, 0), cA, voffA); PG8_STAGE(PG8_SA(0, 1), cA + hstep, voffA);
    if (wr == 1) PG8_BAR;
    PG8_WAIT_V(2); PG8_BAR;
    PG8_STAGE(PG8_SB(1, 0), cB + kstep, voffB); PG8_STAGE(PG8_SA(1, 0), cA + kstep, voffA); PG8_STAGE(PG8_SB(1, 1), cB + hstep + kstep, voffB);
    PG8_WAIT_V(6); PG8_BAR;
    for (;;) {
        const bool has_next = S.next(ui + 1, nxt);
        const char* nA = has_next ? (const char*)g.A + (size_t)nxt.pm * tstep : cA; const char* nB = has_next ? (const char*)g.Bt + (size_t)nxt.pn * tstep : cB;
        for (int t = 0; t < nt; t += 2) {
            const bool last = (t == nt - 2);
            const char* a1 = cA + (size_t)(t + 1) * kstep;
            const char* a2 = last ? nA : cA + (size_t)(t + 2) * kstep; const char* b2 = last ? nB : cB + (size_t)(t + 2) * kstep;
            const char* a3 = a2 + kstep; const char* b3 = b2 + kstep;
            if constexpr (Epi::HAS_MID) { if (t == nt / 2) E.mid(acc, cur, wr, wc, fr, fq); }
            PG8_LDB(B0, 0, 0); PG8_LDB(B1, 0, 1); PG8_SCHED; PG8_LDA(At, 0, 0); PG8_STAGE(PG8_SA(1, 1), a1 + hstep, voffA);
            PG8_WAIT_V(8); PG8_WAIT_L(0); PG8_BAR; PG8_MMA(0, 0, At, B0); PG8_MMA(0, 1, At, B1); PG8_BAR; PG8_SCHED;
            PG8_LDA(At, 0, 1); PG8_STAGE(PG8_SB(0, 0), b2, voffB); PG8_STAGE(PG8_SB(0, 1), b2 + hstep, voffB); PG8_STAGE(PG8_SA(0, 0), a2, voffA);
            PG8_WAIT_V(8); PG8_WAIT_L(0); PG8_BAR; PG8_MMA(1, 0, At, B0); PG8_MMA(1, 1, At, B1); PG8_BAR; PG8_SCHED;
            PG8_LDB(B0, 1, 0); PG8_LDB(B1, 1, 1); PG8_SCHED; PG8_LDA(At, 1, 0); PG8_STAGE(PG8_SA(0, 1), a2 + hstep, voffA);
            PG8_WAIT_V(8); PG8_WAIT_L(0); PG8_BAR; PG8_MMA(0, 0, At, B0); PG8_MMA(0, 1, At, B1); PG8_BAR; PG8_SCHED;
            PG8_LDA(At, 1, 1); PG8_STAGE(PG8_SB(1, 0), b3, voffB); PG8_STAGE(PG8_SB(1, 1), b3 + hstep, voffB); PG8_STAGE(PG8_SA(1, 0), a3, voffA);
            PG8_WAIT_V(8); PG8_WAIT_L(0); PG8_BAR; PG8_MMA(1, 0, At, B0); PG8_MMA(1, 1, At, B1); PG8_BAR; PG8_SCHED;
        }
        if (wr == 0) PG8_BAR;
        E(acc, cur, wr, wc, fr, fq);
        if (!has_next) break;
#pragma unroll
        for (int a = 0; a < 2; ++a)
#pragma unroll
            for (int b = 0; b < 2; ++b)
#pragma unroll
                for (int m = 0; m < 4; ++m)
#pragma unroll
                    for (int n = 0; n < 2; ++n) acc[a][b][m][n] = (f32x4){0.f, 0.f, 0.f, 0.f};
        cur = nxt; cA = nA; cB = nB; ++ui;
        if (wr == 1) PG8_BAR;
    }
    PG8_WAIT_V(0);
    PG8_BAR;
#undef PG8_SA
#undef PG8_SB
#undef PG8_STAGE
#undef PG8_LDA
#undef PG8_LDB
#undef PG8_MMA
#undef PG8_WAIT_V
#undef PG8_WAIT_L
#undef PG8_BAR
#undef PG8_SCHED
}
}

struct EpiProj {
    static constexpr bool PERM = true, HAS_MID = false;
    unsigned char* ws;
    __device__ __forceinline__ void operator()(const f32x4 (&acc)[2][2][4][2], const pg8::Unit& u, int wr, int wc, int fr, int fq) const {
        const int pn = u.pn;
        const int row0 = u.pm * 256 + wr * 64 + fr;
        if (pn == 74) {
            if (wc == 0 && fq < 2) {
                float* R = (float*)(ws + WS_R);
#pragma unroll
                for (int ai = 0; ai < 2; ++ai)
#pragma unroll
                    for (int m = 0; m < 4; ++m) { float* rp = R + (size_t)(row0 + ai * 128 + m * 16) * 16 + 8 * fq;
                        *(f32x4*)(rp) = acc[ai][0][m][0]; *(f32x4*)(rp + 4) = acc[ai][0][m][1]; }
            }
            return;
        }
        size_t boff; int ldc, ct, act;
        if (pn < 8)       { boff = WS_QA;  ldc = 2048; ct = pn;      act = 0; }
        else if (pn == 8) { boff = WS_KA;  ldc = 256;  ct = 0;       act = 0; }
        else if (pn == 9) { boff = WS_VA;  ldc = 256;  ct = 0;       act = 0; }
        else if (pn < 18) { boff = WS_ZA;  ldc = 2048; ct = pn - 10; act = 1; }
        else if (pn < 22) { boff = WS_QB;  ldc = 1024; ct = pn - 18; act = 0; }
        else if (pn < 26) { boff = WS_KB;  ldc = 1024; ct = pn - 22; act = 0; }
        else if (pn < 34) { boff = WS_VB;  ldc = 2048; ct = pn - 26; act = 0; }
        else if (pn < 42) { boff = WS_ZB;  ldc = 2048; ct = pn - 34; act = 1; }
        else if (pn < 58) { boff = WS_SGA; ldc = 4096; ct = pn - 42; act = 2; }
        else              { boff = WS_SGB; ldc = 4096; ct = pn - 58; act = 2; }
        bf16* base = (bf16*)(ws + boff);
        const int col0 = ct * 256 + wc * 32 + 8 * fq;
#pragma unroll
        for (int ai = 0; ai < 2; ++ai)
#pragma unroll
            for (int m = 0; m < 4; ++m) { bf16* rowp = base + (size_t)(row0 + ai * 128 + m * 16) * ldc + col0;
#pragma unroll
                for (int bj = 0; bj < 2; ++bj) { f32x4 v0 = acc[ai][bj][m][0], v1 = acc[ai][bj][m][1];
                    if (act != 0) {
#pragma unroll
                        for (int j = 0; j < 4; ++j) { const float s0 = sigmoidf_(v0[j]), s1 = sigmoidf_(v1[j]); v0[j] = (act == 1) ? v0[j] * s0 : s0; v1[j] = (act == 1) ? v1[j] * s1 : s1; }
                    }
                    v4u w; w.x = pk2(v0[0], v0[1]); w.y = pk2(v0[2], v0[3]); w.z = pk2(v1[0], v1[1]); w.w = pk2(v1[2], v1[3]);
                    *(v4u*)(rowp + bj * 128) = w; } }
    }
};
struct EpiMerge {
    static constexpr bool PERM = true, HAS_MID = true;
    const bf16* sga; const bf16* sgb; bf16* out;
    __device__ __forceinline__ void mid(f32x4 (&acc)[2][2][4][2], const pg8::Unit& u, int wr, int wc, int fr, int fq) const {
        int row0 = u.pm * 256 + wr * 64 + fr, col0 = u.pn * 256 + wc * 32 + 8 * fq;
        asm volatile("" : "+v"(row0), "+v"(col0));
#pragma unroll
        for (int ai = 0; ai < 2; ++ai)
#pragma unroll
            for (int m = 0; m < 4; ++m) { const size_t off = (size_t)(row0 + ai * 128 + m * 16) * DM + col0;
#pragma unroll
                for (int bj = 0; bj < 2; ++bj) { const v4u a = *(const v4u*)(sga + off + bj * 128), b = *(const v4u*)(sgb + off + bj * 128);
                    f32x4 r0, r1;
                    r0[0] = bflo(a.x) * __builtin_amdgcn_rcpf(bflo(b.x)); r0[1] = bfhi(a.x) * __builtin_amdgcn_rcpf(bfhi(b.x));
                    r0[2] = bflo(a.y) * __builtin_amdgcn_rcpf(bflo(b.y)); r0[3] = bfhi(a.y) * __builtin_amdgcn_rcpf(bfhi(b.y));
                    r1[0] = bflo(a.z) * __builtin_amdgcn_rcpf(bflo(b.z)); r1[1] = bfhi(a.z) * __builtin_amdgcn_rcpf(bfhi(b.z));
                    r1[2] = bflo(a.w) * __builtin_amdgcn_rcpf(bflo(b.w)); r1[3] = bfhi(a.w) * __builtin_amdgcn_rcpf(bfhi(b.w));
                    acc[ai][bj][m][0] *= r0; acc[ai][bj][m][1] *= r1;
                    asm volatile("" ::: "memory"); } }
    }
    __device__ __forceinline__ void operator()(const f32x4 (&acc)[2][2][4][2], const pg8::Unit& u, int wr, int wc, int fr, int fq) const {
        const int row0 = u.pm * 256 + wr * 64 + fr, col0 = u.pn * 256 + wc * 32 + 8 * fq;
#pragma unroll
        for (int ai = 0; ai < 2; ++ai)
#pragma unroll
            for (int m = 0; m < 4; ++m) { const size_t off = (size_t)(row0 + ai * 128 + m * 16) * DM + col0;
#pragma unroll
                for (int bj = 0; bj < 2; ++bj) { const v4u b = *(const v4u*)(sgb + off + bj * 128);
                    const f32x4 v0 = acc[ai][bj][m][0], v1 = acc[ai][bj][m][1];
                    v4u w; w.x = pk2(v0[0] * bflo(b.x), v0[1] * bfhi(b.x)); w.y = pk2(v0[2] * bflo(b.y), v0[3] * bfhi(b.y));
                    w.z = pk2(v1[0] * bflo(b.z), v1[1] * bfhi(b.z)); w.w = pk2(v1[2] * bflo(b.w), v1[3] * bfhi(b.w));
                    *(v4u*)(out + off + bj * 128) = w; } }
    }
};
struct EpiOut {
    static constexpr bool PERM = false, HAS_MID = false;
    const float* xp; const float* xs; const float* mod; float* y; float* ssq;
    __device__ __forceinline__ void operator()(const f32x4 (&acc)[2][2][4][2], const pg8::Unit& u, int wr, int wc, int fr, int fq) const {
        const int col0 = u.pn * 256 + wc * 32 + 4 * fq;
#pragma unroll
        for (int ai = 0; ai < 2; ++ai)
#pragma unroll
            for (int m = 0; m < 4; ++m) { const int row = u.pm * 256 + ai * 128 + wr * 64 + m * 16 + fr;
                const float* xr = (row < NPR) ? xp + (size_t)row * DM : xs + (size_t)(row - NPR) * DM;
                const int seq = (row < NPR) ? (row >> 12) : 2 + ((row - NPR) >> 3);
                const float* gp = mod + (size_t)seq * 12288 + 8192;
                float s = 0.f;
#pragma unroll
                for (int bj = 0; bj < 2; ++bj)
#pragma unroll
                    for (int n = 0; n < 2; ++n) { const int c = col0 + bj * 128 + n * 16;
                        const f32x4 xv = *(const f32x4*)(xr + c), gv = *(const f32x4*)(gp + c);
                        const f32x4 o = xv + gv * acc[ai][bj][m][n];
                        *(f32x4*)(y + (size_t)row * DM + c) = o;
                        s += (o[0] * o[0] + o[1] * o[1]) + (o[2] * o[2] + o[3] * o[3]); }
                s += __shfl_xor(s, 16); s += __shfl_xor(s, 32);
                if (fq == 0) ssq[(size_t)row * 64 + u.pn * 4 + wc] = s;
            }
    }
};

struct Args { const float* in[19]; float* out; unsigned char* ws; int ph_lo, ph_hi; };
#define FIN(k) (A.in[k])
struct Frame {
    LAS unsigned char* lds;
    int tid, lane, wave, blk, G;
    float* out; unsigned char* ws;
};

__device__ __forceinline__ void p0_transpose_item(const float* W, int ldw, int k0, int n_src0, bf16* WT, int ldt, int drow0, int koff, LAS float* scr, int lane) {
#pragma unroll 8
    for (int i = 0; i < 32; ++i) { const int kk = 2 * i + (lane >> 5); scr[kk * 33 + (lane & 31)] = W[(size_t)(k0 + kk) * ldw + n_src0 + (lane & 31)]; }
    LDS_WAIT(); asm volatile("" ::: "memory");
    const int c = lane & 7;
#pragma unroll
    for (int j = 0; j < 4; ++j) { const int n = (lane >> 3) + 8 * j; const LAS float* s = scr + (8 * c) * 33 + n;
        v4u o; o.x = pk2(s[0 * 33], s[1 * 33]); o.y = pk2(s[2 * 33], s[3 * 33]); o.z = pk2(s[4 * 33], s[5 * 33]); o.w = pk2(s[6 * 33], s[7 * 33]);
        *(v4u*)(WT + (size_t)(drow0 + n) * ldt + koff + k0 + 8 * c) = o; }
    LDS_WAIT(); asm volatile("" ::: "memory");
}
__device__ __forceinline__ void phase0(Frame& F, const Args& A) {
    LAS float* scr = (LAS float*)(F.lds + F.wave * 16384);
    const int gw = F.blk * NWAVES + F.wave, NGW = F.G * NWAVES;
    const float* w_in = FIN(10); const float* w_pa = FIN(15); const float* w_pb = FIN(16); const float* w_out = FIN(17);
    bf16* WB1 = (bf16*)(F.ws + WS_WB1); bf16* WB2 = (bf16*)(F.ws + WS_WB2); bf16* WB3 = (bf16*)(F.ws + WS_WB3);
    constexpr int I1 = 64 * 336, I2 = 64 * 256, IA = 32 * 128, IB = 32 * 128, IO = 64 * 128;
    constexpr int NITEMS = I1 + I2 + IA + IB + IO;
    for (int it = gw; it < NITEMS; it += NGW) {
        int r = it;
        if (r < I1) { const int kb = r / 336, nb = r % 336; p0_transpose_item(w_in, PROJ, 64 * kb, 32 * nb, WB1, DM, 32 * nb, 0, scr, F.lane); continue; } r -= I1;
        if (r < I2) { const int kb = r / 256, nb = r % 256; p0_transpose_item(w_in, PROJ, 64 * kb, 10768 + 32 * nb, WB1, DM, 10752 + 32 * nb, 0, scr, F.lane); continue; } r -= I2;
        if (r < IA) { const int kb = r / 128, nb = r % 128; p0_transpose_item(w_pa, DM, 64 * kb, 32 * nb, WB2, DM, 32 * nb, 0, scr, F.lane); continue; } r -= IA;
        if (r < IB) { const int kb = r / 128, nb = r % 128; p0_transpose_item(w_pb, DM, 64 * kb, 32 * nb, WB2, DM, 32 * nb, 2048, scr, F.lane); continue; } r -= IB;
        { const int kb = r / 128, nb = r % 128; p0_transpose_item(w_out, DM, 64 * kb, 32 * nb, WB3, DM, 32 * nb, 0, scr, F.lane); }
    }
    const size_t gt = (size_t)F.blk * 512 + F.tid, NT = (size_t)F.G * 512;
    for (size_t i = gt; i < (size_t)16 * DM; i += NT) { const int k = (int)(i >> 4), j = (int)(i & 15); WB1[(size_t)(18944 + j) * DM + k] = f2bf(w_in[(size_t)k * PROJ + 10752 + j]); }
    { v4u* z = (v4u*)(WB1 + (size_t)18960 * DM); const v4u zero = {0u, 0u, 0u, 0u}; for (size_t i = gt; i < (size_t)240 * DM * 2 / 16; i += NT) z[i] = zero; }
    { bf16* CS = (bf16*)(F.ws + WS_CS); const float* cp = FIN(5); const float* cs = FIN(6);
      for (size_t i = gt; i < (size_t)160 * DM / 4; i += NT) { const int row = (int)(i >> 10), c4 = (int)(i & 1023) * 4;
          f32x4 v = {0.f, 0.f, 0.f, 0.f};
          if (row < 2) v = *(const f32x4*)(cp + (size_t)row * DM + c4); else if (row < NMOD) v = *(const f32x4*)(cs + (size_t)(row - 2) * DM + c4);
          v2u o; o.x = pk2(v[0] * sigmoidf_(v[0]), v[1] * sigmoidf_(v[1])); o.y = pk2(v[2] * sigmoidf_(v[2]), v[3] * sigmoidf_(v[3]));
          *(v2u*)(CS + (size_t)row * DM + c4) = o; } }
}

__device__ __forceinline__ void phase1(Frame& F, const Args& A) {
    if (F.blk >= 192) return;
    const float* w_ada = FIN(7); const float* b_ada = FIN(8);
    const bf16* CS = (const bf16*)(F.ws + WS_CS); float* MOD = (float*)(F.ws + WS_MOD);
    const int nt2 = F.wave & 1, kq = F.wave >> 1, j = F.lane & 31, hh = F.lane >> 5;
    const int n0 = F.blk * 64 + nt2 * 32;
    f32x16 acc[5];
#pragma unroll
    for (int mt = 0; mt < 5; ++mt)
#pragma unroll
        for (int r = 0; r < 16; ++r) acc[mt][r] = 0.f;
    const float* wp = w_ada + (size_t)(kq * 1024 + 8 * hh) * 12288 + n0 + j;
    const bf16* ap = CS + (size_t)j * DM + kq * 1024 + 8 * hh;
#pragma unroll 2
    for (int ks = 0; ks < 64; ++ks) {
        float b[8];
#pragma unroll
        for (int jj = 0; jj < 8; ++jj) b[jj] = wp[(size_t)(ks * 16 + jj) * 12288];
        v4u bw; bw.x = pk2(b[0], b[1]); bw.y = pk2(b[2], b[3]); bw.z = pk2(b[4], b[5]); bw.w = pk2(b[6], b[7]);
        const bf16x8 bf = __builtin_bit_cast(bf16x8, bw);
#pragma unroll
        for (int mt = 0; mt < 5; ++mt) { const bf16x8 af = *(const bf16x8*)(ap + (size_t)mt * 32 * DM + ks * 16);
            acc[mt] = __builtin_amdgcn_mfma_f32_32x32x16_bf16(af, bf, acc[mt], 0, 0, 0); }
    }
    LAS float* red = (LAS float*)F.lds;
    if (kq > 0) {
#pragma unroll
        for (int mt = 0; mt < 5; ++mt)
#pragma unroll
            for (int r = 0; r < 16; ++r) red[((((kq - 1) * 2 + nt2) * 5 + mt) * 16 + r) * 64 + F.lane] = acc[mt][r];
    }
    __syncthreads();
    if (kq == 0) {
        const float bias = b_ada[n0 + j];
#pragma unroll
        for (int mt = 0; mt < 5; ++mt)
#pragma unroll
            for (int r = 0; r < 16; ++r) {
                float v = acc[mt][r];
#pragma unroll
                for (int q = 0; q < 3; ++q) v += red[(((q * 2 + nt2) * 5 + mt) * 16 + r) * 64 + F.lane];
                const int row = 32 * mt + (r & 3) + 8 * (r >> 2) + 4 * hh;
                if (row < NMOD) MOD[(size_t)row * 12288 + n0 + j] = v + bias;
            }
    }
    __syncthreads();
}

__device__ __forceinline__ void phase2(Frame& F, const Args& A) {
    const float* xp = FIN(0); const float* xs = FIN(1); const float* ng = FIN(9);
    const float* MOD = (const float*)(F.ws + WS_MOD); bf16* H = (bf16*)(F.ws + WS_H);
    const int gw = F.blk * NWAVES + F.wave, NGW = F.G * NWAVES;
    for (int row = gw; row < NROW; row += NGW) {
        const float* xr = (row < NPR) ? xp + (size_t)row * DM : xs + (size_t)(row - NPR) * DM;
        const int seq = (row < NPR) ? (row >> 12) : 2 + ((row - NPR) >> 3);
        const float* sh = MOD + (size_t)seq * 12288; const float* sc = sh + 4096;
        f32x4 v[16]; float s = 0.f;
#pragma unroll
        for (int q = 0; q < 16; ++q) { v[q] = *(const f32x4*)(xr + 4 * (F.lane + 64 * q)); s += (v[q][0] * v[q][0] + v[q][1] * v[q][1]) + (v[q][2] * v[q][2] + v[q][3] * v[q][3]); }
        const float rstd = rsqrtf(wave_sum(s) * (1.0f / DM) + EPS);
#pragma unroll
        for (int q = 0; q < 16; ++q) { const int c = 4 * (F.lane + 64 * q);
            const f32x4 g = *(const f32x4*)(ng + c), a = *(const f32x4*)(sc + c), b = *(const f32x4*)(sh + c);
            const f32x4 h = (v[q] * rstd * g) * (a + 1.0f) + b;
            v2u o; o.x = pk2(h[0], h[1]); o.y = pk2(h[2], h[3]);
            *(v2u*)(H + (size_t)row * DM + c) = o; }
    }
}

#define MFMA16(a, b, c) __builtin_amdgcn_mfma_f32_16x16x32_bf16((a), (b), (c), 0, 0, 0)

__device__ __forceinline__ void swa_prompt_unit(Frame& F, const Args& A, int unit) {
    const int b = unit >> 7, i = (unit >> 2) & 31, g = unit & 3;
    const bf16* QA = (const bf16*)(F.ws + WS_QA); const bf16* KA = (const bf16*)(F.ws + WS_KA); const bf16* VA = (const bf16*)(F.ws + WS_VA);
    const bf16* ZA = (const bf16*)(F.ws + WS_ZA); bf16* AB = (bf16*)(F.ws + WS_AB);
    LAS unsigned char* Ks = F.lds;
    LAS bf16* VTs = (LAS bf16*)(F.lds + 36864);
    __syncthreads();
#pragma unroll
    for (int q = 0; q < 4; ++q) { const int p = F.tid + 512 * q, row = p >> 3, c = p & 7; const int tok = (i - 1) * 128 + row;
        v4u kv = {0u, 0u, 0u, 0u}, vv = {0u, 0u, 0u, 0u};
        if (tok >= 0) { const size_t off = (size_t)(b * SEQ + tok) * 256 + g * 64 + c * 8; kv = *(const v4u*)(KA + off); vv = *(const v4u*)(VA + off); }
        *(LAS v4u*)(Ks + row * 144 + c * 16) = kv;
        LAS bf16* vt = VTs + (c * 8) * 264 + row;
        vt[0 * 264] = (bf16)(vv.x & 0xffff); vt[1 * 264] = (bf16)(vv.x >> 16); vt[2 * 264] = (bf16)(vv.y & 0xffff); vt[3 * 264] = (bf16)(vv.y >> 16);
        vt[4 * 264] = (bf16)(vv.z & 0xffff); vt[5 * 264] = (bf16)(vv.z >> 16); vt[6 * 264] = (bf16)(vv.w & 0xffff); vt[7 * 264] = (bf16)(vv.w >> 16); }
    __syncthreads();
    const int hq = g * 8 + F.wave, c = F.lane & 15, gg = F.lane >> 4;
    const float sink = FIN(11)[hq];
    for (int sub = 0; sub < 8; ++sub) {
        const size_t qrow0 = (size_t)b * SEQ + i * 128 + sub * 16;
        bf16x8 bq[2];
#pragma unroll
        for (int ks = 0; ks < 2; ++ks) bq[ks] = *(const bf16x8*)(QA + (qrow0 + c) * 2048 + hq * 64 + ks * 32 + 8 * gg);
        f32x4 s[16];
#pragma unroll
        for (int kt = 0; kt < 16; ++kt) { f32x4 a = {0.f, 0.f, 0.f, 0.f};
#pragma unroll
            for (int ks = 0; ks < 2; ++ks) { const bf16x8 ak = *(const LAS bf16x8*)(Ks + (16 * kt + c) * 144 + (ks * 32 + 8 * gg) * 2); a = MFMA16(ak, bq[ks], a); }
            s[kt] = a; if ((kt & 3) == 3) asm volatile("" ::: "memory"); }
        const int qq = sub * 16 + c;
        float m = sink;
#pragma unroll
        for (int kt = 0; kt < 16; ++kt)
#pragma unroll
            for (int r = 0; r < 4; ++r) { const int kk = 16 * kt + 4 * gg + r; const bool valid = (kk >= qq) && (kk <= qq + 128) && (i > 0 || kk >= 128);
                const float v = valid ? s[kt][r] * 0.125f : -1e30f; s[kt][r] = v; m = fmaxf(m, v); }
        m = fmaxf(m, __shfl_xor(m, 16)); m = fmaxf(m, __shfl_xor(m, 32));
        float sum = 0.f;
#pragma unroll
        for (int kt = 0; kt < 16; ++kt)
#pragma unroll
            for (int r = 0; r < 4; ++r) { const float p = (s[kt][r] > -1e29f) ? __expf(s[kt][r] - m) : 0.f; s[kt][r] = p; sum += p; }
        sum += __shfl_xor(sum, 16); sum += __shfl_xor(sum, 32);
        const float inv = 1.0f / (sum + __expf(sink - m));
        f32x4 o[4];
#pragma unroll
        for (int nt = 0; nt < 4; ++nt) o[nt] = (f32x4){0.f, 0.f, 0.f, 0.f};
#pragma unroll
        for (int j = 0; j < 8; ++j) { v4u pw; pw.x = pk2(s[2 * j][0], s[2 * j][1]); pw.y = pk2(s[2 * j][2], s[2 * j][3]); pw.z = pk2(s[2 * j + 1][0], s[2 * j + 1][1]); pw.w = pk2(s[2 * j + 1][2], s[2 * j + 1][3]);
            const bf16x8 pa = __builtin_bit_cast(bf16x8, pw);
#pragma unroll
            for (int nt = 0; nt < 4; ++nt) { const LAS bf16* vp = VTs + (16 * nt + c) * 264 + 32 * j + 4 * gg;
                const v2u v0 = *(const LAS v2u*)(vp), v1 = *(const LAS v2u*)(vp + 16);
                v4u vw; vw.x = v0.x; vw.y = v0.y; vw.z = v1.x; vw.w = v1.y;
                o[nt] = MFMA16(pa, __builtin_bit_cast(bf16x8, vw), o[nt]); }
            asm volatile("" ::: "memory"); }
#pragma unroll
        for (int r = 0; r < 4; ++r) { const float ir = __shfl(inv, 4 * gg + r); const size_t row = qrow0 + 4 * gg + r;
#pragma unroll
            for (int nt = 0; nt < 4; ++nt) { const int col = hq * 64 + 16 * nt + c;
                AB[row * DM + col] = f2bf(o[nt][r] * ir * bf2f(ZA[row * 2048 + col])); } }
    }
}

__device__ __forceinline__ void swa_sample_unit(Frame& F, const Args& A, int unit) {
    const int n = unit >> 2, g = unit & 3;
    const bf16* QA = (const bf16*)(F.ws + WS_QA); const bf16* KA = (const bf16*)(F.ws + WS_KA); const bf16* VA = (const bf16*)(F.ws + WS_VA);
    const bf16* ZA = (const bf16*)(F.ws + WS_ZA); bf16* AB = (bf16*)(F.ws + WS_AB);
    const float* ck = FIN(2); const float* cv = FIN(3);
    LAS unsigned char* Ks = F.lds;
    LAS bf16* VTs = (LAS bf16*)(F.lds + 23040);
    __syncthreads();
#pragma unroll
    for (int q = 0; q < 4; ++q) { const int p = F.tid + 512 * q, row = p >> 4, c4 = p & 15;
        const size_t off = ((size_t)(n * 128 + row) * 4 + g) * 64 + c4 * 4;
        const f32x4 kv = *(const f32x4*)(ck + off), vv = *(const f32x4*)(cv + off);
        v2u kw; kw.x = pk2(kv[0], kv[1]); kw.y = pk2(kv[2], kv[3]);
        *(LAS v2u*)(Ks + row * 144 + c4 * 8) = kw;
        LAS bf16* vt = VTs + (c4 * 4) * 168 + row;
        vt[0] = f2bf(vv[0]); vt[168] = f2bf(vv[1]); vt[336] = f2bf(vv[2]); vt[504] = f2bf(vv[3]);
        if (row >= 8) { const size_t oo = ((size_t)(n * 128 + row - 8) * 4 + g) * 64 + c4 * 4; *(f32x4*)(F.out + OUT_KWS + oo) = kv; *(f32x4*)(F.out + OUT_VWS + oo) = vv; } }
    if (F.tid < 256) { const int row = 128 + (F.tid >> 3), c = F.tid & 7;
        v4u kv = {0u, 0u, 0u, 0u}, vv = {0u, 0u, 0u, 0u};
        if (row < 136) { const size_t off = (size_t)(NPR + n * 8 + row - 128) * 256 + g * 64 + c * 8; kv = *(const v4u*)(KA + off); vv = *(const v4u*)(VA + off);
            const size_t oo = ((size_t)(n * 128 + row - 8) * 4 + g) * 64 + c * 8;
            *(f32x4*)(F.out + OUT_KWS + oo) = (f32x4){bflo(kv.x), bfhi(kv.x), bflo(kv.y), bfhi(kv.y)}; *(f32x4*)(F.out + OUT_KWS + oo + 4) = (f32x4){bflo(kv.z), bfhi(kv.z), bflo(kv.w), bfhi(kv.w)};
            *(f32x4*)(F.out + OUT_VWS + oo) = (f32x4){bflo(vv.x), bfhi(vv.x), bflo(vv.y), bfhi(vv.y)}; *(f32x4*)(F.out + OUT_VWS + oo + 4) = (f32x4){bflo(vv.z), bfhi(vv.z), bflo(vv.w), bfhi(vv.w)}; }
        *(LAS v4u*)(Ks + row * 144 + c * 16) = kv;
        LAS bf16* vt = VTs + (c * 8) * 168 + row;
        vt[0 * 168] = (bf16)(vv.x & 0xffff); vt[1 * 168] = (bf16)(vv.x >> 16); vt[2 * 168] = (bf16)(vv.y & 0xffff); vt[3 * 168] = (bf16)(vv.y >> 16);
        vt[4 * 168] = (bf16)(vv.z & 0xffff); vt[5 * 168] = (bf16)(vv.z >> 16); vt[6 * 168] = (bf16)(vv.w & 0xffff); vt[7 * 168] = (bf16)(vv.w >> 16); }
    __syncthreads();
    const int hq = g * 8 + F.wave, c = F.lane & 15, gg = F.lane >> 4, tq = c & 7;
    const float sink = FIN(11)[hq];
    const size_t qrow0 = (size_t)NPR + n * 8;
    bf16x8 bq[2];
#pragma unroll
    for (int ks = 0; ks < 2; ++ks) bq[ks] = *(const bf16x8*)(QA + (qrow0 + tq) * 2048 + hq * 64 + ks * 32 + 8 * gg);
    f32x4 s[10];
#pragma unroll
    for (int kt = 0; kt < 10; ++kt) { f32x4 a = {0.f, 0.f, 0.f, 0.f};
#pragma unroll
        for (int ks = 0; ks < 2; ++ks) { const bf16x8 ak = *(const LAS bf16x8*)(Ks + (16 * kt + c) * 144 + (ks * 32 + 8 * gg) * 2); a = MFMA16(ak, bq[ks], a); }
        s[kt] = a; if ((kt & 3) == 3) asm volatile("" ::: "memory"); }
    float m = sink;
#pragma unroll
    for (int kt = 0; kt < 10; ++kt)
#pragma unroll
        for (int r = 0; r < 4; ++r) { const int kk = 16 * kt + 4 * gg + r; const bool valid = (kk >= tq) && (kk <= tq + 128) && (kk < 136);
            const float v = valid ? s[kt][r] * 0.125f : -1e30f; s[kt][r] = v; m = fmaxf(m, v); }
    m = fmaxf(m, __shfl_xor(m, 16)); m = fmaxf(m, __shfl_xor(m, 32));
    float sum = 0.f;
#pragma unroll
    for (int kt = 0; kt < 10; ++kt)
#pragma unroll
        for (int r = 0; r < 4; ++r) { const float p = (s[kt][r] > -1e29f) ? __expf(s[kt][r] - m) : 0.f; s[kt][r] = p; sum += p; }
    sum += __shfl_xor(sum, 16); sum += __shfl_xor(sum, 32);
    const float inv = 1.0f / (sum + __expf(sink - m));
    f32x4 o[4];
#pragma unroll
    for (int nt = 0; nt < 4; ++nt) o[nt] = (f32x4){0.f, 0.f, 0.f, 0.f};
#pragma unroll
    for (int j = 0; j < 5; ++j) { v4u pw; pw.x = pk2(s[2 * j][0], s[2 * j][1]); pw.y = pk2(s[2 * j][2], s[2 * j][3]); pw.z = pk2(s[2 * j + 1][0], s[2 * j + 1][1]); pw.w = pk2(s[2 * j + 1][2], s[2 * j + 1][3]);
        const bf16x8 pa = __builtin_bit_cast(bf16x8, pw);
#pragma unroll
        for (int nt = 0; nt < 4; ++nt) { const LAS bf16* vp = VTs + (16 * nt + c) * 168 + 32 * j + 4 * gg;
            const v2u v0 = *(const LAS v2u*)(vp), v1 = *(const LAS v2u*)(vp + 16);
            v4u vw; vw.x = v0.x; vw.y = v0.y; vw.z = v1.x; vw.w = v1.y;
            o[nt] = MFMA16(pa, __builtin_bit_cast(bf16x8, vw), o[nt]); }
        asm volatile("" ::: "memory"); }
#pragma unroll
    for (int r = 0; r < 4; ++r) { const float ir = __shfl(inv, 4 * gg + r);
        if (gg < 2) { const size_t row = qrow0 + 4 * gg + r;
#pragma unroll
            for (int nt = 0; nt < 4; ++nt) { const int col = hq * 64 + 16 * nt + c;
                AB[row * DM + col] = f2bf(o[nt][r] * ir * bf2f(ZA[row * 2048 + col])); } } }
}

__device__ __forceinline__ float log_sigmoid_(float x) { return fminf(x, 0.f) - log1pf(__expf(-fabsf(x))); }

__device__ __forceinline__ void gla_prep_unit(Frame& F, const Args& A, int unit) {
    const int n = unit >> 8, h = (unit >> 6) & 3, ch = unit & 63;
    const size_t row0 = (size_t)n * SEQ + ch * 64;
    const bf16* QB = (const bf16*)(F.ws + WS_QB); const bf16* KB = (const bf16*)(F.ws + WS_KB); const bf16* VB = (const bf16*)(F.ws + WS_VB);
    const float* R = (const float*)(F.ws + WS_R); const float* w2 = FIN(12); const float* ba = FIN(13);
    bf16* QT = (bf16*)(F.ws + WS_QT) + (size_t)unit * 64 * 256; bf16* KDT = (bf16*)(F.ws + WS_KDT) + (size_t)unit * 256 * 64;
    bf16* ATT = (bf16*)(F.ws + WS_ATT) + (size_t)unit * 64 * 64; bf16* VT = (bf16*)(F.ws + WS_VT) + (size_t)unit * 512 * 64; float* DEC = (float*)(F.ws + WS_DEC) + (size_t)unit * 256;
    LAS float* Rs = (LAS float*)F.lds;
    LAS float* TOT = (LAS float*)(F.lds + 4096);
    LAS unsigned char* Vs = F.lds + 8192;
    LAS bf16* QTs = (LAS bf16*)(F.lds + 8192);
    LAS bf16* KTs = (LAS bf16*)(F.lds + 8192 + 33792);
    __syncthreads();
    if (F.tid < 256) *(LAS f32x4*)(Rs + F.tid * 4) = *(const f32x4*)(R + row0 * 16 + F.tid * 4);
#pragma unroll
    for (int q = 0; q < 8; ++q) { const int p = F.tid + 512 * q, row = p >> 6, c = p & 63;
        *(LAS v4u*)(Vs + row * 1040 + c * 16) = *(const v4u*)(VB + (row0 + row) * 2048 + h * 512 + c * 8); }
    __syncthreads();
    { const LAS bf16* vcol = (const LAS bf16*)Vs + F.tid;
#pragma unroll
      for (int t8 = 0; t8 < 8; ++t8) { unsigned e[8];
#pragma unroll
          for (int k = 0; k < 8; ++k) e[k] = vcol[(t8 * 8 + k) * 520];
          v4u o; o.x = e[0] | (e[1] << 16); o.y = e[2] | (e[3] << 16); o.z = e[4] | (e[5] << 16); o.w = e[6] | (e[7] << 16);
          *(v4u*)(VT + (size_t)F.tid * 64 + t8 * 8) = o; } }
    const int dk = F.tid & 255, half = F.tid >> 8;
    float wv[16];
#pragma unroll
    for (int j = 0; j < 16; ++j) wv[j] = w2[j * 1024 + h * 256 + dk];
    const float bias = ba[h * 256 + dk];
    float run = 0.f;
#pragma unroll 4
    for (int tt = 0; tt < 32; ++tt) { const LAS float* rr = Rs + (half * 32 + tt) * 16; float x = bias;
#pragma unroll
        for (int j4 = 0; j4 < 4; ++j4) { const f32x4 rv = *(const LAS f32x4*)(rr + 4 * j4); x += rv[0] * wv[4 * j4] + rv[1] * wv[4 * j4 + 1] + rv[2] * wv[4 * j4 + 2] + rv[3] * wv[4 * j4 + 3]; }
        run += log_sigmoid_(x) * 0.0625f; }
    TOT[half * 256 + dk] = run;
    __syncthreads();
    const float tot0 = TOT[dk], tot1 = TOT[256 + dk];
    const float off = half ? tot0 : 0.f, blast = tot0 + tot1;
    run = off;
#pragma unroll 1
    for (int q8 = 0; q8 < 4; ++q8) { unsigned kd[4];
#pragma unroll
        for (int e = 0; e < 8; ++e) { const int t = half * 32 + q8 * 8 + e;
            { const LAS float* rr = Rs + t * 16; float x = bias;
#pragma unroll
              for (int j4 = 0; j4 < 4; ++j4) { const f32x4 rv = *(const LAS f32x4*)(rr + 4 * j4); x += rv[0] * wv[4 * j4] + rv[1] * wv[4 * j4 + 1] + rv[2] * wv[4 * j4 + 2] + rv[3] * wv[4 * j4 + 3]; }
              run += log_sigmoid_(x) * 0.0625f; }
            const float b = run;
            const float q = bf2f(QB[(row0 + t) * 1024 + h * 256 + dk]), k = bf2f(KB[(row0 + t) * 1024 + h * 256 + dk]);
            const bf16 qt = f2bf(q * __expf(b) * 0.0625f), kt = f2bf(k * __expf(-b)); const unsigned kdv = f2bf(k * __expf(blast - b));
            QTs[t * 264 + dk] = qt; KTs[t * 264 + dk] = kt; QT[t * 256 + dk] = qt;
            if (e & 1) kd[e >> 1] |= kdv << 16; else kd[e >> 1] = kdv; }
        v4u o; o.x = kd[0]; o.y = kd[1]; o.z = kd[2]; o.w = kd[3]; *(v4u*)(KDT + (size_t)dk * 64 + half * 32 + 8 * q8) = o; }
    if (half == 0) DEC[dk] = __expf(blast);
    __syncthreads();
    { const int c = F.lane & 15, gg = F.lane >> 4;
#pragma unroll
      for (int x = 0; x < 2; ++x) { const int id = F.wave * 2 + x, ti = id >> 2, si = id & 3;
          f32x4 a = {0.f, 0.f, 0.f, 0.f};
          if (si <= ti) {
#pragma unroll
              for (int ks = 0; ks < 8; ++ks) { const bf16x8 ak = *(const LAS bf16x8*)(KTs + (16 * si + c) * 264 + ks * 32 + 8 * gg), bqv = *(const LAS bf16x8*)(QTs + (16 * ti + c) * 264 + ks * 32 + 8 * gg);
                  a = MFMA16(ak, bqv, a); } }
          const int t = 16 * ti + c, s0 = 16 * si + 4 * gg;
          v2u o; o.x = pk2(s0 <= t ? a[0] : 0.f, s0 + 1 <= t ? a[1] : 0.f); o.y = pk2(s0 + 2 <= t ? a[2] : 0.f, s0 + 3 <= t ? a[3] : 0.f);
          *(v2u*)(ATT + (size_t)t * 64 + s0) = o; } }
}

__device__ __forceinline__ void win_prompt(Frame& F, const Args& A) {
    const bf16* KA = (const bf16*)(F.ws + WS_KA); const bf16* VA = (const bf16*)(F.ws + WS_VA);
    const size_t gt = (size_t)F.blk * 512 + F.tid, NT = (size_t)F.G * 512;
    for (size_t i = gt; i < 65536; i += NT) { const int b = (int)(i >> 15), rem = (int)(i & 32767); const size_t src = (size_t)(b * SEQ + SEQ - 128) * 256 + rem;
        F.out[OUT_KWP + i] = bf2f(KA[src]); F.out[OUT_VWP + i] = bf2f(VA[src]); }
}

__device__ __forceinline__ void gla_seq_unit(Frame& F, const Args& A, int unit) {
    const int nh = unit >> 2, dvb = unit & 3, n = nh >> 2, h = nh & 3;
    const int c = F.lane & 15, gg = F.lane >> 4;
    const int dv0 = dvb * 128 + F.wave * 16;
    LAS unsigned char* QTs = F.lds;
    LAS unsigned char* KDs = F.lds + 33792;
    LAS unsigned char* ATs = F.lds + 33792 + 36864;
    LAS float* DCs = (LAS float*)(F.lds + 33792 + 36864 + 9216);
    float* OB = (float*)(F.ws + WS_OB);
    f32x4 S[16];
#pragma unroll
    for (int i = 0; i < 16; ++i) S[i] = (f32x4){0.f, 0.f, 0.f, 0.f};
    for (int ch = 0; ch < 64; ++ch) {
        const size_t uc = (size_t)nh * 64 + ch;
        const bf16* QT = (const bf16*)(F.ws + WS_QT) + uc * 64 * 256; const bf16* KDT = (const bf16*)(F.ws + WS_KDT) + uc * 256 * 64;
        const bf16* ATT = (const bf16*)(F.ws + WS_ATT) + uc * 64 * 64; const bf16* VT = (const bf16*)(F.ws + WS_VT) + uc * 512 * 64; const float* DEC = (const float*)(F.ws + WS_DEC) + uc * 256;
        __syncthreads();
#pragma unroll
        for (int q = 0; q < 4; ++q) { const int p = F.tid + 512 * q;
            *(LAS v4u*)(QTs + (p >> 5) * 528 + (p & 31) * 16) = *(const v4u*)(QT + (size_t)p * 8);
            *(LAS v4u*)(KDs + (p >> 3) * 144 + (p & 7) * 16) = *(const v4u*)(KDT + (size_t)p * 8); }
        *(LAS v4u*)(ATs + (F.tid >> 3) * 144 + (F.tid & 7) * 16) = *(const v4u*)(ATT + (size_t)F.tid * 8);
        if (F.tid < 64) *(LAS f32x4*)(DCs + F.tid * 4) = *(const f32x4*)(DEC + F.tid * 4);
        bf16x8 vf[2];
#pragma unroll
        for (int j = 0; j < 2; ++j) vf[j] = *(const bf16x8*)(VT + (size_t)(dv0 + c) * 64 + 32 * j + 8 * gg);
        __syncthreads();
        f32x4 o[4];
#pragma unroll
        for (int mt = 0; mt < 4; ++mt) { f32x4 a = {0.f, 0.f, 0.f, 0.f};
#pragma unroll
            for (int j = 0; j < 2; ++j) { const bf16x8 af = *(const LAS bf16x8*)(ATs + (16 * mt + c) * 144 + (32 * j + 8 * gg) * 2); a = MFMA16(af, vf[j], a); }
            o[mt] = a; }
#pragma unroll
        for (int j = 0; j < 8; ++j) { v4u sw; sw.x = pk2(S[2 * j][0], S[2 * j][1]); sw.y = pk2(S[2 * j][2], S[2 * j][3]); sw.z = pk2(S[2 * j + 1][0], S[2 * j + 1][1]); sw.w = pk2(S[2 * j + 1][2], S[2 * j + 1][3]);
            const bf16x8 sb = __builtin_bit_cast(bf16x8, sw);
#pragma unroll
            for (int mt = 0; mt < 4; ++mt) { const LAS unsigned char* qp = QTs + (16 * mt + c) * 528 + (32 * j + 4 * gg) * 2;
                const v2u q0 = *(const LAS v2u*)(qp), q1 = *(const LAS v2u*)(qp + 32);
                v4u qw; qw.x = q0.x; qw.y = q0.y; qw.z = q1.x; qw.w = q1.y;
                o[mt] = MFMA16(__builtin_bit_cast(bf16x8, qw), sb, o[mt]); } }
#pragma unroll
        for (int i = 0; i < 16; ++i) { const f32x4 d = *(const LAS f32x4*)(DCs + 16 * i + 4 * gg); f32x4 a = S[i] * d;
#pragma unroll
            for (int j = 0; j < 2; ++j) { const bf16x8 kf = *(const LAS bf16x8*)(KDs + (16 * i + c) * 144 + (32 * j + 8 * gg) * 2); a = MFMA16(kf, vf[j], a); }
            S[i] = a; }
#pragma unroll
        for (int mt = 0; mt < 4; ++mt)
#pragma unroll
            for (int r = 0; r < 4; ++r) OB[((size_t)n * SEQ + ch * 64 + 16 * mt + 4 * gg + r) * 2048 + h * 512 + dv0 + c] = o[mt][r];
    }
    float* gsp = F.out + OUT_GSP + (size_t)nh * 256 * 512;
#pragma unroll
    for (int i = 0; i < 16; ++i)
#pragma unroll
        for (int r = 0; r < 4; ++r) gsp[(size_t)(16 * i + 4 * gg + r) * 512 + dv0 + c] = S[i][r];
}

__device__ __forceinline__ void gla_sample_unit(Frame& F, const Args& A, int unit) {
    const int n = unit >> 2, h = unit & 3;
    const size_t row0 = (size_t)NPR + n * 8;
    const bf16* QB = (const bf16*)(F.ws + WS_QB); const bf16* KB = (const bf16*)(F.ws + WS_KB); const bf16* VB = (const bf16*)(F.ws + WS_VB); const bf16* ZB = (const bf16*)(F.ws + WS_ZB);
    const float* R = (const float*)(F.ws + WS_R); const float* w2 = FIN(12); const float* ba = FIN(13); const float* gg_ = FIN(14);
    bf16* AB = (bf16*)(F.ws + WS_AB);
    const float* S0 = FIN(4) + (size_t)unit * 256 * 512; float* S1 = F.out + OUT_GSS + (size_t)unit * 256 * 512;
    LAS float* QTs = (LAS float*)F.lds;
    LAS float* KDs = (LAS float*)(F.lds + 8192);
    LAS float* KTs = (LAS float*)(F.lds + 16384);
    LAS float* DCs = (LAS float*)(F.lds + 24576);
    LAS float* ATs = (LAS float*)(F.lds + 25600);
    LAS float* SQ  = (LAS float*)(F.lds + 25856);
    LAS float* RED = (LAS float*)(F.lds + 26624);
    __syncthreads();
    if (F.tid < 256) { const int dk = F.tid;
        float wv[16];
#pragma unroll
        for (int j = 0; j < 16; ++j) wv[j] = w2[j * 1024 + h * 256 + dk];
        const float bias = ba[h * 256 + dk];
        float b[8]; float run = 0.f;
#pragma unroll
        for (int t = 0; t < 8; ++t) { const float* rr = R + (row0 + t) * 16; float x = bias;
#pragma unroll
            for (int j = 0; j < 16; ++j) x += rr[j] * wv[j];
            run += log_sigmoid_(x) * 0.0625f; b[t] = run; }
        const float blast = run;
#pragma unroll
        for (int t = 0; t < 8; ++t) { const float q = bf2f(QB[(row0 + t) * 1024 + h * 256 + dk]), k = bf2f(KB[(row0 + t) * 1024 + h * 256 + dk]);
            QTs[dk * 8 + t] = q * __expf(b[t]) * 0.0625f; KTs[dk * 8 + t] = k * __expf(-b[t]); KDs[dk * 8 + t] = k * __expf(blast - b[t]); }
        DCs[dk] = __expf(blast);
    }
    __syncthreads();
    { const int t = F.wave; float a[8];
#pragma unroll
      for (int s = 0; s < 8; ++s) a[s] = 0.f;
#pragma unroll
      for (int q = 0; q < 4; ++q) { const int dk = F.lane + 64 * q; const float qv = QTs[dk * 8 + t];
#pragma unroll
          for (int s = 0; s < 8; ++s) a[s] += qv * KTs[dk * 8 + s]; }
#pragma unroll
      for (int s = 0; s < 8; ++s) { const float v = wave_sum(a[s]); if (F.lane == 0) ATs[t * 8 + s] = (s <= t) ? v : 0.f; } }
    const int dv4 = (F.tid & 127) * 4, dkq = F.tid >> 7;
    f32x4 vv[8];
#pragma unroll
    for (int s = 0; s < 8; ++s) { const v2u w = *(const v2u*)(VB + (row0 + s) * 2048 + h * 512 + dv4); vv[s] = (f32x4){bflo(w.x), bfhi(w.x), bflo(w.y), bfhi(w.y)}; }
    f32x4 oa[8];
#pragma unroll
    for (int t = 0; t < 8; ++t) oa[t] = (f32x4){0.f, 0.f, 0.f, 0.f};
#pragma unroll 4
    for (int it = 0; it < 64; ++it) { const int dk = it * 4 + dkq;
        const f32x4 s0 = __builtin_nontemporal_load((const f32x4*)(S0 + (size_t)dk * 512 + dv4));
        const f32x4 q0 = *(const LAS f32x4*)(QTs + dk * 8), q1 = *(const LAS f32x4*)(QTs + dk * 8 + 4);
        const f32x4 k0 = *(const LAS f32x4*)(KDs + dk * 8), k1 = *(const LAS f32x4*)(KDs + dk * 8 + 4);
        const float d = DCs[dk];
        oa[0] += s0 * q0[0]; oa[1] += s0 * q0[1]; oa[2] += s0 * q0[2]; oa[3] += s0 * q0[3];
        oa[4] += s0 * q1[0]; oa[5] += s0 * q1[1]; oa[6] += s0 * q1[2]; oa[7] += s0 * q1[3];
        f32x4 sn = s0 * d;
        sn += vv[0] * k0[0]; sn += vv[1] * k0[1]; sn += vv[2] * k0[2]; sn += vv[3] * k0[3];
        sn += vv[4] * k1[0]; sn += vv[5] * k1[1]; sn += vv[6] * k1[2]; sn += vv[7] * k1[3];
        __builtin_nontemporal_store(sn, (f32x4*)(S1 + (size_t)dk * 512 + dv4)); }
#pragma unroll
    for (int t = 0; t < 8; ++t) *(LAS f32x4*)(RED + ((dkq * 8 + t) * 512 + dv4)) = oa[t];
    __syncthreads();
    { const int t = F.tid >> 6, d8 = (F.tid & 63) * 8;
      float o[8];
#pragma unroll
      for (int e = 0; e < 8; ++e) o[e] = 0.f;
#pragma unroll
      for (int q = 0; q < 4; ++q) { const f32x4 a = *(const LAS f32x4*)(RED + (q * 8 + t) * 512 + d8), b = *(const LAS f32x4*)(RED + (q * 8 + t) * 512 + d8 + 4);
          o[0] += a[0]; o[1] += a[1]; o[2] += a[2]; o[3] += a[3]; o[4] += b[0]; o[5] += b[1]; o[6] += b[2]; o[7] += b[3]; }
#pragma unroll
      for (int s = 0; s < 8; ++s) { const float at = ATs[t * 8 + s]; const v4u w = *(const v4u*)(VB + (row0 + s) * 2048 + h * 512 + d8);
          o[0] += at * bflo(w.x); o[1] += at * bfhi(w.x); o[2] += at * bflo(w.y); o[3] += at * bfhi(w.y); o[4] += at * bflo(w.z); o[5] += at * bfhi(w.z); o[6] += at * bflo(w.w); o[7] += at * bfhi(w.w); }
      float ss = 0.f;
#pragma unroll
      for (int e = 0; e < 8; ++e) ss += o[e] * o[e];
      ss = wave_sum(ss);
      const float rstd = rsqrtf(ss * (1.0f / 512.0f) + EPS);
      const v4u zw = *(const v4u*)(ZB + (row0 + t) * 2048 + h * 512 + d8);
      const f32x4 g0 = *(const f32x4*)(gg_ + h * 512 + d8), g1 = *(const f32x4*)(gg_ + h * 512 + d8 + 4);
      v4u w; w.x = pk2(o[0] * rstd * g0[0] * bflo(zw.x), o[1] * rstd * g0[1] * bfhi(zw.x)); w.y = pk2(o[2] * rstd * g0[2] * bflo(zw.y), o[3] * rstd * g0[3] * bfhi(zw.y));
      w.z = pk2(o[4] * rstd * g1[0] * bflo(zw.z), o[5] * rstd * g1[1] * bfhi(zw.z)); w.w = pk2(o[6] * rstd * g1[2] * bflo(zw.w), o[7] * rstd * g1[3] * bfhi(zw.w));
      *(v4u*)(AB + (row0 + t) * DM + 2048 + h * 512 + d8) = w; }
    (void)SQ;
}

__device__ __forceinline__ void phase6(Frame& F, const Args& A) {
    const float* OB = (const float*)(F.ws + WS_OB); const bf16* ZB = (const bf16*)(F.ws + WS_ZB); const float* gn = FIN(14); bf16* AB = (bf16*)(F.ws + WS_AB);
    const int gw = F.blk * NWAVES + F.wave, NGW = F.G * NWAVES;
    for (int row = gw; row < NPR; row += NGW) {
#pragma unroll
        for (int hh = 0; hh < 4; ++hh) { const int col = hh * 512 + F.lane * 8;
            const f32x4 a = *(const f32x4*)(OB + (size_t)row * 2048 + col), b = *(const f32x4*)(OB + (size_t)row * 2048 + col + 4);
            float ss = (a[0] * a[0] + a[1] * a[1]) + (a[2] * a[2] + a[3] * a[3]) + (b[0] * b[0] + b[1] * b[1]) + (b[2] * b[2] + b[3] * b[3]);
            ss = wave_sum(ss);
            const float rstd = rsqrtf(ss * (1.0f / 512.0f) + EPS);
            const v4u zw = *(const v4u*)(ZB + (size_t)row * 2048 + col);
            const f32x4 g0 = *(const f32x4*)(gn + col), g1 = *(const f32x4*)(gn + col + 4);
            v4u w; w.x = pk2(a[0] * rstd * g0[0] * bflo(zw.x), a[1] * rstd * g0[1] * bfhi(zw.x)); w.y = pk2(a[2] * rstd * g0[2] * bflo(zw.y), a[3] * rstd * g0[3] * bfhi(zw.y));
            w.z = pk2(b[0] * rstd * g1[0] * bflo(zw.z), b[1] * rstd * g1[1] * bfhi(zw.z)); w.w = pk2(b[2] * rstd * g1[2] * bflo(zw.w), b[3] * rstd * g1[3] * bfhi(zw.w));
            *(v4u*)(AB + (size_t)row * DM + 2048 + col) = w; }
    }
}

__device__ __forceinline__ void phase9(Frame& F, const Args& A) {
    const float* SSQ = (const float*)(F.ws + WS_SSQ); const float* fg = FIN(18); float* Y = F.out + OUT_Y;
    const int gw = F.blk * NWAVES + F.wave, NGW = F.G * NWAVES;
    for (int row = gw; row < NROW; row += NGW) {
        const float rstd = rsqrtf(wave_sum(SSQ[(size_t)row * 64 + F.lane]) * (1.0f / DM) + EPS);
        float* yr = Y + (size_t)row * DM;
#pragma unroll
        for (int q = 0; q < 16; ++q) { const int c = 4 * (F.lane + 64 * q); const f32x4 v = *(const f32x4*)(yr + c), g = *(const f32x4*)(fg + c); *(f32x4*)(yr + c) = v * rstd * g; }
    }
}

constexpr int N_PHASES = 10;

__global__ void __launch_bounds__(NWAVES * 64, 2) mk_fwd(Args args) {
    extern __shared__ __attribute__((aligned(16))) unsigned char lds[];
    Frame F;
    F.lds = (LAS unsigned char*)lds;
    F.tid = threadIdx.x; F.lane = F.tid & 63; F.wave = __builtin_amdgcn_readfirstlane(F.tid >> 6);
    F.G = gridDim.x; F.blk = blockIdx.x;
    const Args& A = args;
    F.out = args.out; F.ws = args.ws;
    volatile LAS unsigned* MISC = (volatile LAS unsigned*)(F.lds + MISC_OFF);
    if (F.tid < 32) MISC[F.tid] = 0u;
    __syncthreads();
    unsigned* ctl = (unsigned*)(F.ws + WS_CTL);
    XcdBarrier bar; bar.bar = ctl + CW_BAR; bar.x = 0; bar.st = nullptr;
    if (MK_N_LAUNCHES == 1) bar = xcd_barrier_post(ctl + CW_BAR, MISC + 8);
    const int lo = args.ph_lo, hi = args.ph_hi;
#ifdef ONLY
#define IN(k) ((k) == ONLY)
#else
#define IN(k) (lo <= (k) && (k) < hi)
#endif
#define SEAM(k) do { if (IN(k) && IN((k) + 1)) xcd_barrier(bar); } while (0)

    if (IN(0)) { phase0(F, A); } SEAM(0);
    if (IN(1)) { phase1(F, A); } SEAM(1);
    if (IN(2)) { phase2(F, A); } SEAM(2);
    if (IN(3)) {
        pg8::Gemm g{(const bf16*)(F.ws + WS_H), (const bf16*)(F.ws + WS_WB1), NROW, N1, DM}; pg8::StaticOrder S; S.init(NROW, N1, F.G, F.blk);
        EpiProj E{F.ws};
        pg8::gemm_phase<EpiProj>(F.lds, g, S, E);
    } SEAM(3);
    if (IN(4)) {
        for (int u = F.blk; u < 256; u += F.G) swa_prompt_unit(F, A, u);
        for (int u = F.blk; u < 512; u += F.G) gla_prep_unit(F, A, u);
        for (int u = F.blk; u < 512; u += F.G) swa_sample_unit(F, A, u);
        win_prompt(F, A);
    } SEAM(4);
    if (IN(5)) {
        if (F.G >= 64) {
            if (F.blk < 32) gla_seq_unit(F, A, F.blk);
            else for (int u = F.blk - 32; u < 512; u += F.G - 32) gla_sample_unit(F, A, u);
        } else {
            for (int u = F.blk; u < 32; u += F.G) gla_seq_unit(F, A, u);
            for (int u = F.blk; u < 512; u += F.G) gla_sample_unit(F, A, u);
        }
    } SEAM(5);
    if (IN(6)) { phase6(F, A); } SEAM(6);
    if (IN(7)) {
        pg8::Gemm g{(const bf16*)(F.ws + WS_AB), (const bf16*)(F.ws + WS_WB2), NROW, DM, DM}; pg8::StaticOrder S; S.init(NROW, DM, F.G, F.blk);
        EpiMerge E{(const bf16*)(F.ws + WS_SGA), (const bf16*)(F.ws + WS_SGB), (bf16*)(F.ws + WS_MERGED)};
        pg8::gemm_phase<EpiMerge>(F.lds, g, S, E);
    } SEAM(7);
    if (IN(8)) {
        pg8::Gemm g{(const bf16*)(F.ws + WS_MERGED), (const bf16*)(F.ws + WS_WB3), NROW, DM, DM}; pg8::StaticOrder S; S.init(NROW, DM, F.G, F.blk);
        EpiOut E{A.in[0], A.in[1], (const float*)(F.ws + WS_MOD), F.out + OUT_Y, (float*)(F.ws + WS_SSQ)};
        pg8::gemm_phase<EpiOut>(F.lds, g, S, E);
    } SEAM(8);
    if (IN(9)) { phase9(F, A); }
#undef IN
#undef SEAM
}

extern "C" void kernel_launch(void* const* d_in, const int* in_sizes, int n_in, void* d_out, int out_size, void* d_ws, size_t ws_size, hipStream_t stream) {
    static int grid = 0;
    if (grid == 0) {
        if (n_in != 19 || (size_t)out_size != OUT_TOTAL || ws_size < WS_END) { fprintf(stderr, "kernel_launch: unexpected sizes n_in %d out %d ws %zu (need %zu)\n", n_in, out_size, ws_size, (size_t)WS_END); grid = -1; return; }
        int dev = 0, cus = 0, per_cu = 0;
        if (hipGetDevice(&dev) != hipSuccess || hipDeviceGetAttribute(&cus, hipDeviceAttributeMultiprocessorCount, dev) != hipSuccess) { grid = -1; return; }
        if (hipFuncSetAttribute((const void*)mk_fwd, hipFuncAttributeMaxDynamicSharedMemorySize, LDS_BYTES) != hipSuccess) { fprintf(stderr, "kernel_launch: hipFuncSetAttribute failed\n"); grid = -1; return; }
        if (hipOccupancyMaxActiveBlocksPerMultiprocessor(&per_cu, (const void*)mk_fwd, NWAVES * 64, LDS_BYTES) != hipSuccess || per_cu < 1) fprintf(stderr, "kernel_launch: occupancy query reports %d\n", per_cu);
        (void)hipGetLastError();
        grid = cus;
    }
    if (grid < 0) return;
    (void)hipMemsetAsync((char*)d_ws + WS_CTL, 0, CTL_ZERO_BYTES, stream);
    Args a{};
    for (int i = 0; i < 19; ++i) a.in[i] = (const float*)d_in[i];
    a.out = (float*)d_out; a.ws = (unsigned char*)d_ws;
    if (MK_N_LAUNCHES == 1) { a.ph_lo = 0; a.ph_hi = N_PHASES; hipLaunchKernelGGL(mk_fwd, dim3(grid), dim3(NWAVES * 64), LDS_BYTES, stream, a); }
    else for (int li = 0; li < N_PHASES; ++li) { a.ph_lo = li; a.ph_hi = li + 1; hipLaunchKernelGGL(mk_fwd, dim3(grid), dim3(NWAVES * 64), LDS_BYTES, stream, a); }
}
```

```cpp
#include <hip/hip_runtime.h>
#include <cstdio>
#include <cstdint>

#ifndef MK_N_LAUNCHES
#define MK_N_LAUNCHES 1
#endif

#define GAS __attribute__((address_space(1)))
#define LAS __attribute__((address_space(3)))
typedef unsigned short bf16;
typedef unsigned v4u __attribute__((ext_vector_type(4)));
typedef unsigned v2u __attribute__((ext_vector_type(2)));
typedef float f32x2 __attribute__((ext_vector_type(2)));
typedef float f32x4 __attribute__((ext_vector_type(4)));
typedef float f32x16 __attribute__((ext_vector_type(16)));
typedef short bf16x8 __attribute__((ext_vector_type(8)));
typedef __bf16 bf16x2_t __attribute__((ext_vector_type(2)));
#define LDS_WAIT() asm volatile("s_waitcnt lgkmcnt(0)" ::: "memory")
#define VM_WAIT() asm volatile("s_waitcnt vmcnt(0)" ::: "memory")

__device__ __forceinline__ unsigned pk2(float lo, float hi) { f32x2 v = {lo, hi}; bf16x2_t b = __builtin_convertvector(v, bf16x2_t); return __builtin_bit_cast(unsigned, b); }
__device__ __forceinline__ bf16 f2bf(float f) { return (bf16)(pk2(f, 0.f) & 0xffffu); }
__device__ __forceinline__ float bf2f(bf16 b) { return __uint_as_float(((unsigned)b) << 16); }
__device__ __forceinline__ float bflo(unsigned w) { return __uint_as_float(w << 16); }
__device__ __forceinline__ float bfhi(unsigned w) { return __uint_as_float(w & 0xffff0000u); }
__device__ __forceinline__ float wave_sum(float v) {
#pragma unroll
    for (int o = 1; o < 64; o <<= 1) v += __shfl_xor(v, o);
    return v;
}
__device__ __forceinline__ float sigmoidf_(float x) { return __builtin_amdgcn_rcpf(1.0f + __builtin_amdgcn_exp2f(-1.44269504089f * x)); }

#define XB_TMO      128
#define XB_XCNT(j)  (256  + 64 * (j))
#define XB_XSUB(j)  (1280 + 64 * (j))
#define XB_XGEN(j)  (2304 + 64 * (j))
#define XB_TOP      3328
#define XB_TOPGEN   3392
#define XCD_BAR_WORDS 3456
#define XB_SPIN_CAP (1u << 18)

__device__ __forceinline__ unsigned xb_ld(unsigned* p)              { return __hip_atomic_load(p, __ATOMIC_RELAXED, __HIP_MEMORY_SCOPE_AGENT); }
__device__ __forceinline__ unsigned xb_add(unsigned* p, unsigned v) { return __hip_atomic_fetch_add(p, v, __ATOMIC_RELAXED, __HIP_MEMORY_SCOPE_AGENT); }
__device__ __forceinline__ unsigned xb_xcc_id() { return (unsigned)__builtin_amdgcn_s_getreg((3 << 11) | 20) & 0xFu; }
#define XB_SPIN(cond, bar) do { unsigned _sp = 0; while (cond) { __builtin_amdgcn_s_sleep(1); \
    if ((++_sp & 255u) == 0u) { if (xb_ld(&(bar)[XB_TMO])) break; if (_sp > XB_SPIN_CAP) { atomicAdd(&(bar)[XB_TMO], 1u); break; } } } } while (0)

struct XcdBarrier { unsigned* bar; unsigned x; volatile LAS unsigned* st; };

__device__ __forceinline__ XcdBarrier xcd_barrier_post(unsigned* bar, volatile LAS unsigned* st) {
    XcdBarrier b; b.bar = bar; b.x = xb_xcc_id(); b.st = st;
    if (threadIdx.x == 0) (void)xb_add(&bar[XB_XCNT(b.x)], 1u);
    return b;
}
__device__ __forceinline__ void xcd_barrier_complete(unsigned* bar, unsigned x, unsigned& nloc, unsigned& nx) {
    const unsigned G = gridDim.x * gridDim.y * gridDim.z;
    unsigned sum, cnt, mine, sp = 0u;
    for (;;) {
        sum = 0u; cnt = 0u; mine = 0u;
#pragma unroll
        for (unsigned j = 0; j < 16; ++j) { const unsigned c = xb_ld(&bar[XB_XCNT(j)]); sum += c; cnt += (c > 0u) ? 1u : 0u; mine = (j == x) ? c : mine; }
        if (sum == G) break;
        __builtin_amdgcn_s_sleep(1);
        if ((++sp & 255u) == 0u) { if (xb_ld(&bar[XB_TMO])) break; if (sp > XB_SPIN_CAP) { atomicAdd(&bar[XB_TMO], 1u); break; } }
    }
    nloc = mine > 0u ? mine : 1u; nx = cnt > 0u ? cnt : 1u;
}
__device__ __forceinline__ void xcd_barrier(const XcdBarrier& b) {
    asm volatile("s_waitcnt vmcnt(0)" ::: "memory");
    __syncthreads();
    if (threadIdx.x == 0) {
        unsigned* bar = b.bar;
        __builtin_amdgcn_s_waitcnt(0);
        unsigned nloc = b.st[0], nx = b.st[1];
        if (nloc == 0u) { xcd_barrier_complete(bar, b.x, nloc, nx); b.st[0] = nloc; b.st[1] = nx; }
        const unsigned old = xb_add(&bar[XB_XSUB(b.x)], 1u);
        const unsigned gen = old / nloc;
        if (old + 1u == (gen + 1u) * nloc) {
            __builtin_amdgcn_fence(__ATOMIC_RELEASE, "agent");
            asm volatile("s_waitcnt vmcnt(0)" ::: "memory");
            const unsigned og = xb_add(&bar[XB_TOP], 1u);
            const unsigned tg = og / nx;
            if (og + 1u == (tg + 1u) * nx) xb_add(&bar[XB_TOPGEN], 1u);
            else XB_SPIN(xb_ld(&bar[XB_TOPGEN]) == tg, bar);
            __builtin_amdgcn_fence(__ATOMIC_ACQUIRE, "agent");
            xb_add(&bar[XB_XGEN(b.x)], 1u);
            asm volatile("s_waitcnt vmcnt(0)" ::: "memory");
        } else {
            XB_SPIN(xb_ld(&bar[XB_XGEN(b.x)]) == gen, bar);
            __builtin_amdgcn_fence(__ATOMIC_ACQUIRE, "agent");
            asm volatile("s_waitcnt vmcnt(0)" ::: "memory");
        }
    }
    __syncthreads();
}

constexpr int DM = 4096;
constexpr int NPR = 8192, NSR = 1024, NROW = NPR + NSR;
constexpr int SEQ = 4096, NSEQ_S = 128, TS = 8;
constexpr int N1 = 19200, NT1 = 75;
constexpr int PROJ = 18960;
constexpr int NMOD = 130;
constexpr float EPS = 1e-6f;

constexpr size_t MiB = 1u << 20;
constexpr size_t WS_CTL = 0, CTL_ZERO_BYTES = 1 * MiB;
constexpr size_t WS_WB1 = 1 * MiB;
constexpr size_t WS_WB2 = WS_WB1 + (size_t)N1 * DM * 2;
constexpr size_t WS_WB3 = WS_WB2 + (size_t)DM * DM * 2;
constexpr size_t WS_CS  = WS_WB3 + (size_t)DM * DM * 2;
constexpr size_t WS_MOD = WS_CS + (size_t)160 * DM * 2;
constexpr size_t WS_H   = WS_MOD + (size_t)132 * 12288 * 4;
constexpr size_t WS_QA  = WS_H + (size_t)NROW * DM * 2;
constexpr size_t WS_KA  = WS_QA + (size_t)NROW * 2048 * 2;
constexpr size_t WS_VA  = WS_KA + (size_t)NROW * 256 * 2;
constexpr size_t WS_ZA  = WS_VA + (size_t)NROW * 256 * 2;
constexpr size_t WS_QB  = WS_ZA + (size_t)NROW * 2048 * 2;
constexpr size_t WS_KB  = WS_QB + (size_t)NROW * 1024 * 2;
constexpr size_t WS_VB  = WS_KB + (size_t)NROW * 1024 * 2;
constexpr size_t WS_ZB  = WS_VB + (size_t)NROW * 2048 * 2;
constexpr size_t WS_SGA = WS_ZB + (size_t)NROW * 2048 * 2;
constexpr size_t WS_SGB = WS_SGA + (size_t)NROW * DM * 2;
constexpr size_t WS_R   = WS_SGB + (size_t)NROW * DM * 2;
constexpr size_t WS_QT  = WS_R + (size_t)NROW * 16 * 4;
constexpr size_t WS_KDT = WS_QT + (size_t)512 * 64 * 256 * 2;
constexpr size_t WS_ATT = WS_KDT + (size_t)512 * 64 * 256 * 2;
constexpr size_t WS_VT  = WS_ATT + (size_t)512 * 64 * 64 * 2;
constexpr size_t WS_DEC = WS_VT + (size_t)512 * 512 * 64 * 2;
constexpr size_t WS_OB  = WS_DEC + (size_t)512 * 256 * 4;
constexpr size_t WS_AB  = WS_OB + (size_t)NPR * 2048 * 4;
constexpr size_t WS_SSQ = WS_AB + (size_t)NROW * DM * 2;
constexpr size_t WS_END = WS_SSQ + (size_t)NROW * 64 * 4;
constexpr size_t WS_MERGED = WS_H;
constexpr size_t WS_XN = WS_AB;
constexpr int CW_BAR = 4096;

constexpr size_t OUT_Y = 0;
constexpr size_t OUT_KWP = (size_t)NROW * DM;
constexpr size_t OUT_VWP = OUT_KWP + 65536;
constexpr size_t OUT_GSP = OUT_VWP + 65536;
constexpr size_t OUT_KWS = OUT_GSP + 1048576;
constexpr size_t OUT_VWS = OUT_KWS + 4194304;
constexpr size_t OUT_GSS = OUT_VWS + 4194304;
constexpr size_t OUT_TOTAL = OUT_GSS + 67108864;

constexpr int RING_BYTES = 131072;
constexpr int LDS_BYTES = 155648;
constexpr int MISC_OFF = LDS_BYTES - 256;
constexpr int SMP_P4 = 0;
constexpr int CW_SMP = 64;
constexpr int NWAVES = 8;

namespace pg8 {
constexpr int BM = 256, BK = 64, HALF = 128, HTB = HALF * BK * 2, STAGE_BYTES = 8 * HTB, NXCD = 8, WGM = 8;
__host__ __device__ __forceinline__ int lds_byte(int r, int c) { const int st = (r >> 4) * 2 + (c >> 5), rr = r & 15, cc = c & 31, ob = rr * 64 + cc * 2; return st * 1024 + (ob ^ (((ob >> 9) & 1) << 5)); }
__host__ __device__ __forceinline__ void stage_rc(int b, int& R, int& C) { const int st = b / 1024, sb = b % 1024, swz = sb ^ (((sb >> 9) & 1) << 5); R = (st >> 1) * 16 + swz / 64; C = (st & 1) * 32 + (swz % 64) / 2; }
__host__ __device__ __forceinline__ int perm32(int rho) { const int n = rho >> 4, i = rho & 15; return 8 * (i >> 2) + 4 * n + (i & 3); }

struct Unit { int pm, pn; };
struct Gemm { const bf16* A; const bf16* Bt; int M, N, K; };

struct StaticOrder {
    int nM, nN, nwg, G, c;
    __host__ __device__ void init(int M, int N, int G_, int c_, int bm_rows = BM) { nM = M / bm_rows; nN = N / BM; nwg = nM * nN; G = G_; c = c_; }
    __host__ __device__ bool next(int i, Unit& u) const {
        const long L = (long)i * G + c; if (L >= nwg) return false;
        int wgid = (int)L; { const int q = nwg / NXCD, r = nwg % NXCD, xcd = wgid % NXCD, off = wgid / NXCD; wgid = (xcd < r ? xcd * (q + 1) : r * (q + 1) + (xcd - r) * q) + off; }
        const int nig = WGM * nN, gid = wgid / nig, fm = gid * WGM, gsz = (nM - fm) < WGM ? (nM - fm) : WGM;
        u.pm = fm + ((wgid % nig) % gsz); u.pn = (wgid % nig) / gsz; return true;
    }
};

struct GroupedOrder {
    int nM, nNg, ncg, per, G, c;
    __host__ __device__ void init(int M, int N, int G_, int c_, int ncg_) { nM = M / BM; ncg = ncg_; nNg = (N / BM) / ncg_; per = nM * nNg; G = G_; c = c_; }
    __host__ __device__ bool next(int i, Unit& u) const {
        const long L = (long)i * G + c; if (L >= (long)per * ncg) return false;
        const int grp = (int)(L / per); int wgid = (int)(L % per);
        { const int q = per / NXCD, r = per % NXCD, xcd = wgid % NXCD, off = wgid / NXCD; wgid = (xcd < r ? xcd * (q + 1) : r * (q + 1) + (xcd - r) * q) + off; }
        const int nig = WGM * nNg, gid = wgid / nig, fm = gid * WGM, gsz = (nM - fm) < WGM ? (nM - fm) : WGM;
        u.pm = fm + ((wgid % nig) % gsz); u.pn = grp * nNg + (wgid % nig) / gsz; return true;
    }
};

template <class Epi, class Sched = StaticOrder>
__device__ __forceinline__ void gemm_phase(LAS unsigned char* lds, const Gemm g, const Sched& S, const Epi& E) {
    const int tid = threadIdx.x, wid = __builtin_amdgcn_readfirstlane(tid >> 6), lane = tid & 63, wr = wid >> 2, wc = wid & 3, fr = lane & 15, fq = lane >> 4;
    constexpr int MT = Epi::MT;
    const int K = g.K, nt = K / BK;
    unsigned voffA[2], voffB[2];
#pragma unroll
    for (int i = 0; i < 2; ++i) { int R, C; stage_rc(tid * 16 + i * 8192, R, C); const int Rb = Epi::PERM ? ((R & ~31) + perm32(R & 31)) : R;
        const int Ra = (MT == 3 && R >= 96) ? R - 32 : R;
        voffA[i] = (unsigned)(Ra * K + C) * 2u; voffB[i] = (unsigned)(Rb * K + C) * 2u; }
    const size_t kstep = (size_t)(BK * 2);
    const size_t hstep = (size_t)HALF * K * 2;
    const size_t tstep = 2 * hstep;
    const size_t hstepA = (size_t)(32 * MT) * K * 2;
    const size_t tstepA = 2 * hstepA;
    const unsigned ldsw = (unsigned)wid * 1024u;
    const int aoff = lds_byte(wr * 16 * MT + fr, fq * 8), boff = lds_byte(wc * 32 + fr, fq * 8);
#define PG8_SA(b, h) (((b) * 2 + (h)) * HTB)
#define PG8_SB(b, h) ((4 + (b) * 2 + (h)) * HTB)
#define PG8_STAGE(bufoff, gbase, voff) do { _Pragma("unroll") for (int _i = 0; _i < 2; ++_i) \
        __builtin_amdgcn_global_load_lds((const unsigned*)((const char*)(gbase) + (voff)[_i]), (LAS unsigned*)(lds + (bufoff) + ldsw + _i * 8192), 16, 0, 0); } while (0)
#define PG8_STAGEB(bufoff, gbase, voff) do { _Pragma("unroll") for (int _i = 0; _i < 2; ++_i) \
        __builtin_amdgcn_global_load_lds((const unsigned*)((const char*)(gbase) + (voff)[_i]), (LAS unsigned*)(lds + (bufoff) + ldsw + _i * 8192), 16, 0, Epi::AUXB); } while (0)
#define PG8_LDA(dst, b, h) do { _Pragma("unroll") for (int m = 0; m < MT; ++m) _Pragma("unroll") for (int k = 0; k < 2; ++k) dst[m][k] = *(const LAS bf16x8*)(lds + PG8_SA(b, h) + aoff + m * 2048 + k * 1024); } while (0)
#define PG8_LDB(dst, b, h) do { _Pragma("unroll") for (int n = 0; n < 2; ++n) _Pragma("unroll") for (int k = 0; k < 2; ++k) dst[n][k] = *(const LAS bf16x8*)(lds + PG8_SB(b, h) + boff + n * 2048 + k * 1024); } while (0)
#define PG8_MMA(ai, bj, At, Bt) do { __builtin_amdgcn_s_setprio(1); _Pragma("unroll") for (int m = 0; m < MT; ++m) _Pragma("unroll") for (int n = 0; n < 2; ++n) _Pragma("unroll") for (int k = 0; k < 2; ++k) \
        acc[ai][bj][m][n] = __builtin_amdgcn_mfma_f32_16x16x32_bf16(Bt[n][k], At[m][k], acc[ai][bj][m][n], 0, 0, 0); __builtin_amdgcn_s_setprio(0); } while (0)
#define PG8_WAIT_V(n) asm volatile("s_waitcnt vmcnt(" #n ")" ::: "memory")
#define PG8_WAIT_L(n) asm volatile("s_waitcnt lgkmcnt(" #n ")" ::: "memory")
#define PG8_BAR __builtin_amdgcn_s_barrier()
#define PG8_SCHED __builtin_amdgcn_sched_barrier(0)
    Unit cur, nxt; int ui = 0;
    if (!S.next(0, cur)) return;
    f32x4 acc[2][2][MT][2];
#pragma unroll
    for (int a = 0; a < 2; ++a)
#pragma unroll
        for (int b = 0; b < 2; ++b)
#pragma unroll
            for (int m = 0; m < MT; ++m)
#pragma unroll
                for (int n = 0; n < 2; ++n) acc[a][b][m][n] = (f32x4){0.f, 0.f, 0.f, 0.f};
    bf16x8 At[MT][2], B0[2][2], B1[2][2];
    const char* cA = (const char*)g.A + (size_t)cur.pm * tstepA; const char* cB = (const char*)g.Bt + (size_t)cur.pn * tstep;
    PG8_STAGEB(PG8_SB(0, 0), cB, voffB); PG8_STAGEB(PG8_SB(0, 1), cB + hstep, voffB); PG8_STAGE(PG8_SA(0, 0), cA, voffA); PG8_STAGE(PG8_SA(0, 1), cA + hstepA, voffA);
    if (wr == 1) PG8_BAR;
    PG8_WAIT_V(2); PG8_BAR;
    PG8_STAGEB(PG8_SB(1, 0), cB + kstep, voffB); PG8_STAGE(PG8_SA(1, 0), cA + kstep, voffA); PG8_STAGEB(PG8_SB(1, 1), cB + hstep + kstep, voffB);
    PG8_WAIT_V(6); PG8_BAR;
    for (;;) {
        const bool has_next = S.next(ui + 1, nxt);
        const char* nA = has_next ? (const char*)g.A + (size_t)nxt.pm * tstepA : cA; const char* nB = has_next ? (const char*)g.Bt + (size_t)nxt.pn * tstep : cB;
        for (int t = 0; t < nt; t += 2) {
            const bool last = (t == nt - 2);
            const char* a1 = cA + (size_t)(t + 1) * kstep;
            const char* a2 = last ? nA : cA + (size_t)(t + 2) * kstep; const char* b2 = last ? nB : cB + (size_t)(t + 2) * kstep;
            const char* a3 = a2 + kstep; const char* b3 = b2 + kstep;
            if constexpr (Epi::HAS_MID) { if (t == nt / 2) E.mid(acc, cur, wr, wc, fr, fq); }
            PG8_LDB(B0, 0, 0); PG8_LDB(B1, 0, 1); PG8_SCHED; PG8_LDA(At, 0, 0); PG8_STAGE(PG8_SA(1, 1), a1 + hstepA, voffA);
            PG8_WAIT_V(8); PG8_WAIT_L(0); PG8_BAR; PG8_MMA(0, 0, At, B0); PG8_MMA(0, 1, At, B1); PG8_BAR; PG8_SCHED;
            PG8_LDA(At, 0, 1); PG8_STAGEB(PG8_SB(0, 0), b2, voffB); PG8_STAGEB(PG8_SB(0, 1), b2 + hstep, voffB); PG8_STAGE(PG8_SA(0, 0), a2, voffA);
            PG8_WAIT_V(8); PG8_WAIT_L(0); PG8_BAR; PG8_MMA(1, 0, At, B0); PG8_MMA(1, 1, At, B1); PG8_BAR; PG8_SCHED;
            PG8_LDB(B0, 1, 0); PG8_LDB(B1, 1, 1); PG8_SCHED; PG8_LDA(At, 1, 0); PG8_STAGE(PG8_SA(0, 1), a2 + hstepA, voffA);
            PG8_WAIT_V(8); PG8_WAIT_L(0); PG8_BAR; PG8_MMA(0, 0, At, B0); PG8_MMA(0, 1, At, B1); PG8_BAR; PG8_SCHED;
            PG8_LDA(At, 1, 1); PG8_STAGEB(PG8_SB(1, 0), b3, voffB); PG8_STAGEB(PG8_SB(1, 1), b3 + hstep, voffB); PG8_STAGE(PG8_SA(1, 0), a3, voffA);
            PG8_WAIT_V(8); PG8_WAIT_L(0); PG8_BAR; PG8_MMA(1, 0, At, B0); PG8_MMA(1, 1, At, B1); PG8_BAR; PG8_SCHED;
        }
        if (wr == 0) PG8_BAR;
        E(acc, cur, wr, wc, fr, fq);
        if (!has_next) break;
#pragma unroll
        for (int a = 0; a < 2; ++a)
#pragma unroll
            for (int b = 0; b < 2; ++b)
#pragma unroll
                for (int m = 0; m < MT; ++m)
#pragma unroll
                    for (int n = 0; n < 2; ++n) acc[a][b][m][n] = (f32x4){0.f, 0.f, 0.f, 0.f};
        cur = nxt; cA = nA; cB = nB; ++ui;
        if (wr == 1) PG8_BAR;
    }
    PG8_WAIT_V(0);
    PG8_BAR;
#undef PG8_SA
#undef PG8_SB
#undef PG8_STAGE
#undef PG8_STAGEB
#undef PG8_LDA
#undef PG8_LDB
#undef PG8_MMA
#undef PG8_WAIT_V
#undef PG8_WAIT_L
#undef PG8_BAR
#undef PG8_SCHED
}
}

struct EpiProj {
    static constexpr bool PERM = true, HAS_MID = false; static constexpr int MT = 4, AUXB = 0;
    unsigned char* ws;
    __device__ __forceinline__ void operator()(const f32x4 (&acc)[2][2][4][2], const pg8::Unit& u, int wr, int wc, int fr, int fq) const {
        const int pn = u.pn;
        const int row0 = u.pm * 256 + wr * 64 + fr;
        if (pn == 74) {
            if (wc == 0 && fq < 2) {
                float* R = (float*)(ws + WS_R);
#pragma unroll
                for (int ai = 0; ai < 2; ++ai)
#pragma unroll
                    for (int m = 0; m < 4; ++m) { float* rp = R + (size_t)(row0 + ai * 128 + m * 16) * 16 + 8 * fq;
                        *(f32x4*)(rp) = acc[ai][0][m][0]; *(f32x4*)(rp + 4) = acc[ai][0][m][1]; }
            }
            return;
        }
        size_t boff; int ldc, ct, act;
        if (pn < 8)       { boff = WS_QA;  ldc = 2048; ct = pn;      act = 0; }
        else if (pn == 8) { boff = WS_KA;  ldc = 256;  ct = 0;       act = 0; }
        else if (pn == 9) { boff = WS_VA;  ldc = 256;  ct = 0;       act = 0; }
        else if (pn < 18) { boff = WS_ZA;  ldc = 2048; ct = pn - 10; act = 1; }
        else if (pn < 22) { boff = WS_QB;  ldc = 1024; ct = pn - 18; act = 0; }
        else if (pn < 26) { boff = WS_KB;  ldc = 1024; ct = pn - 22; act = 0; }
        else if (pn < 34) { boff = WS_VB;  ldc = 2048; ct = pn - 26; act = 0; }
        else if (pn < 42) { boff = WS_ZB;  ldc = 2048; ct = pn - 34; act = 1; }
        else if (pn < 58) { boff = WS_SGA; ldc = 4096; ct = pn - 42; act = 2; }
        else              { boff = WS_SGB; ldc = 4096; ct = pn - 58; act = 2; }
        bf16* base = (bf16*)(ws + boff);
        const int col0 = ct * 256 + wc * 32 + 8 * fq;
#pragma unroll
        for (int ai = 0; ai < 2; ++ai)
#pragma unroll
            for (int m = 0; m < 4; ++m) { bf16* rowp = base + (size_t)(row0 + ai * 128 + m * 16) * ldc + col0;
#pragma unroll
                for (int bj = 0; bj < 2; ++bj) { f32x4 v0 = acc[ai][bj][m][0], v1 = acc[ai][bj][m][1];
                    if (act != 0) {
#pragma unroll
                        for (int j = 0; j < 4; ++j) { const float s0 = sigmoidf_(v0[j]), s1 = sigmoidf_(v1[j]); v0[j] = (act == 1) ? v0[j] * s0 : s0; v1[j] = (act == 1) ? v1[j] * s1 : s1; }
                    }
                    v4u w; w.x = pk2(v0[0], v0[1]); w.y = pk2(v0[2], v0[3]); w.z = pk2(v1[0], v1[1]); w.w = pk2(v1[2], v1[3]);
                    __builtin_nontemporal_store(w, (v4u*)(rowp + bj * 128)); } }
    }
};
struct EpiMerge {
    static constexpr bool PERM = true, HAS_MID = true; static constexpr int MT = 3, AUXB = 0;
    const bf16* sga; const bf16* sgb; bf16* out;
    __device__ __forceinline__ void mid(f32x4 (&acc)[2][2][MT][2], const pg8::Unit& u, int wr, int wc, int fr, int fq) const {
        int row0 = u.pm * (64 * MT) + wr * (16 * MT) + fr, col0 = u.pn * 256 + wc * 32 + 8 * fq;
        asm volatile("" : "+v"(row0), "+v"(col0));
#pragma unroll
        for (int ai = 0; ai < 2; ++ai)
#pragma unroll
            for (int m = 0; m < MT; ++m) { const size_t off = (size_t)(row0 + ai * (32 * MT) + m * 16) * DM + col0;
#pragma unroll
                for (int bj = 0; bj < 2; ++bj) { const v4u a = *(const v4u*)(sga + off + bj * 128), b = *(const v4u*)(sgb + off + bj * 128);
                    f32x4 r0, r1;
                    r0[0] = bflo(a.x) * __builtin_amdgcn_rcpf(bflo(b.x)); r0[1] = bfhi(a.x) * __builtin_amdgcn_rcpf(bfhi(b.x));
                    r0[2] = bflo(a.y) * __builtin_amdgcn_rcpf(bflo(b.y)); r0[3] = bfhi(a.y) * __builtin_amdgcn_rcpf(bfhi(b.y));
                    r1[0] = bflo(a.z) * __builtin_amdgcn_rcpf(bflo(b.z)); r1[1] = bfhi(a.z) * __builtin_amdgcn_rcpf(bfhi(b.z));
                    r1[2] = bflo(a.w) * __builtin_amdgcn_rcpf(bflo(b.w)); r1[3] = bfhi(a.w) * __builtin_amdgcn_rcpf(bfhi(b.w));
                    acc[ai][bj][m][0] *= r0; acc[ai][bj][m][1] *= r1;
                    asm volatile("" ::: "memory"); } }
    }
    __device__ __forceinline__ void operator()(const f32x4 (&acc)[2][2][MT][2], const pg8::Unit& u, int wr, int wc, int fr, int fq) const {
        const int row0 = u.pm * (64 * MT) + wr * (16 * MT) + fr, col0 = u.pn * 256 + wc * 32 + 8 * fq;
#pragma unroll
        for (int ai = 0; ai < 2; ++ai)
#pragma unroll
            for (int m = 0; m < MT; ++m) { const size_t off = (size_t)(row0 + ai * (32 * MT) + m * 16) * DM + col0;
#pragma unroll
                for (int bj = 0; bj < 2; ++bj) { const v4u b = *(const v4u*)(sgb + off + bj * 128);
                    const f32x4 v0 = acc[ai][bj][m][0], v1 = acc[ai][bj][m][1];
                    v4u w; w.x = pk2(v0[0] * bflo(b.x), v0[1] * bfhi(b.x)); w.y = pk2(v0[2] * bflo(b.y), v0[3] * bfhi(b.y));
                    w.z = pk2(v1[0] * bflo(b.z), v1[1] * bfhi(b.z)); w.w = pk2(v1[2] * bflo(b.w), v1[3] * bfhi(b.w));
                    *(v4u*)(out + off + bj * 128) = w; } }
    }
};
struct EpiOut {
    static constexpr bool PERM = false, HAS_MID = false; static constexpr int MT = 3, AUXB = 0;
    const float* xp; const float* xs; const float* mod; bf16* y; float* ssq;
    __device__ __forceinline__ void operator()(const f32x4 (&acc)[2][2][MT][2], const pg8::Unit& u, int wr, int wc, int fr, int fq) const {
        const int col0 = u.pn * 256 + wc * 32 + 4 * fq;
#pragma unroll
        for (int ai = 0; ai < 2; ++ai)
#pragma unroll
            for (int m = 0; m < MT; ++m) { const int row = u.pm * (64 * MT) + ai * (32 * MT) + wr * (16 * MT) + m * 16 + fr;
                const float* xr = (row < NPR) ? xp + (size_t)row * DM : xs + (size_t)(row - NPR) * DM;
                const int seq = (row < NPR) ? (row >> 12) : 2 + ((row - NPR) >> 3);
                const float* gp = mod + (size_t)seq * 12288 + 8192;
                float s = 0.f;
#pragma unroll
                for (int bj = 0; bj < 2; ++bj)
#pragma unroll
                    for (int n = 0; n < 2; ++n) { const int c = col0 + bj * 128 + n * 16;
                        const f32x4 xv = *(const f32x4*)(xr + c), gv = *(const f32x4*)(gp + c);
                        const f32x4 o = xv + gv * acc[ai][bj][m][n];
                        v2u w; w.x = pk2(o[0], o[1]); w.y = pk2(o[2], o[3]);
                        *(v2u*)(y + (size_t)row * DM + c) = w;
                        s += (o[0] * o[0] + o[1] * o[1]) + (o[2] * o[2] + o[3] * o[3]); }
                s += __shfl_xor(s, 16); s += __shfl_xor(s, 32);
                if (fq == 0) ssq[(size_t)row * 64 + u.pn * 4 + wc] = s;
            }
    }
};

struct Args { const float* in[19]; float* out; unsigned char* ws; int ph_lo, ph_hi; };
#define FIN(k) (A.in[k])
struct Frame {
    LAS unsigned char* lds;
    int tid, lane, wave, blk, G;
    float* out; unsigned char* ws;
};

template <bool NTS>
__device__ __forceinline__ void p0_transpose_item(const float* W, int ldw, int k0, int n_src0, bf16* WT, int ldt, int drow0, int koff, LAS float* scr, int lane) {
    f32x4 v[16];
    const float* wp = W + (size_t)(k0 + (lane >> 4)) * ldw + n_src0 + (lane & 15) * 4;
#pragma unroll
    for (int i = 0; i < 16; ++i) v[i] = __builtin_nontemporal_load((const f32x4*)(wp + (size_t)(4 * i) * ldw));
#pragma unroll
    for (int i = 0; i < 16; ++i) { LAS float* s = scr + (4 * i + (lane >> 4)) * 65 + (lane & 15) * 4; s[0] = v[i][0]; s[1] = v[i][1]; s[2] = v[i][2]; s[3] = v[i][3]; }
    LDS_WAIT(); asm volatile("" ::: "memory");
    const int c = lane & 7;
#pragma unroll
    for (int j = 0; j < 8; ++j) { const int n = (lane >> 3) + 8 * j; const LAS float* s = scr + (8 * c) * 65 + n;
        v4u o; o.x = pk2(s[0 * 65], s[1 * 65]); o.y = pk2(s[2 * 65], s[3 * 65]); o.z = pk2(s[4 * 65], s[5 * 65]); o.w = pk2(s[6 * 65], s[7 * 65]);
        if (NTS) __builtin_nontemporal_store(o, (v4u*)(WT + (size_t)(drow0 + n) * ldt + koff + k0 + 8 * c)); else *(v4u*)(WT + (size_t)(drow0 + n) * ldt + koff + k0 + 8 * c) = o; }
    LDS_WAIT(); asm volatile("" ::: "memory");
}
__device__ __forceinline__ void phase0(Frame& F, const Args& A) {
    const size_t gt = (size_t)F.blk * 512 + F.tid, NT = (size_t)F.G * 512;
    bf16* CS = (bf16*)(F.ws + WS_CS); const float* cp = FIN(5); const float* cs = FIN(6);
    for (size_t i = gt; i < (size_t)160 * DM / 4; i += NT) { const int row = (int)(i >> 10), c4 = (int)(i & 1023) * 4;
        f32x4 v = {0.f, 0.f, 0.f, 0.f};
        if (row < 2) v = *(const f32x4*)(cp + (size_t)row * DM + c4); else if (row < NMOD) v = *(const f32x4*)(cs + (size_t)(row - 2) * DM + c4);
        v2u o; o.x = pk2(v[0] * sigmoidf_(v[0]), v[1] * sigmoidf_(v[1])); o.y = pk2(v[2] * sigmoidf_(v[2]), v[3] * sigmoidf_(v[3]));
        *(v2u*)(CS + (size_t)row * DM + c4) = o; }
    { f32x4* z = (f32x4*)(F.ws + WS_MOD); const f32x4 zero = {0.f, 0.f, 0.f, 0.f}; for (size_t i = gt; i < (size_t)NMOD * 12288 / 4; i += NT) z[i] = zero; }
}
__device__ __forceinline__ void p1_modgemm(Frame& F, const Args& A) {
    const float* w_ada = FIN(7); const float* b_ada = FIN(8);
    const bf16* CS = (const bf16*)(F.ws + WS_CS); float* MOD = (float*)(F.ws + WS_MOD);
    const int kq = F.blk & 3, j = F.lane & 31, hh = F.lane >> 5;
    const int n0 = (F.blk >> 2) * 256 + F.wave * 32;
    f32x16 acc[5];
#pragma unroll
    for (int mt = 0; mt < 5; ++mt)
#pragma unroll
        for (int r = 0; r < 16; ++r) acc[mt][r] = 0.f;
    const float* wp = w_ada + (size_t)(kq * 1024 + 8 * hh) * 12288 + n0 + j;
    const bf16* ap = CS + (size_t)j * DM + kq * 1024 + 8 * hh;
    float bn[32];
#pragma unroll
    for (int e = 0; e < 32; ++e) bn[e] = __builtin_nontemporal_load(wp + (size_t)((e >> 3) * 16 + (e & 7)) * 12288);
#pragma unroll 1
    for (int g4 = 0; g4 < 16; ++g4) {
        float bc[32];
#pragma unroll
        for (int e = 0; e < 32; ++e) bc[e] = bn[e];
        { const int gn = (g4 < 15) ? g4 + 1 : g4; const float* wq = wp + (size_t)(gn * 64) * 12288;
#pragma unroll
          for (int e = 0; e < 32; ++e) bn[e] = __builtin_nontemporal_load(wq + (size_t)((e >> 3) * 16 + (e & 7)) * 12288); }
#pragma unroll
        for (int s4 = 0; s4 < 4; ++s4) { const int ks = g4 * 4 + s4;
            v4u bw; bw.x = pk2(bc[8 * s4], bc[8 * s4 + 1]); bw.y = pk2(bc[8 * s4 + 2], bc[8 * s4 + 3]); bw.z = pk2(bc[8 * s4 + 4], bc[8 * s4 + 5]); bw.w = pk2(bc[8 * s4 + 6], bc[8 * s4 + 7]);
            const bf16x8 bf = __builtin_bit_cast(bf16x8, bw);
#pragma unroll
            for (int mt = 0; mt < 5; ++mt) { const bf16x8 af = *(const bf16x8*)(ap + (size_t)mt * 32 * DM + ks * 16);
                acc[mt] = __builtin_amdgcn_mfma_f32_32x32x16_bf16(af, bf, acc[mt], 0, 0, 0); }
            asm volatile("" ::: "memory"); }
    }
    { const float bias = (kq == 0) ? b_ada[n0 + j] : 0.f;
#pragma unroll
      for (int mt = 0; mt < 5; ++mt)
#pragma unroll
          for (int r = 0; r < 16; ++r) { const int row = 32 * mt + (r & 3) + 8 * (r >> 2) + 4 * hh;
              if (row < NMOD) atomicAdd(MOD + (size_t)row * 12288 + n0 + j, acc[mt][r] + bias); } }
}
constexpr int CW_TRN = 1024, CW_TRN2 = 1088;
template <int WHICH>
__device__ __forceinline__ void transpose_queue(Frame& F, const Args& A, unsigned* ctr) {
    LAS float* scr = (LAS float*)(F.lds + F.wave * 16896);
    const float* w_in = FIN(10); const float* w_pa = FIN(15); const float* w_pb = FIN(16); const float* w_out = FIN(17);
    bf16* WB1 = (bf16*)(F.ws + WS_WB1); bf16* WB2 = (bf16*)(F.ws + WS_WB2); bf16* WB3 = (bf16*)(F.ws + WS_WB3);
    constexpr int I1 = 64 * 168, I2 = 64 * 128, IA = 32 * 64, IB = 32 * 64, IO = 64 * 64;
    constexpr int NITEMS = WHICH == 0 ? (I1 + I2) : (IA + IB + IO);
    volatile LAS unsigned* MISC = (volatile LAS unsigned*)(F.lds + MISC_OFF);
    for (;;) {
        __syncthreads();
        if (F.tid == 0) MISC[17] = __hip_atomic_fetch_add(ctr, 32u, __ATOMIC_RELAXED, __HIP_MEMORY_SCOPE_AGENT);
        __syncthreads();
        const int base = __builtin_amdgcn_readfirstlane((int)MISC[17]);
        if (base >= NITEMS) break;
#pragma unroll 1
        for (int i4 = 0; i4 < 4; ++i4) { const int it = base + i4 * 8 + F.wave; if (it >= NITEMS) break;
            int r = it;
            if (WHICH == 0) {
                if (r < I1) { const int kb = r / 168, nb = r % 168; p0_transpose_item<false>(w_in, PROJ, 64 * kb, 64 * nb, WB1, DM, 64 * nb, 0, scr, F.lane); continue; } r -= I1;
                { const int kb = r / 128, nb = r % 128; p0_transpose_item<false>(w_in, PROJ, 64 * kb, 10768 + 64 * nb, WB1, DM, 10752 + 64 * nb, 0, scr, F.lane); }
            } else {
                if (r < IA) { const int kb = r / 64, nb = r % 64; p0_transpose_item<true>(w_pa, DM, 64 * kb, 64 * nb, WB2, DM, 64 * nb, 0, scr, F.lane); continue; } r -= IA;
                if (r < IB) { const int kb = r / 64, nb = r % 64; p0_transpose_item<true>(w_pb, DM, 64 * kb, 64 * nb, WB2, DM, 64 * nb, 2048, scr, F.lane); continue; } r -= IB;
                { const int kb = r / 64, nb = r % 64; p0_transpose_item<true>(w_out, DM, 64 * kb, 64 * nb, WB3, DM, 64 * nb, 0, scr, F.lane); }
            }
        }
    }
}
__device__ __forceinline__ void phase1(Frame& F, const Args& A, unsigned* ctl) {
    if (F.blk < 192) p1_modgemm(F, A);
    transpose_queue<0>(F, A, ctl + CW_TRN);
    const float* w_in = FIN(10); bf16* WB1 = (bf16*)(F.ws + WS_WB1);
    const size_t gt = (size_t)F.blk * 512 + F.tid, NT = (size_t)F.G * 512;
    for (size_t i = gt; i < (size_t)16 * DM; i += NT) { const int k = (int)(i >> 4), j = (int)(i & 15); WB1[(size_t)(18944 + j) * DM + k] = f2bf(w_in[(size_t)k * PROJ + 10752 + j]); }
    { v4u* z = (v4u*)(WB1 + (size_t)18960 * DM); const v4u zero = {0u, 0u, 0u, 0u}; for (size_t i = gt; i < (size_t)240 * DM * 2 / 16; i += NT) z[i] = zero; }
}

__device__ __forceinline__ const float* xrow_ptr(const float* xp, const float* xs, int row) { return (row < NPR) ? xp + (size_t)row * DM : xs + (size_t)(row - NPR) * DM; }
__device__ __forceinline__ void phase2(Frame& F, const Args& A) {
    const float* xp = FIN(0); const float* xs = FIN(1); const float* ng = FIN(9);
    const float* MOD = (const float*)(F.ws + WS_MOD); bf16* H = (bf16*)(F.ws + WS_H);
    const int gw = F.blk * NWAVES + F.wave, NGW = F.G * NWAVES;
    if (gw >= NROW) return;
    f32x4 v[16], vn[16];
    { const float* xr = xrow_ptr(xp, xs, gw) + 4 * F.lane;
#pragma unroll
      for (int q = 0; q < 16; ++q) v[q] = __builtin_nontemporal_load((const f32x4*)(xr + 256 * q)); }
#pragma unroll 1
    for (int row = gw; row < NROW; row += NGW) {
        { const int rn = (row + NGW < NROW) ? row + NGW : row; const float* xr = xrow_ptr(xp, xs, rn) + 4 * F.lane;
#pragma unroll
          for (int q = 0; q < 16; ++q) vn[q] = __builtin_nontemporal_load((const f32x4*)(xr + 256 * q)); }
        const int seq = (row < NPR) ? (row >> 12) : 2 + ((row - NPR) >> 3);
        const float* sh = MOD + (size_t)seq * 12288; const float* sc = sh + 4096;
        float s = 0.f;
#pragma unroll
        for (int q = 0; q < 16; ++q) s += (v[q][0] * v[q][0] + v[q][1] * v[q][1]) + (v[q][2] * v[q][2] + v[q][3] * v[q][3]);
        const float rstd = rsqrtf(wave_sum(s) * (1.0f / DM) + EPS);
#pragma unroll
        for (int q = 0; q < 16; ++q) { const int c = 4 * (F.lane + 64 * q);
            const f32x4 g = *(const f32x4*)(ng + c), a = *(const f32x4*)(sc + c), b = *(const f32x4*)(sh + c);
            const f32x4 h = (v[q] * rstd * g) * (a + 1.0f) + b;
            v2u o; o.x = pk2(h[0], h[1]); o.y = pk2(h[2], h[3]);
            *(v2u*)(H + (size_t)row * DM + c) = o;
            if ((q & 3) == 3) asm volatile("" ::: "memory"); }
#pragma unroll
        for (int q = 0; q < 16; ++q) v[q] = vn[q];
    }
}

#define MFMA16(a, b, c) __builtin_amdgcn_mfma_f32_16x16x32_bf16((a), (b), (c), 0, 0, 0)

constexpr int SWA_VS = 280;
__device__ __forceinline__ void swa_prompt_unit(Frame& F, const Args& A, int unit) {
    const int b = unit >> 7, i = (unit >> 2) & 31, g = unit & 3;
    const bf16* QA = (const bf16*)(F.ws + WS_QA); const bf16* KA = (const bf16*)(F.ws + WS_KA); const bf16* VA = (const bf16*)(F.ws + WS_VA);
    const bf16* ZA = (const bf16*)(F.ws + WS_ZA); bf16* AB = (bf16*)(F.ws + WS_AB);
    LAS unsigned char* Ks = F.lds;
    LAS bf16* VTs = (LAS bf16*)(F.lds + 36864);
    __syncthreads();
#pragma unroll
    for (int q = 0; q < 4; ++q) { const int p = F.tid + 512 * q, row = p >> 3, c = p & 7; const int tok = (i - 1) * 128 + row;
        v4u kv = {0u, 0u, 0u, 0u}, vv = {0u, 0u, 0u, 0u};
        if (tok >= 0) { const size_t off = (size_t)(b * SEQ + tok) * 256 + g * 64 + c * 8; kv = *(const v4u*)(KA + off); vv = *(const v4u*)(VA + off); }
        *(LAS v4u*)(Ks + row * 144 + c * 16) = kv;
        LAS bf16* vt = VTs + (c * 8) * SWA_VS + row;
        vt[0 * SWA_VS] = (bf16)(vv.x & 0xffff); vt[1 * SWA_VS] = (bf16)(vv.x >> 16); vt[2 * SWA_VS] = (bf16)(vv.y & 0xffff); vt[3 * SWA_VS] = (bf16)(vv.y >> 16);
        vt[4 * SWA_VS] = (bf16)(vv.z & 0xffff); vt[5 * SWA_VS] = (bf16)(vv.z >> 16); vt[6 * SWA_VS] = (bf16)(vv.w & 0xffff); vt[7 * SWA_VS] = (bf16)(vv.w >> 16); }
    if (F.tid < 192) { const int d = F.tid / 3, q = F.tid % 3; *(LAS v4u*)(VTs + d * SWA_VS + 256 + 8 * q) = (v4u){0u, 0u, 0u, 0u}; }
    __syncthreads();
    const int hq = g * 8 + F.wave, c = F.lane & 15, gg = F.lane >> 4;
    const float sink = FIN(11)[hq];
    const size_t qbase = (size_t)b * SEQ + i * 128;
    bf16x8 bq[2], bqn[2];
#pragma unroll
    for (int ks = 0; ks < 2; ++ks) bq[ks] = *(const bf16x8*)(QA + (qbase + c) * 2048 + hq * 64 + ks * 32 + 8 * gg);
#pragma unroll 1
    for (int sub = 0; sub < 8; ++sub) {
        const size_t qrow = qbase + sub * 16 + c;
        { const int sn = (sub < 7) ? sub + 1 : sub;
#pragma unroll
          for (int ks = 0; ks < 2; ++ks) bqn[ks] = *(const bf16x8*)(QA + (qbase + sn * 16 + c) * 2048 + hq * 64 + ks * 32 + 8 * gg); }
        v2u zaw[4];
#pragma unroll
        for (int nt = 0; nt < 4; ++nt) zaw[nt] = *(const v2u*)(ZA + qrow * 2048 + hq * 64 + 16 * nt + 4 * gg);
        f32x4 s[10];
        const LAS unsigned char* kp = Ks + (16 * sub + c) * 144 + 16 * gg;
#pragma unroll
        for (int x = 0; x < 9; ++x) { f32x4 a = {0.f, 0.f, 0.f, 0.f};
#pragma unroll
            for (int ks = 0; ks < 2; ++ks) { const bf16x8 ak = *(const LAS bf16x8*)(kp + x * 16 * 144 + ks * 64); a = MFMA16(ak, bq[ks], a); }
            s[x] = a; if ((x & 3) == 3) asm volatile("" ::: "memory"); }
        s[9] = (f32x4){0.f, 0.f, 0.f, 0.f};
        float m = sink;
#pragma unroll
        for (int x = 0; x < 9; ++x) { const bool tile_ok = (i > 0) || (sub + x >= 8);
#pragma unroll
            for (int r = 0; r < 4; ++r) { bool valid = tile_ok; if (x == 0) valid = valid && (4 * gg + r >= c); if (x == 8) valid = valid && (4 * gg + r <= c);
                const float v = valid ? s[x][r] * 0.125f : -1e30f; s[x][r] = v; m = fmaxf(m, v); } }
        m = fmaxf(m, __shfl_xor(m, 16)); m = fmaxf(m, __shfl_xor(m, 32));
        float sum = 0.f;
#pragma unroll
        for (int x = 0; x < 9; ++x)
#pragma unroll
            for (int r = 0; r < 4; ++r) { const float p = (s[x][r] > -1e29f) ? __expf(s[x][r] - m) : 0.f; s[x][r] = p; sum += p; }
        sum += __shfl_xor(sum, 16); sum += __shfl_xor(sum, 32);
        const float inv = 1.0f / (sum + __expf(sink - m));
        f32x4 o[4];
#pragma unroll
        for (int nt = 0; nt < 4; ++nt) o[nt] = (f32x4){0.f, 0.f, 0.f, 0.f};
        const LAS bf16* vbase = VTs + c * SWA_VS + 16 * sub + 4 * gg;
#pragma unroll
        for (int jp = 0; jp < 5; ++jp) { v4u pw; pw.x = pk2(s[2 * jp][0], s[2 * jp][1]); pw.y = pk2(s[2 * jp][2], s[2 * jp][3]); pw.z = pk2(s[2 * jp + 1][0], s[2 * jp + 1][1]); pw.w = pk2(s[2 * jp + 1][2], s[2 * jp + 1][3]);
            const bf16x8 pb = __builtin_bit_cast(bf16x8, pw);
#pragma unroll
            for (int nt = 0; nt < 4; ++nt) { const LAS bf16* vp = vbase + 16 * nt * SWA_VS + 32 * jp;
                const v2u v0 = *(const LAS v2u*)(vp), v1 = *(const LAS v2u*)(vp + 16);
                v4u vw; vw.x = v0.x; vw.y = v0.y; vw.z = v1.x; vw.w = v1.y;
                o[nt] = MFMA16(__builtin_bit_cast(bf16x8, vw), pb, o[nt]); }
            asm volatile("" ::: "memory"); }
#pragma unroll
        for (int nt = 0; nt < 4; ++nt) { v2u w; w.x = pk2(o[nt][0] * inv * bflo(zaw[nt].x), o[nt][1] * inv * bfhi(zaw[nt].x)); w.y = pk2(o[nt][2] * inv * bflo(zaw[nt].y), o[nt][3] * inv * bfhi(zaw[nt].y));
            *(v2u*)(AB + qrow * DM + hq * 64 + 16 * nt + 4 * gg) = w; }
        bq[0] = bqn[0]; bq[1] = bqn[1];
    }
}

__device__ __forceinline__ void swa_sample_unit(Frame& F, const Args& A, int unit) {
    const int n = unit >> 2, g = unit & 3;
    const bf16* QA = (const bf16*)(F.ws + WS_QA); const bf16* KA = (const bf16*)(F.ws + WS_KA); const bf16* VA = (const bf16*)(F.ws + WS_VA);
    const bf16* ZA = (const bf16*)(F.ws + WS_ZA); bf16* AB = (bf16*)(F.ws + WS_AB);
    const float* ck = FIN(2); const float* cv = FIN(3);
    LAS unsigned char* Ks = F.lds;
    LAS bf16* VTs = (LAS bf16*)(F.lds + 23040);
    const int hq = g * 8 + F.wave, c = F.lane & 15, gg = F.lane >> 4, tq = c & 7;
    const size_t qrow0 = (size_t)NPR + n * 8;
    bf16x8 bq[2]; v2u zaw[4];
#pragma unroll
    for (int ks = 0; ks < 2; ++ks) bq[ks] = *(const bf16x8*)(QA + (qrow0 + tq) * 2048 + hq * 64 + ks * 32 + 8 * gg);
#pragma unroll
    for (int nt = 0; nt < 4; ++nt) zaw[nt] = *(const v2u*)(ZA + (qrow0 + tq) * 2048 + hq * 64 + 16 * nt + 4 * gg);
    __syncthreads();
#pragma unroll
    for (int q = 0; q < 4; ++q) { const int p = F.tid + 512 * q, row = p >> 4, c4 = p & 15;
        const size_t off = ((size_t)(n * 128 + row) * 4 + g) * 64 + c4 * 4;
        const f32x4 kv = *(const f32x4*)(ck + off), vv = *(const f32x4*)(cv + off);
        v2u kw; kw.x = pk2(kv[0], kv[1]); kw.y = pk2(kv[2], kv[3]);
        *(LAS v2u*)(Ks + row * 144 + c4 * 8) = kw;
        LAS bf16* vt = VTs + (c4 * 4) * 168 + row;
        vt[0] = f2bf(vv[0]); vt[168] = f2bf(vv[1]); vt[336] = f2bf(vv[2]); vt[504] = f2bf(vv[3]);
        if (row >= 8) { const size_t oo = ((size_t)(n * 128 + row - 8) * 4 + g) * 64 + c4 * 4; *(f32x4*)(F.out + OUT_KWS + oo) = kv; *(f32x4*)(F.out + OUT_VWS + oo) = vv; } }
    if (F.tid < 256) { const int row = 128 + (F.tid >> 3), c = F.tid & 7;
        v4u kv = {0u, 0u, 0u, 0u}, vv = {0u, 0u, 0u, 0u};
        if (row < 136) { const size_t off = (size_t)(NPR + n * 8 + row - 128) * 256 + g * 64 + c * 8; kv = *(const v4u*)(KA + off); vv = *(const v4u*)(VA + off);
            const size_t oo = ((size_t)(n * 128 + row - 8) * 4 + g) * 64 + c * 8;
            *(f32x4*)(F.out + OUT_KWS + oo) = (f32x4){bflo(kv.x), bfhi(kv.x), bflo(kv.y), bfhi(kv.y)}; *(f32x4*)(F.out + OUT_KWS + oo + 4) = (f32x4){bflo(kv.z), bfhi(kv.z), bflo(kv.w), bfhi(kv.w)};
            *(f32x4*)(F.out + OUT_VWS + oo) = (f32x4){bflo(vv.x), bfhi(vv.x), bflo(vv.y), bfhi(vv.y)}; *(f32x4*)(F.out + OUT_VWS + oo + 4) = (f32x4){bflo(vv.z), bfhi(vv.z), bflo(vv.w), bfhi(vv.w)}; }
        *(LAS v4u*)(Ks + row * 144 + c * 16) = kv;
        LAS bf16* vt = VTs + (c * 8) * 168 + row;
        vt[0 * 168] = (bf16)(vv.x & 0xffff); vt[1 * 168] = (bf16)(vv.x >> 16); vt[2 * 168] = (bf16)(vv.y & 0xffff); vt[3 * 168] = (bf16)(vv.y >> 16);
        vt[4 * 168] = (bf16)(vv.z & 0xffff); vt[5 * 168] = (bf16)(vv.z >> 16); vt[6 * 168] = (bf16)(vv.w & 0xffff); vt[7 * 168] = (bf16)(vv.w >> 16); }
    __syncthreads();
    const float sink = FIN(11)[hq];
    f32x4 s[10];
#pragma unroll
    for (int kt = 0; kt < 10; ++kt) { f32x4 a = {0.f, 0.f, 0.f, 0.f};
#pragma unroll
        for (int ks = 0; ks < 2; ++ks) { const bf16x8 ak = *(const LAS bf16x8*)(Ks + (16 * kt + c) * 144 + (ks * 32 + 8 * gg) * 2); a = MFMA16(ak, bq[ks], a); }
        s[kt] = a; if ((kt & 3) == 3) asm volatile("" ::: "memory"); }
    float m = sink;
#pragma unroll
    for (int kt = 0; kt < 10; ++kt)
#pragma unroll
        for (int r = 0; r < 4; ++r) { const int kk = 16 * kt + 4 * gg + r; const bool valid = (kk >= tq) && (kk <= tq + 128) && (kk < 136);
            const float v = valid ? s[kt][r] * 0.125f : -1e30f; s[kt][r] = v; m = fmaxf(m, v); }
    m = fmaxf(m, __shfl_xor(m, 16)); m = fmaxf(m, __shfl_xor(m, 32));
    float sum = 0.f;
#pragma unroll
    for (int kt = 0; kt < 10; ++kt)
#pragma unroll
        for (int r = 0; r < 4; ++r) { const float p = (s[kt][r] > -1e29f) ? __expf(s[kt][r] - m) : 0.f; s[kt][r] = p; sum += p; }
    sum += __shfl_xor(sum, 16); sum += __shfl_xor(sum, 32);
    const float inv = 1.0f / (sum + __expf(sink - m));
    f32x4 o[4];
#pragma unroll
    for (int nt = 0; nt < 4; ++nt) o[nt] = (f32x4){0.f, 0.f, 0.f, 0.f};
#pragma unroll
    for (int j = 0; j < 5; ++j) { v4u pw; pw.x = pk2(s[2 * j][0], s[2 * j][1]); pw.y = pk2(s[2 * j][2], s[2 * j][3]); pw.z = pk2(s[2 * j + 1][0], s[2 * j + 1][1]); pw.w = pk2(s[2 * j + 1][2], s[2 * j + 1][3]);
        const bf16x8 pa = __builtin_bit_cast(bf16x8, pw);
#pragma unroll
        for (int nt = 0; nt < 4; ++nt) { const LAS bf16* vp = VTs + (16 * nt + c) * 168 + 32 * j + 4 * gg;
            const v2u v0 = *(const LAS v2u*)(vp), v1 = *(const LAS v2u*)(vp + 16);
            v4u vw; vw.x = v0.x; vw.y = v0.y; vw.z = v1.x; vw.w = v1.y;
            o[nt] = MFMA16(__builtin_bit_cast(bf16x8, vw), pa, o[nt]); }
        asm volatile("" ::: "memory"); }
    if (c < 8) {
#pragma unroll
        for (int nt = 0; nt < 4; ++nt) { v2u w; w.x = pk2(o[nt][0] * inv * bflo(zaw[nt].x), o[nt][1] * inv * bfhi(zaw[nt].x)); w.y = pk2(o[nt][2] * inv * bflo(zaw[nt].y), o[nt][3] * inv * bfhi(zaw[nt].y));
            *(v2u*)(AB + (qrow0 + c) * DM + hq * 64 + 16 * nt + 4 * gg) = w; } }
}

__device__ __forceinline__ float log_sigmoid_(float x) { return fminf(x, 0.f) - __logf(1.0f + __expf(-fabsf(x))); }

__device__ __forceinline__ void gla_prep_unit(Frame& F, const Args& A, int unit) {
    const int n = unit >> 8, h = (unit >> 6) & 3, ch = unit & 63;
    const size_t row0 = (size_t)n * SEQ + ch * 64;
    const bf16* QB = (const bf16*)(F.ws + WS_QB); const bf16* KB = (const bf16*)(F.ws + WS_KB); const bf16* VB = (const bf16*)(F.ws + WS_VB);
    const float* R = (const float*)(F.ws + WS_R); const float* w2 = FIN(12); const float* ba = FIN(13);
    bf16* QT = (bf16*)(F.ws + WS_QT) + (size_t)unit * 64 * 256; bf16* KDT = (bf16*)(F.ws + WS_KDT) + (size_t)unit * 256 * 64;
    bf16* ATT = (bf16*)(F.ws + WS_ATT) + (size_t)unit * 64 * 64; bf16* VT = (bf16*)(F.ws + WS_VT) + (size_t)unit * 512 * 64; float* DEC = (float*)(F.ws + WS_DEC) + (size_t)unit * 256;
    LAS float* Rs = (LAS float*)F.lds;
    LAS float* TOT = (LAS float*)(F.lds + 4096);
    LAS unsigned char* Vs = F.lds + 8192;
    LAS bf16* QS = (LAS bf16*)(F.lds + 8192);
    LAS bf16* KS = (LAS bf16*)(F.lds + 8192 + 33792);
    LAS float* BS = (LAS float*)(F.lds + 8192 + 67584);
    int tz = F.tid; asm volatile("" : "+v"(tz));
    v4u vreg[8], qreg[4], kreg[4]; f32x4 rreg = {0.f, 0.f, 0.f, 0.f};
#pragma unroll
    for (int q = 0; q < 8; ++q) { const int p = tz + 512 * q, row = p >> 6, c = p & 63; vreg[q] = *(const v4u*)(VB + (row0 + row) * 2048 + h * 512 + c * 8); }
#pragma unroll
    for (int q = 0; q < 4; ++q) { const int p = tz + 512 * q, row = p >> 5, c = p & 31; const size_t off = (row0 + row) * 1024 + h * 256 + c * 8; qreg[q] = *(const v4u*)(QB + off); kreg[q] = *(const v4u*)(KB + off); }
    if (tz < 256) rreg = *(const f32x4*)(R + row0 * 16 + tz * 4);
    __syncthreads();
    if (tz < 256) *(LAS f32x4*)(Rs + tz * 4) = rreg;
#pragma unroll
    for (int q = 0; q < 8; ++q) { const int p = tz + 512 * q, row = p >> 6, c = p & 63; *(LAS v4u*)(Vs + row * 1040 + c * 16) = vreg[q]; }
    __syncthreads();
    { const LAS bf16* vcol = (const LAS bf16*)Vs + tz;
#pragma unroll
      for (int t8 = 0; t8 < 8; ++t8) { unsigned e[8];
#pragma unroll
          for (int k = 0; k < 8; ++k) e[k] = vcol[(t8 * 8 + k) * 520];
          v4u o; o.x = e[0] | (e[1] << 16); o.y = e[2] | (e[3] << 16); o.z = e[4] | (e[5] << 16); o.w = e[6] | (e[7] << 16);
          *(v4u*)(VT + (size_t)tz * 64 + t8 * 8) = o; } }
    const int dk = tz & 255, half = tz >> 8;
    { float wv[16];
#pragma unroll
      for (int j = 0; j < 16; ++j) wv[j] = w2[j * 1024 + h * 256 + dk];
      const float bias = ba[h * 256 + dk];
      float run = 0.f;
#pragma unroll 4
      for (int tt = 0; tt < 32; ++tt) { const int t = half * 32 + tt; const LAS float* rr = Rs + t * 16; float x = bias;
#pragma unroll
          for (int j4 = 0; j4 < 4; ++j4) { const f32x4 rv = *(const LAS f32x4*)(rr + 4 * j4); x += rv[0] * wv[4 * j4] + rv[1] * wv[4 * j4 + 1] + rv[2] * wv[4 * j4 + 2] + rv[3] * wv[4 * j4 + 3]; }
          run += log_sigmoid_(x) * 0.0625f; BS[t * 256 + dk] = run; }
      TOT[half * 256 + dk] = run; }
    __syncthreads();
#pragma unroll
    for (int q = 0; q < 4; ++q) { const int p = tz + 512 * q, row = p >> 5, c = p & 31; *(LAS v4u*)(QS + row * 264 + c * 8) = qreg[q]; *(LAS v4u*)(KS + row * 264 + c * 8) = kreg[q]; }
    __syncthreads();
    { const float tot0 = TOT[dk], tot1 = TOT[256 + dk];
      const float off = half ? tot0 : 0.f, blast = tot0 + tot1;
#pragma unroll 1
      for (int q8 = 0; q8 < 4; ++q8) { unsigned kd[4];
#pragma unroll
          for (int e = 0; e < 8; ++e) { const int t = half * 32 + q8 * 8 + e;
              const float b = BS[t * 256 + dk] + off;
              const float q = bf2f(QS[t * 264 + dk]), k = bf2f(KS[t * 264 + dk]);
              const bf16 qt = f2bf(q * __expf(b) * 0.0625f), kt = f2bf(k * __expf(-b)); const unsigned kdv = f2bf(k * __expf(blast - b));
              QS[t * 264 + dk] = qt; KS[t * 264 + dk] = kt;
              if (e & 1) kd[e >> 1] |= kdv << 16; else kd[e >> 1] = kdv; }
          v4u o; o.x = kd[0]; o.y = kd[1]; o.z = kd[2]; o.w = kd[3]; *(v4u*)(KDT + (size_t)dk * 64 + half * 32 + 8 * q8) = o; }
      if (half == 0) DEC[dk] = __expf(blast); }
    __syncthreads();
#pragma unroll
    for (int q = 0; q < 4; ++q) { const int p = tz + 512 * q, t = p >> 5, c = p & 31, jb = c >> 2, g4 = c & 3;
        const LAS bf16* sp = QS + t * 264 + 32 * jb + 4 * g4;
        const v2u lo = *(const LAS v2u*)(sp), hi = *(const LAS v2u*)(sp + 16);
        v4u o; o.x = lo.x; o.y = lo.y; o.z = hi.x; o.w = hi.y;
        *(v4u*)(QT + (size_t)t * 256 + c * 8) = o; }
    { const int c = tz & 15, gg = (tz >> 4) & 3;
#pragma unroll
      for (int x = 0; x < 2; ++x) { const int id = F.wave * 2 + x, ti = id >> 2, si = id & 3;
          f32x4 a = {0.f, 0.f, 0.f, 0.f};
          if (si <= ti) {
#pragma unroll
              for (int ks = 0; ks < 8; ++ks) { const bf16x8 ak = *(const LAS bf16x8*)(KS + (16 * si + c) * 264 + ks * 32 + 8 * gg), bqv = *(const LAS bf16x8*)(QS + (16 * ti + c) * 264 + ks * 32 + 8 * gg);
                  a = MFMA16(ak, bqv, a); } }
          const int t = 16 * ti + c, s0 = 16 * si + 4 * gg;
          v2u o; o.x = pk2(s0 <= t ? a[0] : 0.f, s0 + 1 <= t ? a[1] : 0.f); o.y = pk2(s0 + 2 <= t ? a[2] : 0.f, s0 + 3 <= t ? a[3] : 0.f);
          *(v2u*)(ATT + (size_t)t * 64 + s0) = o; } }
}

__device__ __forceinline__ void win_prompt(Frame& F, const Args& A) {
    const bf16* KA = (const bf16*)(F.ws + WS_KA); const bf16* VA = (const bf16*)(F.ws + WS_VA);
    const size_t gt = (size_t)F.blk * 512 + F.tid, NT = (size_t)F.G * 512;
    for (size_t i = gt; i < 65536; i += NT) { const int b = (int)(i >> 15), rem = (int)(i & 32767); const size_t src = (size_t)(b * SEQ + SEQ - 128) * 256 + rem;
        F.out[OUT_KWP + i] = bf2f(KA[src]); F.out[OUT_VWP + i] = bf2f(VA[src]); }
}

constexpr int SEQ_QT = 0, SEQ_KD = 32768, SEQ_AT = 65536, SEQ_DC = 73728, SEQ_BUF = 74752;
constexpr int SEQ_CW = 2;
constexpr int SEQ_DVG = 512 / (16 * SEQ_CW);
#define SEQ_BARRIER() do { asm volatile("s_waitcnt lgkmcnt(0)" ::: "memory"); __builtin_amdgcn_s_barrier(); asm volatile("" ::: "memory"); } while (0)
__device__ __forceinline__ void gla_seq_unit(Frame& F, const Args& A, int unit) {
    const int nh = unit & 7, dvg = unit >> 3, n = nh >> 2, h = nh & 3;
    const bf16* QTg = (const bf16*)(F.ws + WS_QT) + (size_t)nh * 64 * 16384;
    const bf16* KDg = (const bf16*)(F.ws + WS_KDT) + (size_t)nh * 64 * 16384;
    const bf16* ATg = (const bf16*)(F.ws + WS_ATT) + (size_t)nh * 64 * 4096;
    const float* DCg = (const float*)(F.ws + WS_DEC) + (size_t)nh * 64 * 256;
    const bf16* VTg = (const bf16*)(F.ws + WS_VT) + (size_t)nh * 64 * 32768;
    __syncthreads();
    if (F.wave >= 4) {
        const int lt = F.tid - 256;
        v4u rq[2][8], rk[2][8], ra[2][2]; f32x4 rd[2] = {{0.f, 0.f, 0.f, 0.f}, {0.f, 0.f, 0.f, 0.f}};
#define SEQ_LOAD(sx, chx) do { const bf16* q_ = QTg + (size_t)(chx) * 16384; const bf16* k_ = KDg + (size_t)(chx) * 16384; const bf16* a_ = ATg + (size_t)(chx) * 4096; \
        _Pragma("unroll") for (int i = 0; i < 8; ++i) { rq[sx][i] = *(const v4u*)(q_ + (size_t)(lt + 256 * i) * 8); rk[sx][i] = *(const v4u*)(k_ + (size_t)(lt + 256 * i) * 8); } \
        _Pragma("unroll") for (int i = 0; i < 2; ++i) ra[sx][i] = *(const v4u*)(a_ + (size_t)(lt + 256 * i) * 8); \
        if (lt < 64) rd[sx] = *(const f32x4*)(DCg + (size_t)(chx) * 256 + lt * 4); } while (0)
#define SEQ_WRITE(sx, bufx) do { LAS unsigned char* b_ = F.lds + (bufx) * SEQ_BUF; \
        _Pragma("unroll") for (int i = 0; i < 8; ++i) { const int p = lt + 256 * i; \
            { const int row = p >> 5, slot = p & 31; *(LAS v4u*)(b_ + SEQ_QT + row * 512 + ((slot ^ (row & 15)) << 4)) = rq[sx][i]; } \
            { const int row = p >> 3, slot = p & 7;  *(LAS v4u*)(b_ + SEQ_KD + row * 128 + ((slot ^ ((row >> 1) & 7)) << 4)) = rk[sx][i]; } } \
        _Pragma("unroll") for (int i = 0; i < 2; ++i) { const int p = lt + 256 * i, row = p >> 3, slot = p & 7; *(LAS v4u*)(b_ + SEQ_AT + row * 128 + ((slot ^ ((row >> 1) & 7)) << 4)) = ra[sx][i]; } \
        if (lt < 64) *(LAS f32x4*)(b_ + SEQ_DC + lt * 16) = rd[sx]; } while (0)
        SEQ_LOAD(0, 0); SEQ_WRITE(0, 0); SEQ_LOAD(1, 1); SEQ_LOAD(0, 2);
        SEQ_BARRIER();
        for (int ch = 0; ch < 64; ch += 2) {
            SEQ_WRITE(1, 1); if (ch + 3 < 64) SEQ_LOAD(1, ch + 3);
            SEQ_BARRIER();
            if (ch + 2 < 64) { SEQ_WRITE(0, 0); if (ch + 4 < 64) SEQ_LOAD(0, ch + 4); }
            SEQ_BARRIER();
        }
#undef SEQ_LOAD
#undef SEQ_WRITE
    } else if (F.wave >= SEQ_CW) {
        for (int ch = 0; ch < 65; ++ch) SEQ_BARRIER();
    } else {
        const int c = F.lane & 15, gg = F.lane >> 4, sa = (c >> 1) & 7;
        const int dv0 = dvg * (16 * SEQ_CW) + F.wave * 16;
        float* OB = (float*)(F.ws + WS_OB);
        f32x4 S[16];
#pragma unroll
        for (int i = 0; i < 16; ++i) S[i] = (f32x4){0.f, 0.f, 0.f, 0.f};
        const bf16* vtp = VTg + (size_t)(dv0 + c) * 64 + 8 * gg;
        bf16x8 vf[2], vn[2];
#pragma unroll
        for (int j = 0; j < 2; ++j) vf[j] = *(const bf16x8*)(vtp + 32 * j);
        SEQ_BARRIER();
        for (int ch = 0; ch < 64; ++ch) {
            const LAS unsigned char* b_ = F.lds + (ch & 1) * SEQ_BUF;
            { const int cn = (ch + 1 < 64) ? ch + 1 : ch;
#pragma unroll
              for (int j = 0; j < 2; ++j) vn[j] = *(const bf16x8*)(vtp + (size_t)cn * 32768 + 32 * j); }
#define SEQ_LDQ(dst, jx) do { _Pragma("unroll") for (int mt = 0; mt < 4; ++mt) dst[mt] = *(const LAS bf16x8*)(b_ + SEQ_QT + (16 * mt + c) * 512 + (((4 * (jx) + gg) ^ c) << 4)); } while (0)
#define SEQ_LDK(kd_, dd_, gx) do { _Pragma("unroll") for (int e = 0; e < 2; ++e) { dd_[e] = *(const LAS f32x4*)(b_ + SEQ_DC + (16 * (2 * (gx) + e) + 4 * gg) * 4); \
            _Pragma("unroll") for (int j = 0; j < 2; ++j) kd_[e][j] = *(const LAS bf16x8*)(b_ + SEQ_KD + (16 * (2 * (gx) + e) + c) * 128 + (((4 * j + gg) ^ sa) << 4)); } } while (0)
            f32x4 o[4];
            bf16x8 af[4][2], qf[2][4];
#pragma unroll
            for (int mt = 0; mt < 4; ++mt)
#pragma unroll
                for (int j = 0; j < 2; ++j) af[mt][j] = *(const LAS bf16x8*)(b_ + SEQ_AT + (16 * mt + c) * 128 + (((4 * j + gg) ^ sa) << 4));
            SEQ_LDQ(qf[0], 0);
            __builtin_amdgcn_sched_barrier(0);
#pragma unroll
            for (int mt = 0; mt < 4; ++mt) { f32x4 a = {0.f, 0.f, 0.f, 0.f}; a = MFMA16(af[mt][0], vf[0], a); a = MFMA16(af[mt][1], vf[1], a); o[mt] = a; }
            bf16x8 kf[2][2][2]; f32x4 dd[2][2];
#pragma unroll
            for (int j = 0; j < 8; ++j) {
                if (j < 7) SEQ_LDQ(qf[(j + 1) & 1], j + 1); else SEQ_LDK(kf[0], dd[0], 0);
                v4u sw; sw.x = pk2(S[2 * j][0], S[2 * j][1]); sw.y = pk2(S[2 * j][2], S[2 * j][3]); sw.z = pk2(S[2 * j + 1][0], S[2 * j + 1][1]); sw.w = pk2(S[2 * j + 1][2], S[2 * j + 1][3]);
                const bf16x8 sb = __builtin_bit_cast(bf16x8, sw);
                __builtin_amdgcn_sched_barrier(0);
#pragma unroll
                for (int mt = 0; mt < 4; ++mt) o[mt] = MFMA16(qf[j & 1][mt], sb, o[mt]);
                __builtin_amdgcn_sched_barrier(0);
            }
#pragma unroll
            for (int g2 = 0; g2 < 8; ++g2) {
                if (g2 < 7) SEQ_LDK(kf[(g2 + 1) & 1], dd[(g2 + 1) & 1], g2 + 1);
                __builtin_amdgcn_sched_barrier(0);
#pragma unroll
                for (int e = 0; e < 2; ++e) { f32x4 a = S[2 * g2 + e] * dd[g2 & 1][e]; a = MFMA16(kf[g2 & 1][e][0], vf[0], a); a = MFMA16(kf[g2 & 1][e][1], vf[1], a); S[2 * g2 + e] = a; }
                __builtin_amdgcn_sched_barrier(0);
            }
#undef SEQ_LDQ
#undef SEQ_LDK
#pragma unroll
            for (int mt = 0; mt < 4; ++mt)
#pragma unroll
                for (int r = 0; r < 4; ++r) OB[((size_t)n * SEQ + ch * 64 + 16 * mt + 4 * gg + r) * 2048 + h * 512 + dv0 + c] = o[mt][r];
            vf[0] = vn[0]; vf[1] = vn[1];
            SEQ_BARRIER();
        }
        float* gsp = F.out + OUT_GSP + (size_t)nh * 256 * 512;
#pragma unroll
        for (int i = 0; i < 16; ++i)
#pragma unroll
            for (int r = 0; r < 4; ++r) gsp[(size_t)(16 * i + 4 * gg + r) * 512 + dv0 + c] = S[i][r];
    }
}

__device__ __forceinline__ void gla_sample_unit(Frame& F, const Args& A, int unit) {
    const int n = unit >> 2, h = unit & 3;
    const size_t row0 = (size_t)NPR + n * 8;
    const bf16* QB = (const bf16*)(F.ws + WS_QB); const bf16* KB = (const bf16*)(F.ws + WS_KB); const bf16* VB = (const bf16*)(F.ws + WS_VB); const bf16* ZB = (const bf16*)(F.ws + WS_ZB);
    const float* R = (const float*)(F.ws + WS_R); const float* w2 = FIN(12); const float* ba = FIN(13); const float* gg_ = FIN(14);
    bf16* AB = (bf16*)(F.ws + WS_AB);
    LAS float* QTs = (LAS float*)F.lds;
    LAS float* KDs = (LAS float*)(F.lds + 8192);
    LAS float* KTs = (LAS float*)(F.lds + 16384);
    LAS float* DCs = (LAS float*)(F.lds + 24576);
    LAS float* ATs = (LAS float*)(F.lds + 25600);
    LAS float* Rs  = (LAS float*)(F.lds + 25856);
    LAS float* RED = (LAS float*)(F.lds + 26624);
    int tz = F.tid; asm volatile("" : "+v"(tz));
    const int dv4 = (tz & 127) * 4, dkq = tz >> 7;
    const float* s0p = FIN(4) + (size_t)unit * 256 * 512 + (size_t)dkq * 512 + dv4;
    float* s1p = F.out + OUT_GSS + (size_t)unit * 256 * 512 + (size_t)dkq * 512 + dv4;
    f32x4 sb[8];
    const float* lp = s0p;
#pragma unroll
    for (int k = 0; k < 8; ++k) { sb[k] = __builtin_nontemporal_load((const f32x4*)lp); lp += 2048; asm volatile("" : "+v"(lp)); }
    SEQ_BARRIER();
    if (F.tid < 32) *(LAS f32x4*)(Rs + F.tid * 4) = *(const f32x4*)(R + row0 * 16 + F.tid * 4);
    SEQ_BARRIER();
    if (F.tid < 256) { const int dk = F.tid;
        float wv[16];
#pragma unroll
        for (int j = 0; j < 16; ++j) wv[j] = w2[j * 1024 + h * 256 + dk];
        const float bias = ba[h * 256 + dk];
        float b[8]; float run = 0.f;
#pragma unroll
        for (int t = 0; t < 8; ++t) { const LAS float* rr = Rs + t * 16; float x = bias;
#pragma unroll
            for (int j4 = 0; j4 < 4; ++j4) { const f32x4 rv = *(const LAS f32x4*)(rr + 4 * j4); x += rv[0] * wv[4 * j4] + rv[1] * wv[4 * j4 + 1] + rv[2] * wv[4 * j4 + 2] + rv[3] * wv[4 * j4 + 3]; }
            run += log_sigmoid_(x) * 0.0625f; b[t] = run; asm volatile("" ::: "memory"); }
        const float blast = run;
#pragma unroll
        for (int t = 0; t < 8; ++t) { const float q = bf2f(QB[(row0 + t) * 1024 + h * 256 + dk]), k = bf2f(KB[(row0 + t) * 1024 + h * 256 + dk]);
            QTs[dk * 8 + t] = q * __expf(b[t]) * 0.0625f; KTs[dk * 8 + t] = k * __expf(-b[t]); KDs[dk * 8 + t] = k * __expf(blast - b[t]); }
        DCs[dk] = __expf(blast);
    }
    SEQ_BARRIER();
    { const int t = F.wave; float a[8];
#pragma unroll
      for (int s = 0; s < 8; ++s) a[s] = 0.f;
#pragma unroll
      for (int q = 0; q < 4; ++q) { const int dk = F.lane + 64 * q; const float qv = QTs[dk * 8 + t];
#pragma unroll
          for (int s = 0; s < 8; ++s) a[s] += qv * KTs[dk * 8 + s]; }
#pragma unroll
      for (int s = 0; s < 8; ++s) { const float v = wave_sum(a[s]); if (F.lane == 0) ATs[t * 8 + s] = (s <= t) ? v : 0.f; } }
    f32x4 vv[8];
#pragma unroll
    for (int s = 0; s < 8; ++s) { const v2u w = *(const v2u*)(VB + (row0 + s) * 2048 + h * 512 + dv4); vv[s] = (f32x4){bflo(w.x), bfhi(w.x), bflo(w.y), bfhi(w.y)}; }
    f32x4 oa[8];
#pragma unroll
    for (int t = 0; t < 8; ++t) oa[t] = (f32x4){0.f, 0.f, 0.f, 0.f};
    float* sp = s1p;
#define SMP_BATCH(PF) do { _Pragma("unroll") for (int k = 0; k < 8; ++k) { const int dk = (bt * 8 + k) * 4 + dkq; \
            const f32x4 s0 = sb[k]; \
            if (PF) { sb[k] = __builtin_nontemporal_load((const f32x4*)lp); lp += 2048; asm volatile("" : "+v"(lp)); } \
            const f32x4 q0 = *(const LAS f32x4*)(QTs + dk * 8), q1 = *(const LAS f32x4*)(QTs + dk * 8 + 4); \
            const f32x4 k0 = *(const LAS f32x4*)(KDs + dk * 8), k1 = *(const LAS f32x4*)(KDs + dk * 8 + 4); \
            const float d = DCs[dk]; \
            oa[0] += s0 * q0[0]; oa[1] += s0 * q0[1]; oa[2] += s0 * q0[2]; oa[3] += s0 * q0[3]; \
            oa[4] += s0 * q1[0]; oa[5] += s0 * q1[1]; oa[6] += s0 * q1[2]; oa[7] += s0 * q1[3]; \
            f32x4 sn = s0 * d; \
            sn += vv[0] * k0[0]; sn += vv[1] * k0[1]; sn += vv[2] * k0[2]; sn += vv[3] * k0[3]; \
            sn += vv[4] * k1[0]; sn += vv[5] * k1[1]; sn += vv[6] * k1[2]; sn += vv[7] * k1[3]; \
            __builtin_nontemporal_store(sn, (f32x4*)sp); sp += 2048; asm volatile("" : "+v"(sp)); \
            if (k & 1) asm volatile("" ::: "memory"); } } while (0)
    { int bt = 0;
#pragma unroll 1
      for (; bt < 7; ++bt) SMP_BATCH(true);
      SMP_BATCH(false); }
#undef SMP_BATCH
#pragma unroll
    for (int t = 0; t < 8; ++t) *(LAS f32x4*)(RED + ((dkq * 8 + t) * 512 + dv4)) = oa[t];
    SEQ_BARRIER();
    { const int t = F.tid >> 6, d8 = (F.tid & 63) * 8;
      float o[8];
#pragma unroll
      for (int e = 0; e < 8; ++e) o[e] = 0.f;
#pragma unroll
      for (int q = 0; q < 4; ++q) { const f32x4 a = *(const LAS f32x4*)(RED + (q * 8 + t) * 512 + d8), b = *(const LAS f32x4*)(RED + (q * 8 + t) * 512 + d8 + 4);
          o[0] += a[0]; o[1] += a[1]; o[2] += a[2]; o[3] += a[3]; o[4] += b[0]; o[5] += b[1]; o[6] += b[2]; o[7] += b[3]; }
#pragma unroll
      for (int s = 0; s < 8; ++s) { const float at = ATs[t * 8 + s]; const v4u w = *(const v4u*)(VB + (row0 + s) * 2048 + h * 512 + d8);
          o[0] += at * bflo(w.x); o[1] += at * bfhi(w.x); o[2] += at * bflo(w.y); o[3] += at * bfhi(w.y); o[4] += at * bflo(w.z); o[5] += at * bfhi(w.z); o[6] += at * bflo(w.w); o[7] += at * bfhi(w.w); }
      float ss = 0.f;
#pragma unroll
      for (int e = 0; e < 8; ++e) ss += o[e] * o[e];
      ss = wave_sum(ss);
      const float rstd = rsqrtf(ss * (1.0f / 512.0f) + EPS);
      const v4u zw = *(const v4u*)(ZB + (row0 + t) * 2048 + h * 512 + d8);
      const f32x4 g0 = *(const f32x4*)(gg_ + h * 512 + d8), g1 = *(const f32x4*)(gg_ + h * 512 + d8 + 4);
      v4u w; w.x = pk2(o[0] * rstd * g0[0] * bflo(zw.x), o[1] * rstd * g0[1] * bfhi(zw.x)); w.y = pk2(o[2] * rstd * g0[2] * bflo(zw.y), o[3] * rstd * g0[3] * bfhi(zw.y));
      w.z = pk2(o[4] * rstd * g1[0] * bflo(zw.z), o[5] * rstd * g1[1] * bfhi(zw.z)); w.w = pk2(o[6] * rstd * g1[2] * bflo(zw.w), o[7] * rstd * g1[3] * bfhi(zw.w));
      *(v4u*)(AB + (row0 + t) * DM + 2048 + h * 512 + d8) = w; }
}
__device__ __forceinline__ void gla_sample_loop(Frame& F, const Args& A, unsigned* ctr) {
    volatile LAS unsigned* MISC = (volatile LAS unsigned*)(F.lds + MISC_OFF);
    for (;;) {
        __syncthreads();
        if (F.tid == 0) MISC[16] = __hip_atomic_fetch_add(ctr, 1u, __ATOMIC_RELAXED, __HIP_MEMORY_SCOPE_AGENT);
        __syncthreads();
        const int u = __builtin_amdgcn_readfirstlane((int)MISC[16]);
        if (u >= 512) break;
        gla_sample_unit(F, A, u);
    }
}

__device__ __forceinline__ void phase6(Frame& F, const Args& A) {
    const float* OB = (const float*)(F.ws + WS_OB); const bf16* ZB = (const bf16*)(F.ws + WS_ZB); const float* gn = FIN(14); bf16* AB = (bf16*)(F.ws + WS_AB);
    const int gw = F.blk * NWAVES + F.wave, NGW = F.G * NWAVES;
    if (gw >= NPR) return;
    f32x4 a[4][2], an[4][2]; v4u z[4], zn[4];
#pragma unroll
    for (int hh = 0; hh < 4; ++hh) { const size_t o = (size_t)gw * 2048 + hh * 512 + F.lane * 8; a[hh][0] = *(const f32x4*)(OB + o); a[hh][1] = *(const f32x4*)(OB + o + 4); z[hh] = *(const v4u*)(ZB + o); }
#pragma unroll 1
    for (int row = gw; row < NPR; row += NGW) {
        { const int rn = (row + NGW < NPR) ? row + NGW : row;
#pragma unroll
          for (int hh = 0; hh < 4; ++hh) { const size_t o = (size_t)rn * 2048 + hh * 512 + F.lane * 8; an[hh][0] = *(const f32x4*)(OB + o); an[hh][1] = *(const f32x4*)(OB + o + 4); zn[hh] = *(const v4u*)(ZB + o); } }
#pragma unroll
        for (int hh = 0; hh < 4; ++hh) { const int col = hh * 512 + F.lane * 8;
            const f32x4 x0 = a[hh][0], x1 = a[hh][1];
            float ss = (x0[0] * x0[0] + x0[1] * x0[1]) + (x0[2] * x0[2] + x0[3] * x0[3]) + (x1[0] * x1[0] + x1[1] * x1[1]) + (x1[2] * x1[2] + x1[3] * x1[3]);
            ss = wave_sum(ss);
            const float rstd = rsqrtf(ss * (1.0f / 512.0f) + EPS);
            const v4u zw = z[hh];
            const f32x4 g0 = *(const f32x4*)(gn + col), g1 = *(const f32x4*)(gn + col + 4);
            v4u w; w.x = pk2(x0[0] * rstd * g0[0] * bflo(zw.x), x0[1] * rstd * g0[1] * bfhi(zw.x)); w.y = pk2(x0[2] * rstd * g0[2] * bflo(zw.y), x0[3] * rstd * g0[3] * bfhi(zw.y));
            w.z = pk2(x1[0] * rstd * g1[0] * bflo(zw.z), x1[1] * rstd * g1[1] * bfhi(zw.z)); w.w = pk2(x1[2] * rstd * g1[2] * bflo(zw.w), x1[3] * rstd * g1[3] * bfhi(zw.w));
            *(v4u*)(AB + (size_t)row * DM + 2048 + col) = w; }
#pragma unroll
        for (int hh = 0; hh < 4; ++hh) { a[hh][0] = an[hh][0]; a[hh][1] = an[hh][1]; z[hh] = zn[hh]; }
    }
}

__device__ __forceinline__ void phase9(Frame& F, const Args& A) {
    const float* SSQ = (const float*)(F.ws + WS_SSQ); const float* fg = FIN(18); float* Y = F.out + OUT_Y; const bf16* XN = (const bf16*)(F.ws + WS_XN);
    const int gw = F.blk * NWAVES + F.wave, NGW = F.G * NWAVES;
    if (gw >= NROW) return;
    v4u v[8], vn[8]; float sq, sqn;
    { const bf16* xr = XN + (size_t)gw * DM + 8 * F.lane;
#pragma unroll
      for (int q = 0; q < 8; ++q) v[q] = *(const v4u*)(xr + 512 * q);
      sq = SSQ[(size_t)gw * 64 + F.lane]; }
#pragma unroll 1
    for (int row = gw; row < NROW; row += NGW) {
        { const int rn = (row + NGW < NROW) ? row + NGW : row; const bf16* xr = XN + (size_t)rn * DM + 8 * F.lane;
#pragma unroll
          for (int q = 0; q < 8; ++q) vn[q] = *(const v4u*)(xr + 512 * q);
          sqn = SSQ[(size_t)rn * 64 + F.lane]; }
        const float rstd = rsqrtf(wave_sum(sq) * (1.0f / DM) + EPS);
        float* yw = Y + (size_t)row * DM;
#pragma unroll
        for (int q = 0; q < 8; ++q) { const int c = 8 * (F.lane + 64 * q); const f32x4 g0 = *(const f32x4*)(fg + c), g1 = *(const f32x4*)(fg + c + 4);
            const f32x4 a = {bflo(v[q].x), bfhi(v[q].x), bflo(v[q].y), bfhi(v[q].y)}, b = {bflo(v[q].z), bfhi(v[q].z), bflo(v[q].w), bfhi(v[q].w)};
            __builtin_nontemporal_store(a * rstd * g0, (f32x4*)(yw + c)); __builtin_nontemporal_store(b * rstd * g1, (f32x4*)(yw + c + 4)); }
#pragma unroll
        for (int q = 0; q < 8; ++q) v[q] = vn[q];
        sq = sqn;
    }
}

constexpr int N_PHASES = 10;
constexpr int P3_NCG = 3;

__global__ void __launch_bounds__(NWAVES * 64, 2) mk_fwd(Args args) {
    extern __shared__ __attribute__((aligned(16))) unsigned char lds[];
    Frame F;
    F.lds = (LAS unsigned char*)lds;
    F.tid = threadIdx.x; F.lane = F.tid & 63; F.wave = __builtin_amdgcn_readfirstlane(F.tid >> 6);
    F.G = gridDim.x; F.blk = blockIdx.x;
    const Args& A = args;
    F.out = args.out; F.ws = args.ws;
    volatile LAS unsigned* MISC = (volatile LAS unsigned*)(F.lds + MISC_OFF);
    if (F.tid < 32) MISC[F.tid] = 0u;
    __syncthreads();
    unsigned* ctl = (unsigned*)(F.ws + WS_CTL);
    XcdBarrier bar; bar.bar = ctl + CW_BAR; bar.x = 0; bar.st = nullptr;
    if (MK_N_LAUNCHES == 1) bar = xcd_barrier_post(ctl + CW_BAR, MISC + 8);
    const int lo = args.ph_lo, hi = args.ph_hi;
#ifdef ONLY
#define IN(k) ((k) == ONLY)
#else
#define IN(k) (lo <= (k) && (k) < hi)
#endif
#define SEAM(k) do { if (IN(k) && IN((k) + 1)) xcd_barrier(bar); } while (0)
#ifndef PROBE_REPEAT
#define PROBE_REPEAT -1
#endif
#define PH(k, ...) do { if (IN(k)) { __VA_ARGS__ } SEAM(k); if (PROBE_REPEAT == (k)) { { __VA_ARGS__ } xcd_barrier(bar); } } while (0)

    PH(0, phase0(F, A););
    PH(1, phase1(F, A, ctl););
    PH(2, phase2(F, A););
    PH(3,
        pg8::Gemm g{(const bf16*)(F.ws + WS_H), (const bf16*)(F.ws + WS_WB1), NROW, N1, DM}; pg8::GroupedOrder S; S.init(NROW, N1, F.G, F.blk, P3_NCG);
        EpiProj E{F.ws};
        pg8::gemm_phase<EpiProj, pg8::GroupedOrder>(F.lds, g, S, E);
        transpose_queue<1>(F, A, ctl + CW_TRN2);
    );
    int p5_pass = 0;
    PH(4,
        for (int u = F.blk; u < 256; u += F.G) swa_prompt_unit(F, A, u);
        for (int u = F.blk; u < 512; u += F.G) gla_prep_unit(F, A, u);
        for (int u = F.blk; u < 512; u += F.G) swa_sample_unit(F, A, u);
        win_prompt(F, A);
    );
    PH(5,
        for (int u = F.blk; u < 8 * SEQ_DVG; u += F.G) gla_seq_unit(F, A, u);
        gla_sample_loop(F, A, ctl + CW_SMP + 64 * p5_pass); ++p5_pass;
    );
    if (PROBE_REPEAT == 40) { for (int u = F.blk; u < 256; u += F.G) swa_prompt_unit(F, A, u); xcd_barrier(bar); }
    if (PROBE_REPEAT == 41) { for (int u = F.blk; u < 512; u += F.G) gla_prep_unit(F, A, u); xcd_barrier(bar); }
    if (PROBE_REPEAT == 42) { for (int u = F.blk; u < 512; u += F.G) swa_sample_unit(F, A, u); xcd_barrier(bar); }
    if (PROBE_REPEAT == 50) { for (int u = F.blk; u < 8 * SEQ_DVG; u += F.G) gla_seq_unit(F, A, u); xcd_barrier(bar); }
    if (PROBE_REPEAT == 51) { gla_sample_loop(F, A, ctl + CW_SMP + 64 * p5_pass); xcd_barrier(bar); }
    PH(6, phase6(F, A););
    PH(7,
        pg8::Gemm g{(const bf16*)(F.ws + WS_AB), (const bf16*)(F.ws + WS_WB2), NROW, DM, DM}; pg8::StaticOrder S; S.init(NROW, DM, F.G, F.blk, 192);
        EpiMerge E{(const bf16*)(F.ws + WS_SGA), (const bf16*)(F.ws + WS_SGB), (bf16*)(F.ws + WS_MERGED)};
        pg8::gemm_phase<EpiMerge>(F.lds, g, S, E);
    );
    PH(8,
        pg8::Gemm g{(const bf16*)(F.ws + WS_MERGED), (const bf16*)(F.ws + WS_WB3), NROW, DM, DM}; pg8::StaticOrder S; S.init(NROW, DM, F.G, F.blk, 192);
        EpiOut E{A.in[0], A.in[1], (const float*)(F.ws + WS_MOD), (bf16*)(F.ws + WS_XN), (float*)(F.ws + WS_SSQ)};
        pg8::gemm_phase<EpiOut>(F.lds, g, S, E);
    );
    if (IN(9)) { phase9(F, A); }
    if (PROBE_REPEAT == 900) { for (int i = 0; i < 8; ++i) xcd_barrier(bar); }
#undef IN
#undef SEAM
#undef PH
}

extern "C" void kernel_launch(void* const* d_in, const int* in_sizes, int n_in, void* d_out, int out_size, void* d_ws, size_t ws_size, hipStream_t stream) {
    static int grid = 0;
    if (grid == 0) {
        if (n_in != 19 || (size_t)out_size != OUT_TOTAL || ws_size < WS_END) { fprintf(stderr, "kernel_launch: unexpected sizes n_in %d out %d ws %zu (need %zu)\n", n_in, out_size, ws_size, (size_t)WS_END); grid = -1; return; }
        int dev = 0, cus = 0, per_cu = 0;
        if (hipGetDevice(&dev) != hipSuccess || hipDeviceGetAttribute(&cus, hipDeviceAttributeMultiprocessorCount, dev) != hipSuccess) { grid = -1; return; }
        if (hipFuncSetAttribute((const void*)mk_fwd, hipFuncAttributeMaxDynamicSharedMemorySize, LDS_BYTES) != hipSuccess) { fprintf(stderr, "kernel_launch: hipFuncSetAttribute failed\n"); grid = -1; return; }
        if (hipOccupancyMaxActiveBlocksPerMultiprocessor(&per_cu, (const void*)mk_fwd, NWAVES * 64, LDS_BYTES) != hipSuccess || per_cu < 1) fprintf(stderr, "kernel_launch: occupancy query reports %d\n", per_cu);
        (void)hipGetLastError();
        grid = cus;
    }
    if (grid < 0) return;
    (void)hipMemsetAsync((char*)d_ws + WS_CTL, 0, CTL_ZERO_BYTES, stream);
    Args a{};
    for (int i = 0; i < 19; ++i) a.in[i] = (const float*)d_in[i];
    a.out = (float*)d_out; a.ws = (unsigned char*)d_ws;
    if (MK_N_LAUNCHES == 1) { a.ph_lo = 0; a.ph_hi = N_PHASES; hipLaunchKernelGGL(mk_fwd, dim3(grid), dim3(NWAVES * 64), LDS_BYTES, stream, a); }
    else for (int li = 0; li < N_PHASES; ++li) { a.ph_lo = li; a.ph_hi = li + 1; hipLaunchKernelGGL(mk_fwd, dim3(grid), dim3(NWAVES * 64), LDS_BYTES, stream, a); }
}
```

```cpp
#include <hip/hip_runtime.h>
#include <cstdio>
#include <cstdint>

#ifndef MK_N_LAUNCHES
#define MK_N_LAUNCHES 1
#endif

#define GAS __attribute__((address_space(1)))
#define LAS __attribute__((address_space(3)))
typedef unsigned short bf16;
typedef unsigned v4u __attribute__((ext_vector_type(4)));
typedef unsigned v2u __attribute__((ext_vector_type(2)));
typedef float f32x2 __attribute__((ext_vector_type(2)));
typedef float f32x4 __attribute__((ext_vector_type(4)));
typedef float f32x16 __attribute__((ext_vector_type(16)));
typedef short bf16x8 __attribute__((ext_vector_type(8)));
typedef __bf16 bf16x2_t __attribute__((ext_vector_type(2)));
#define LDS_WAIT() asm volatile("s_waitcnt lgkmcnt(0)" ::: "memory")
#define VM_WAIT() asm volatile("s_waitcnt vmcnt(0)" ::: "memory")

__device__ __forceinline__ unsigned pk2(float lo, float hi) { f32x2 v = {lo, hi}; bf16x2_t b = __builtin_convertvector(v, bf16x2_t); return __builtin_bit_cast(unsigned, b); }
__device__ __forceinline__ bf16 f2bf(float f) { return (bf16)(pk2(f, 0.f) & 0xffffu); }
__device__ __forceinline__ float bf2f(bf16 b) { return __uint_as_float(((unsigned)b) << 16); }
__device__ __forceinline__ float bflo(unsigned w) { return __uint_as_float(w << 16); }
__device__ __forceinline__ float bfhi(unsigned w) { return __uint_as_float(w & 0xffff0000u); }
__device__ __forceinline__ float wave_sum(float v) {
#pragma unroll
    for (int o = 1; o < 64; o <<= 1) v += __shfl_xor(v, o);
    return v;
}
__device__ __forceinline__ float sigmoidf_(float x) { return __builtin_amdgcn_rcpf(1.0f + __builtin_amdgcn_exp2f(-1.44269504089f * x)); }

#define XB_TMO      128
#define XB_XCNT(j)  (256  + 64 * (j))
#define XB_XSUB(j)  (1280 + 64 * (j))
#define XB_XGEN(j)  (2304 + 64 * (j))
#define XB_TOP      3328
#define XB_TOPGEN   3392
#define XCD_BAR_WORDS 3456
#define XB_SPIN_CAP (1u << 18)

__device__ __forceinline__ unsigned xb_ld(unsigned* p)              { return __hip_atomic_load(p, __ATOMIC_RELAXED, __HIP_MEMORY_SCOPE_AGENT); }
__device__ __forceinline__ unsigned xb_add(unsigned* p, unsigned v) { return __hip_atomic_fetch_add(p, v, __ATOMIC_RELAXED, __HIP_MEMORY_SCOPE_AGENT); }
__device__ __forceinline__ unsigned xb_xcc_id() { return (unsigned)__builtin_amdgcn_s_getreg((3 << 11) | 20) & 0xFu; }
#define XB_SPIN(cond, bar) do { unsigned _sp = 0; while (cond) { __builtin_amdgcn_s_sleep(1); \
    if ((++_sp & 255u) == 0u) { if (xb_ld(&(bar)[XB_TMO])) break; if (_sp > XB_SPIN_CAP) { atomicAdd(&(bar)[XB_TMO], 1u); break; } } } } while (0)

struct XcdBarrier { unsigned* bar; unsigned x; volatile LAS unsigned* st; };

__device__ __forceinline__ XcdBarrier xcd_barrier_post(unsigned* bar, volatile LAS unsigned* st) {
    XcdBarrier b; b.bar = bar; b.x = xb_xcc_id(); b.st = st;
    if (threadIdx.x == 0) (void)xb_add(&bar[XB_XCNT(b.x)], 1u);
    return b;
}
__device__ __forceinline__ void xcd_barrier_complete(unsigned* bar, unsigned x, unsigned& nloc, unsigned& nx) {
    const unsigned G = gridDim.x * gridDim.y * gridDim.z;
    unsigned sum, cnt, mine, sp = 0u;
    for (;;) {
        sum = 0u; cnt = 0u; mine = 0u;
#pragma unroll
        for (unsigned j = 0; j < 16; ++j) { const unsigned c = xb_ld(&bar[XB_XCNT(j)]); sum += c; cnt += (c > 0u) ? 1u : 0u; mine = (j == x) ? c : mine; }
        if (sum == G) break;
        __builtin_amdgcn_s_sleep(1);
        if ((++sp & 255u) == 0u) { if (xb_ld(&bar[XB_TMO])) break; if (sp > XB_SPIN_CAP) { atomicAdd(&bar[XB_TMO], 1u); break; } }
    }
    nloc = mine > 0u ? mine : 1u; nx = cnt > 0u ? cnt : 1u;
}
__device__ __forceinline__ void xcd_barrier(const XcdBarrier& b) {
    asm volatile("s_waitcnt vmcnt(0)" ::: "memory");
    __syncthreads();
    if (threadIdx.x == 0) {
        unsigned* bar = b.bar;
        __builtin_amdgcn_s_waitcnt(0);
        unsigned nloc = b.st[0], nx = b.st[1];
        if (nloc == 0u) { xcd_barrier_complete(bar, b.x, nloc, nx); b.st[0] = nloc; b.st[1] = nx; }
        const unsigned old = xb_add(&bar[XB_XSUB(b.x)], 1u);
        const unsigned gen = old / nloc;
        if (old + 1u == (gen + 1u) * nloc) {
            __builtin_amdgcn_fence(__ATOMIC_RELEASE, "agent");
            asm volatile("s_waitcnt vmcnt(0)" ::: "memory");
            const unsigned og = xb_add(&bar[XB_TOP], 1u);
            const unsigned tg = og / nx;
            if (og + 1u == (tg + 1u) * nx) xb_add(&bar[XB_TOPGEN], 1u);
            else XB_SPIN(xb_ld(&bar[XB_TOPGEN]) == tg, bar);
            __builtin_amdgcn_fence(__ATOMIC_ACQUIRE, "agent");
            xb_add(&bar[XB_XGEN(b.x)], 1u);
            asm volatile("s_waitcnt vmcnt(0)" ::: "memory");
        } else {
            XB_SPIN(xb_ld(&bar[XB_XGEN(b.x)]) == gen, bar);
            __builtin_amdgcn_fence(__ATOMIC_ACQUIRE, "agent");
            asm volatile("s_waitcnt vmcnt(0)" ::: "memory");
        }
    }
    __syncthreads();
}

constexpr int DM = 4096;
constexpr int NPR = 8192, NSR = 1024, NROW = NPR + NSR;
constexpr int SEQ = 4096, NSEQ_S = 128, TS = 8;
constexpr int N1 = 19200, NT1 = 75;
constexpr int PROJ = 18960;
constexpr int NMOD = 130;
constexpr float EPS = 1e-6f;

constexpr size_t MiB = 1u << 20;
constexpr size_t WS_CTL = 0, CTL_ZERO_BYTES = 1 * MiB;
constexpr size_t WS_WB1 = 1 * MiB;
constexpr size_t WS_WB2 = WS_WB1 + (size_t)N1 * DM * 2;
constexpr size_t WS_WB3 = WS_WB2 + (size_t)DM * DM * 2;
constexpr size_t WS_CS  = WS_WB3 + (size_t)DM * DM * 2;
constexpr size_t WS_MOD = WS_CS + (size_t)160 * DM * 2;
constexpr size_t WS_H   = WS_MOD + (size_t)132 * 12288 * 4;
constexpr size_t WS_QA  = WS_H + (size_t)NROW * DM * 2;
constexpr size_t WS_KA  = WS_QA + (size_t)NROW * 2048 * 2;
constexpr size_t WS_VA  = WS_KA + (size_t)NROW * 256 * 2;
constexpr size_t WS_ZA  = WS_VA + (size_t)NROW * 256 * 2;
constexpr size_t WS_QB  = WS_ZA + (size_t)NROW * 2048 * 2;
constexpr size_t WS_KB  = WS_QB + (size_t)NROW * 1024 * 2;
constexpr size_t WS_VB  = WS_KB + (size_t)NROW * 1024 * 2;
constexpr size_t WS_ZB  = WS_VB + (size_t)NROW * 2048 * 2;
constexpr size_t WS_SGA = WS_ZB + (size_t)NROW * 2048 * 2;
constexpr size_t WS_SGB = WS_SGA + (size_t)NROW * DM * 2;
constexpr size_t WS_R   = WS_SGB + (size_t)NROW * DM * 2;
constexpr size_t WS_QT  = WS_R + (size_t)NROW * 16 * 4;
constexpr size_t WS_KDT = WS_QT + (size_t)512 * 64 * 256 * 2;
constexpr size_t WS_ATT = WS_KDT + (size_t)512 * 64 * 256 * 2;
constexpr size_t WS_VT  = WS_ATT + (size_t)512 * 64 * 64 * 2;
constexpr size_t WS_DEC = WS_VT + (size_t)512 * 512 * 64 * 2;
constexpr size_t WS_OB  = WS_DEC + (size_t)512 * 256 * 4;
constexpr size_t WS_AB  = WS_OB + (size_t)NPR * 2048 * 4;
constexpr size_t WS_SSQ = WS_AB + (size_t)NROW * DM * 2;
constexpr size_t WS_END = WS_SSQ + (size_t)NROW * 64 * 4;
constexpr size_t WS_MERGED = WS_H;
constexpr size_t WS_XN = WS_AB;
constexpr int CW_BAR = 4096;

constexpr size_t OUT_Y = 0;
constexpr size_t OUT_KWP = (size_t)NROW * DM;
constexpr size_t OUT_VWP = OUT_KWP + 65536;
constexpr size_t OUT_GSP = OUT_VWP + 65536;
constexpr size_t OUT_KWS = OUT_GSP + 1048576;
constexpr size_t OUT_VWS = OUT_KWS + 4194304;
constexpr size_t OUT_GSS = OUT_VWS + 4194304;
constexpr size_t OUT_TOTAL = OUT_GSS + 67108864;

constexpr int RING_BYTES = 131072;
constexpr int LDS_BYTES = 155648;
constexpr int MISC_OFF = LDS_BYTES - 256;
constexpr int SMP_P4 = 0;
constexpr int CW_SMP = 64;
constexpr int NWAVES = 8;

namespace pg8 {
constexpr int BM = 256, BK = 64, HALF = 128, HTB = HALF * BK * 2, STAGE_BYTES = 8 * HTB, NXCD = 8, WGM = 8;
__host__ __device__ __forceinline__ int lds_byte(int r, int c) { const int st = (r >> 4) * 2 + (c >> 5), rr = r & 15, cc = c & 31, ob = rr * 64 + cc * 2; return st * 1024 + (ob ^ (((ob >> 9) & 1) << 5)); }
__host__ __device__ __forceinline__ void stage_rc(int b, int& R, int& C) { const int st = b / 1024, sb = b % 1024, swz = sb ^ (((sb >> 9) & 1) << 5); R = (st >> 1) * 16 + swz / 64; C = (st & 1) * 32 + (swz % 64) / 2; }
__host__ __device__ __forceinline__ int perm32(int rho) { const int n = rho >> 4, i = rho & 15; return 8 * (i >> 2) + 4 * n + (i & 3); }

struct Unit { int pm, pn; };
struct Gemm { const bf16* A; const bf16* Bt; int M, N, K; };

struct StaticOrder {
    int nM, nN, nwg, G, c;
    __host__ __device__ void init(int M, int N, int G_, int c_, int bm_rows = BM) { nM = M / bm_rows; nN = N / BM; nwg = nM * nN; G = G_; c = c_; }
    __host__ __device__ bool next(int i, Unit& u) const {
        const long L = (long)i * G + c; if (L >= nwg) return false;
        int wgid = (int)L; { const int q = nwg / NXCD, r = nwg % NXCD, xcd = wgid % NXCD, off = wgid / NXCD; wgid = (xcd < r ? xcd * (q + 1) : r * (q + 1) + (xcd - r) * q) + off; }
        const int nig = WGM * nN, gid = wgid / nig, fm = gid * WGM, gsz = (nM - fm) < WGM ? (nM - fm) : WGM;
        u.pm = fm + ((wgid % nig) % gsz); u.pn = (wgid % nig) / gsz; return true;
    }
};

struct GroupedOrder {
    int nM, nNg, ncg, per, G, c;
    __host__ __device__ void init(int M, int N, int G_, int c_, int ncg_) { nM = M / BM; ncg = ncg_; nNg = (N / BM) / ncg_; per = nM * nNg; G = G_; c = c_; }
    __host__ __device__ bool next(int i, Unit& u) const {
        const long L = (long)i * G + c; if (L >= (long)per * ncg) return false;
        const int grp = (int)(L / per); int wgid = (int)(L % per);
        { const int q = per / NXCD, r = per % NXCD, xcd = wgid % NXCD, off = wgid / NXCD; wgid = (xcd < r ? xcd * (q + 1) : r * (q + 1) + (xcd - r) * q) + off; }
        const int nig = WGM * nNg, gid = wgid / nig, fm = gid * WGM, gsz = (nM - fm) < WGM ? (nM - fm) : WGM;
        u.pm = fm + ((wgid % nig) % gsz); u.pn = grp * nNg + (wgid % nig) / gsz; return true;
    }
};

template <class Epi, class Sched = StaticOrder>
__device__ __forceinline__ void gemm_phase(LAS unsigned char* lds, const Gemm g, const Sched& S, const Epi& E) {
    const int tid = threadIdx.x, wid = __builtin_amdgcn_readfirstlane(tid >> 6), lane = tid & 63, wr = wid >> 2, wc = wid & 3, fr = lane & 15, fq = lane >> 4;
    constexpr int MT = Epi::MT;
    const int K = g.K, nt = K / BK;
    unsigned voffA[2], voffB[2];
#pragma unroll
    for (int i = 0; i < 2; ++i) { int R, C; stage_rc(tid * 16 + i * 8192, R, C); const int Rb = Epi::PERM ? ((R & ~31) + perm32(R & 31)) : R;
        const int Ra = (MT == 3 && R >= 96) ? R - 32 : R;
        voffA[i] = (unsigned)(Ra * K + C) * 2u; voffB[i] = (unsigned)(Rb * K + C) * 2u; }
    const size_t kstep = (size_t)(BK * 2);
    const size_t hstep = (size_t)HALF * K * 2;
    const size_t tstep = 2 * hstep;
    const size_t hstepA = (size_t)(32 * MT) * K * 2;
    const size_t tstepA = 2 * hstepA;
    const unsigned ldsw = (unsigned)wid * 1024u;
    const int aoff = lds_byte(wr * 16 * MT + fr, fq * 8), boff = lds_byte(wc * 32 + fr, fq * 8);
#define PG8_SA(b, h) (((b) * 2 + (h)) * HTB)
#define PG8_SB(b, h) ((4 + (b) * 2 + (h)) * HTB)
#define PG8_STAGE(bufoff, gbase, voff) do { _Pragma("unroll") for (int _i = 0; _i < 2; ++_i) \
        __builtin_amdgcn_global_load_lds((const unsigned*)((const char*)(gbase) + (voff)[_i]), (LAS unsigned*)(lds + (bufoff) + ldsw + _i * 8192), 16, 0, 0); } while (0)
#define PG8_STAGEB(bufoff, gbase, voff) do { _Pragma("unroll") for (int _i = 0; _i < 2; ++_i) \
        __builtin_amdgcn_global_load_lds((const unsigned*)((const char*)(gbase) + (voff)[_i]), (LAS unsigned*)(lds + (bufoff) + ldsw + _i * 8192), 16, 0, Epi::AUXB); } while (0)
#define PG8_LDA(dst, b, h) do { _Pragma("unroll") for (int m = 0; m < MT; ++m) _Pragma("unroll") for (int k = 0; k < 2; ++k) dst[m][k] = *(const LAS bf16x8*)(lds + PG8_SA(b, h) + aoff + m * 2048 + k * 1024); } while (0)
#define PG8_LDB(dst, b, h) do { _Pragma("unroll") for (int n = 0; n < 2; ++n) _Pragma("unroll") for (int k = 0; k < 2; ++k) dst[n][k] = *(const LAS bf16x8*)(lds + PG8_SB(b, h) + boff + n * 2048 + k * 1024); } while (0)
#define PG8_MMA(ai, bj, At, Bt) do { __builtin_amdgcn_s_setprio(1); _Pragma("unroll") for (int m = 0; m < MT; ++m) _Pragma("unroll") for (int n = 0; n < 2; ++n) _Pragma("unroll") for (int k = 0; k < 2; ++k) \
        acc[ai][bj][m][n] = __builtin_amdgcn_mfma_f32_16x16x32_bf16(Bt[n][k], At[m][k], acc[ai][bj][m][n], 0, 0, 0); __builtin_amdgcn_s_setprio(0); } while (0)
#define PG8_WAIT_V(n) asm volatile("s_waitcnt vmcnt(" #n ")" ::: "memory")
#define PG8_WAIT_L(n) asm volatile("s_waitcnt lgkmcnt(" #n ")" ::: "memory")
#define PG8_BAR __builtin_amdgcn_s_barrier()
#define PG8_SCHED __builtin_amdgcn_sched_barrier(0)
    Unit cur, nxt; int ui = 0;
    if (!S.next(0, cur)) return;
    f32x4 acc[2][2][MT][2];
#pragma unroll
    for (int a = 0; a < 2; ++a)
#pragma unroll
        for (int b = 0; b < 2; ++b)
#pragma unroll
            for (int m = 0; m < MT; ++m)
#pragma unroll
                for (int n = 0; n < 2; ++n) acc[a][b][m][n] = (f32x4){0.f, 0.f, 0.f, 0.f};
    bf16x8 At[MT][2], B0[2][2], B1[2][2];
    const char* cA = (const char*)g.A + (size_t)cur.pm * tstepA; const char* cB = (const char*)g.Bt + (size_t)cur.pn * tstep;
    PG8_STAGEB(PG8_SB(0, 0), cB, voffB); PG8_STAGEB(PG8_SB(0, 1), cB + hstep, voffB); PG8_STAGE(PG8_SA(0, 0), cA, voffA); PG8_STAGE(PG8_SA(0, 1), cA + hstepA, voffA);
    if (wr == 1) PG8_BAR;
    PG8_WAIT_V(2); PG8_BAR;
    PG8_STAGEB(PG8_SB(1, 0), cB + kstep, voffB); PG8_STAGE(PG8_SA(1, 0), cA + kstep, voffA); PG8_STAGEB(PG8_SB(1, 1), cB + hstep + kstep, voffB);
    PG8_WAIT_V(6); PG8_BAR;
    for (;;) {
        const bool has_next = S.next(ui + 1, nxt);
        const char* nA = has_next ? (const char*)g.A + (size_t)nxt.pm * tstepA : cA; const char* nB = has_next ? (const char*)g.Bt + (size_t)nxt.pn * tstep : cB;
        for (int t = 0; t < nt; t += 2) {
            const bool last = (t == nt - 2);
            const char* a1 = cA + (size_t)(t + 1) * kstep;
            const char* a2 = last ? nA : cA + (size_t)(t + 2) * kstep; const char* b2 = last ? nB : cB + (size_t)(t + 2) * kstep;
            const char* a3 = a2 + kstep; const char* b3 = b2 + kstep;
            if constexpr (Epi::HAS_MID) { if (t == nt / 2) E.mid(acc, cur, wr, wc, fr, fq); }
            PG8_LDB(B0, 0, 0); PG8_LDB(B1, 0, 1); PG8_SCHED; PG8_LDA(At, 0, 0); PG8_STAGE(PG8_SA(1, 1), a1 + hstepA, voffA);
            PG8_WAIT_V(8); PG8_WAIT_L(0); PG8_BAR; PG8_MMA(0, 0, At, B0); PG8_MMA(0, 1, At, B1); PG8_BAR; PG8_SCHED;
            PG8_LDA(At, 0, 1); PG8_STAGEB(PG8_SB(0, 0), b2, voffB); PG8_STAGEB(PG8_SB(0, 1), b2 + hstep, voffB); PG8_STAGE(PG8_SA(0, 0), a2, voffA);
            PG8_WAIT_V(8); PG8_WAIT_L(0); PG8_BAR; PG8_MMA(1, 0, At, B0); PG8_MMA(1, 1, At, B1); PG8_BAR; PG8_SCHED;
            PG8_LDB(B0, 1, 0); PG8_LDB(B1, 1, 1); PG8_SCHED; PG8_LDA(At, 1, 0); PG8_STAGE(PG8_SA(0, 1), a2 + hstepA, voffA);
            PG8_WAIT_V(8); PG8_WAIT_L(0); PG8_BAR; PG8_MMA(0, 0, At, B0); PG8_MMA(0, 1, At, B1); PG8_BAR; PG8_SCHED;
            PG8_LDA(At, 1, 1); PG8_STAGEB(PG8_SB(1, 0), b3, voffB); PG8_STAGEB(PG8_SB(1, 1), b3 + hstep, voffB); PG8_STAGE(PG8_SA(1, 0), a3, voffA);
            PG8_WAIT_V(8); PG8_WAIT_L(0); PG8_BAR; PG8_MMA(1, 0, At, B0); PG8_MMA(1, 1, At, B1); PG8_BAR; PG8_SCHED;
        }
        if (wr == 0) PG8_BAR;
        E(acc, cur, wr, wc, fr, fq);
        if (!has_next) break;
#pragma unroll
        for (int a = 0; a < 2; ++a)
#pragma unroll
            for (int b = 0; b < 2; ++b)
#pragma unroll
                for (int m = 0; m < MT; ++m)
#pragma unroll
                    for (int n = 0; n < 2; ++n) acc[a][b][m][n] = (f32x4){0.f, 0.f, 0.f, 0.f};
        cur = nxt; cA = nA; cB = nB; ++ui;
        if (wr == 1) PG8_BAR;
    }
    PG8_WAIT_V(0);
    PG8_BAR;
#undef PG8_SA
#undef PG8_SB
#undef PG8_STAGE
#undef PG8_STAGEB
#undef PG8_LDA
#undef PG8_LDB
#undef PG8_MMA
#undef PG8_WAIT_V
#undef PG8_WAIT_L
#undef PG8_BAR
#undef PG8_SCHED
}
}

struct EpiProj {
    static constexpr bool PERM = true, HAS_MID = false; static constexpr int MT = 4, AUXB = 0;
    unsigned char* ws;
    __device__ __forceinline__ void operator()(const f32x4 (&acc)[2][2][4][2], const pg8::Unit& u, int wr, int wc, int fr, int fq) const {
        const int pn = u.pn;
        const int row0 = u.pm * 256 + wr * 64 + fr;
        if (pn == 74) {
            if (wc == 0 && fq < 2) {
                float* R = (float*)(ws + WS_R);
#pragma unroll
                for (int ai = 0; ai < 2; ++ai)
#pragma unroll
                    for (int m = 0; m < 4; ++m) { float* rp = R + (size_t)(row0 + ai * 128 + m * 16) * 16 + 8 * fq;
                        *(f32x4*)(rp) = acc[ai][0][m][0]; *(f32x4*)(rp + 4) = acc[ai][0][m][1]; }
            }
            return;
        }
        if (pn >= 42) {
            bf16* RT = (bf16*)(ws + WS_SGA); bf16* SB = (bf16*)(ws + WS_SGB);
            const int col0 = (pn - 42) * 128 + wc * 32 + 8 * fq;
#pragma unroll
            for (int ai = 0; ai < 2; ++ai)
#pragma unroll
                for (int m = 0; m < 4; ++m) { const size_t off = (size_t)(row0 + ai * 128 + m * 16) * DM + col0;
                    float rt[8], sb[8];
#pragma unroll
                    for (int n = 0; n < 2; ++n)
#pragma unroll
                        for (int j = 0; j < 4; ++j) { const float ea = __builtin_amdgcn_exp2f(-1.44269504089f * acc[ai][0][m][n][j]), eb = __builtin_amdgcn_exp2f(-1.44269504089f * acc[ai][1][m][n][j]);
                            sb[4 * n + j] = __builtin_amdgcn_rcpf(1.0f + eb); rt[4 * n + j] = (1.0f + eb) * __builtin_amdgcn_rcpf(1.0f + ea); }
                    v4u w; w.x = pk2(rt[0], rt[1]); w.y = pk2(rt[2], rt[3]); w.z = pk2(rt[4], rt[5]); w.w = pk2(rt[6], rt[7]);
                    __builtin_nontemporal_store(w, (v4u*)(RT + off));
                    w.x = pk2(sb[0], sb[1]); w.y = pk2(sb[2], sb[3]); w.z = pk2(sb[4], sb[5]); w.w = pk2(sb[6], sb[7]);
                    __builtin_nontemporal_store(w, (v4u*)(SB + off)); }
            return;
        }
        size_t boff; int ldc, ct, act;
        if (pn < 8)       { boff = WS_QA;  ldc = 2048; ct = pn;      act = 0; }
        else if (pn == 8) { boff = WS_KA;  ldc = 256;  ct = 0;       act = 0; }
        else if (pn == 9) { boff = WS_VA;  ldc = 256;  ct = 0;       act = 0; }
        else if (pn < 18) { boff = WS_ZA;  ldc = 2048; ct = pn - 10; act = 1; }
        else if (pn < 22) { boff = WS_QB;  ldc = 1024; ct = pn - 18; act = 0; }
        else if (pn < 26) { boff = WS_KB;  ldc = 1024; ct = pn - 22; act = 0; }
        else if (pn < 34) { boff = WS_VB;  ldc = 2048; ct = pn - 26; act = 0; }
        else              { boff = WS_ZB;  ldc = 2048; ct = pn - 34; act = 1; }
        bf16* base = (bf16*)(ws + boff);
        const int col0 = ct * 256 + wc * 32 + 8 * fq;
#pragma unroll
        for (int ai = 0; ai < 2; ++ai)
#pragma unroll
            for (int m = 0; m < 4; ++m) { bf16* rowp = base + (size_t)(row0 + ai * 128 + m * 16) * ldc + col0;
#pragma unroll
                for (int bj = 0; bj < 2; ++bj) { f32x4 v0 = acc[ai][bj][m][0], v1 = acc[ai][bj][m][1];
                    if (act != 0) {
#pragma unroll
                        for (int j = 0; j < 4; ++j) { v0[j] *= sigmoidf_(v0[j]); v1[j] *= sigmoidf_(v1[j]); }
                    }
                    v4u w; w.x = pk2(v0[0], v0[1]); w.y = pk2(v0[2], v0[3]); w.z = pk2(v1[0], v1[1]); w.w = pk2(v1[2], v1[3]);
                    __builtin_nontemporal_store(w, (v4u*)(rowp + bj * 128)); } }
    }
};
struct EpiMerge {
    static constexpr bool PERM = true, HAS_MID = true; static constexpr int MT = 3, AUXB = 0;
    const bf16* sga; const bf16* sgb; bf16* out;
    __device__ __forceinline__ void mid(f32x4 (&acc)[2][2][MT][2], const pg8::Unit& u, int wr, int wc, int fr, int fq) const {
        int row0 = u.pm * (64 * MT) + wr * (16 * MT) + fr, col0 = u.pn * 256 + wc * 32 + 8 * fq;
        asm volatile("" : "+v"(row0), "+v"(col0));
#pragma unroll
        for (int ai = 0; ai < 2; ++ai)
#pragma unroll
            for (int m = 0; m < MT; ++m) { const size_t off = (size_t)(row0 + ai * (32 * MT) + m * 16) * DM + col0;
#pragma unroll
                for (int bj = 0; bj < 2; ++bj) { const v4u a = *(const v4u*)(sga + off + bj * 128);
                    const f32x4 r0 = {bflo(a.x), bfhi(a.x), bflo(a.y), bfhi(a.y)}, r1 = {bflo(a.z), bfhi(a.z), bflo(a.w), bfhi(a.w)};
                    acc[ai][bj][m][0] *= r0; acc[ai][bj][m][1] *= r1;
                    asm volatile("" ::: "memory"); } }
    }
    __device__ __forceinline__ void operator()(const f32x4 (&acc)[2][2][MT][2], const pg8::Unit& u, int wr, int wc, int fr, int fq) const {
        const int row0 = u.pm * (64 * MT) + wr * (16 * MT) + fr, col0 = u.pn * 256 + wc * 32 + 8 * fq;
#pragma unroll
        for (int ai = 0; ai < 2; ++ai)
#pragma unroll
            for (int m = 0; m < MT; ++m) { const size_t off = (size_t)(row0 + ai * (32 * MT) + m * 16) * DM + col0;
#pragma unroll
                for (int bj = 0; bj < 2; ++bj) { const v4u b = *(const v4u*)(sgb + off + bj * 128);
                    const f32x4 v0 = acc[ai][bj][m][0], v1 = acc[ai][bj][m][1];
                    v4u w; w.x = pk2(v0[0] * bflo(b.x), v0[1] * bfhi(b.x)); w.y = pk2(v0[2] * bflo(b.y), v0[3] * bfhi(b.y));
                    w.z = pk2(v1[0] * bflo(b.z), v1[1] * bfhi(b.z)); w.w = pk2(v1[2] * bflo(b.w), v1[3] * bfhi(b.w));
                    *(v4u*)(out + off + bj * 128) = w; } }
    }
};
struct EpiOut {
    static constexpr bool PERM = false, HAS_MID = false; static constexpr int MT = 3, AUXB = 0;
    const float* xp; const float* xs; const float* mod; bf16* y; float* ssq;
    __device__ __forceinline__ void operator()(const f32x4 (&acc)[2][2][MT][2], const pg8::Unit& u, int wr, int wc, int fr, int fq) const {
        const int col0 = u.pn * 256 + wc * 32 + 4 * fq;
#pragma unroll
        for (int ai = 0; ai < 2; ++ai)
#pragma unroll
            for (int m = 0; m < MT; ++m) { const int row = u.pm * (64 * MT) + ai * (32 * MT) + wr * (16 * MT) + m * 16 + fr;
                const float* xr = (row < NPR) ? xp + (size_t)row * DM : xs + (size_t)(row - NPR) * DM;
                const int seq = (row < NPR) ? (row >> 12) : 2 + ((row - NPR) >> 3);
                const float* gp = mod + (size_t)seq * 12288 + 8192;
                float s = 0.f;
#pragma unroll
                for (int bj = 0; bj < 2; ++bj)
#pragma unroll
                    for (int n = 0; n < 2; ++n) { const int c = col0 + bj * 128 + n * 16;
                        const f32x4 xv = *(const f32x4*)(xr + c), gv = *(const f32x4*)(gp + c);
                        const f32x4 o = xv + gv * acc[ai][bj][m][n];
                        v2u w; w.x = pk2(o[0], o[1]); w.y = pk2(o[2], o[3]);
                        *(v2u*)(y + (size_t)row * DM + c) = w;
                        s += (o[0] * o[0] + o[1] * o[1]) + (o[2] * o[2] + o[3] * o[3]); }
                s += __shfl_xor(s, 16); s += __shfl_xor(s, 32);
                if (fq == 0) ssq[(size_t)row * 64 + u.pn * 4 + wc] = s;
            }
    }
};

struct Args { const float* in[19]; float* out; unsigned char* ws; int ph_lo, ph_hi, ph_rep, pad_; };
#define FIN(k) (A.in[k])
struct Frame {
    LAS unsigned char* lds;
    int tid, lane, wave, blk, G;
    float* out; unsigned char* ws;
};

template <bool NTS>
__device__ __forceinline__ void p0_transpose_item(const float* W, int ldw, int k0, int n_src0, bf16* WT, int ldt, int drow0, int koff, LAS float* scr, int lane) {
    f32x4 v[16];
    const float* wp = W + (size_t)(k0 + (lane >> 4)) * ldw + n_src0 + (lane & 15) * 4;
#pragma unroll
    for (int i = 0; i < 16; ++i) v[i] = __builtin_nontemporal_load((const f32x4*)(wp + (size_t)(4 * i) * ldw));
#pragma unroll
    for (int i = 0; i < 16; ++i) { LAS float* s = scr + (4 * i + (lane >> 4)) * 65 + (lane & 15) * 4; s[0] = v[i][0]; s[1] = v[i][1]; s[2] = v[i][2]; s[3] = v[i][3]; }
    LDS_WAIT(); asm volatile("" ::: "memory");
    const int c = lane & 7;
#pragma unroll
    for (int j = 0; j < 8; ++j) { const int n = (lane >> 3) + 8 * j; const LAS float* s = scr + (8 * c) * 65 + n;
        v4u o; o.x = pk2(s[0 * 65], s[1 * 65]); o.y = pk2(s[2 * 65], s[3 * 65]); o.z = pk2(s[4 * 65], s[5 * 65]); o.w = pk2(s[6 * 65], s[7 * 65]);
        if (NTS) __builtin_nontemporal_store(o, (v4u*)(WT + (size_t)(drow0 + n) * ldt + koff + k0 + 8 * c)); else *(v4u*)(WT + (size_t)(drow0 + n) * ldt + koff + k0 + 8 * c) = o; }
    LDS_WAIT(); asm volatile("" ::: "memory");
}
__device__ __forceinline__ void phase0(Frame& F, const Args& A) {
    const size_t gt = (size_t)F.blk * 512 + F.tid, NT = (size_t)F.G * 512;
    bf16* CS = (bf16*)(F.ws + WS_CS); const float* cp = FIN(5); const float* cs = FIN(6);
    for (size_t i = gt; i < (size_t)160 * DM / 4; i += NT) { const int row = (int)(i >> 10), c4 = (int)(i & 1023) * 4;
        f32x4 v = {0.f, 0.f, 0.f, 0.f};
        if (row < 2) v = *(const f32x4*)(cp + (size_t)row * DM + c4); else if (row < NMOD) v = *(const f32x4*)(cs + (size_t)(row - 2) * DM + c4);
        v2u o; o.x = pk2(v[0] * sigmoidf_(v[0]), v[1] * sigmoidf_(v[1])); o.y = pk2(v[2] * sigmoidf_(v[2]), v[3] * sigmoidf_(v[3]));
        *(v2u*)(CS + (size_t)row * DM + c4) = o; }
    { f32x4* z = (f32x4*)(F.ws + WS_MOD); const f32x4 zero = {0.f, 0.f, 0.f, 0.f}; for (size_t i = gt; i < (size_t)NMOD * 12288 / 4; i += NT) z[i] = zero; }
}
__device__ __forceinline__ void p1_modgemm(Frame& F, const Args& A) {
    const float* w_ada = FIN(7); const float* b_ada = FIN(8);
    const bf16* CS = (const bf16*)(F.ws + WS_CS); float* MOD = (float*)(F.ws + WS_MOD);
    const int kq = F.blk & 3, j = F.lane & 31, hh = F.lane >> 5;
    const int n0 = (F.blk >> 2) * 256 + F.wave * 32;
    f32x16 acc[5];
#pragma unroll
    for (int mt = 0; mt < 5; ++mt)
#pragma unroll
        for (int r = 0; r < 16; ++r) acc[mt][r] = 0.f;
    const float* wp = w_ada + (size_t)(kq * 1024 + 8 * hh) * 12288 + n0 + j;
    const bf16* ap = CS + (size_t)j * DM + kq * 1024 + 8 * hh;
    float bn[32];
#pragma unroll
    for (int e = 0; e < 32; ++e) bn[e] = __builtin_nontemporal_load(wp + (size_t)((e >> 3) * 16 + (e & 7)) * 12288);
#pragma unroll 1
    for (int g4 = 0; g4 < 16; ++g4) {
        float bc[32];
#pragma unroll
        for (int e = 0; e < 32; ++e) bc[e] = bn[e];
        { const int gn = (g4 < 15) ? g4 + 1 : g4; const float* wq = wp + (size_t)(gn * 64) * 12288;
#pragma unroll
          for (int e = 0; e < 32; ++e) bn[e] = __builtin_nontemporal_load(wq + (size_t)((e >> 3) * 16 + (e & 7)) * 12288); }
#pragma unroll
        for (int s4 = 0; s4 < 4; ++s4) { const int ks = g4 * 4 + s4;
            v4u bw; bw.x = pk2(bc[8 * s4], bc[8 * s4 + 1]); bw.y = pk2(bc[8 * s4 + 2], bc[8 * s4 + 3]); bw.z = pk2(bc[8 * s4 + 4], bc[8 * s4 + 5]); bw.w = pk2(bc[8 * s4 + 6], bc[8 * s4 + 7]);
            const bf16x8 bf = __builtin_bit_cast(bf16x8, bw);
#pragma unroll
            for (int mt = 0; mt < 5; ++mt) { const bf16x8 af = *(const bf16x8*)(ap + (size_t)mt * 32 * DM + ks * 16);
                acc[mt] = __builtin_amdgcn_mfma_f32_32x32x16_bf16(af, bf, acc[mt], 0, 0, 0); }
            asm volatile("" ::: "memory"); }
    }
    { const float bias = (kq == 0) ? b_ada[n0 + j] : 0.f;
#pragma unroll
      for (int mt = 0; mt < 5; ++mt)
#pragma unroll
          for (int r = 0; r < 16; ++r) { const int row = 32 * mt + (r & 3) + 8 * (r >> 2) + 4 * hh;
              if (row < NMOD) atomicAdd(MOD + (size_t)row * 12288 + n0 + j, acc[mt][r] + bias); } }
}
constexpr int CW_TRN = 1024, CW_TRN2 = 1088;
template <int WHICH>
__device__ __forceinline__ void transpose_queue(Frame& F, const Args& A, unsigned* ctr) {
    LAS float* scr = (LAS float*)(F.lds + F.wave * 16896);
    const float* w_in = FIN(10); const float* w_pa = FIN(15); const float* w_pb = FIN(16); const float* w_out = FIN(17);
    bf16* WB1 = (bf16*)(F.ws + WS_WB1); bf16* WB2 = (bf16*)(F.ws + WS_WB2); bf16* WB3 = (bf16*)(F.ws + WS_WB3);
    constexpr int I1 = 64 * 168, I2 = 64 * 128, IA = 32 * 64, IB = 32 * 64, IO = 64 * 64;
    constexpr int NITEMS = WHICH == 0 ? (I1 + I2) : (IA + IB + IO);
    volatile LAS unsigned* MISC = (volatile LAS unsigned*)(F.lds + MISC_OFF);
    for (;;) {
        __syncthreads();
        if (F.tid == 0) MISC[17] = __hip_atomic_fetch_add(ctr, 32u, __ATOMIC_RELAXED, __HIP_MEMORY_SCOPE_AGENT);
        __syncthreads();
        const int base = __builtin_amdgcn_readfirstlane((int)MISC[17]);
        if (base >= NITEMS) break;
#pragma unroll 1
        for (int i4 = 0; i4 < 4; ++i4) { const int it = base + i4 * 8 + F.wave; if (it >= NITEMS) break;
            int r = it;
            if (WHICH == 0) {
                if (r < I1) { const int kb = r / 168, nb = r % 168; p0_transpose_item<false>(w_in, PROJ, 64 * kb, 64 * nb, WB1, DM, 64 * nb, 0, scr, F.lane); continue; } r -= I1;
                { const int kb = r / 128, nb = r % 128, gsel = nb >> 6, nb2 = nb & 63;
                  p0_transpose_item<false>(w_in, PROJ, 64 * kb, 10768 + 64 * nb, WB1, DM, 10752 + 256 * (nb2 >> 1) + 128 * gsel + 64 * (nb2 & 1), 0, scr, F.lane); }
            } else {
                if (r < IA) { const int kb = r / 64, nb = r % 64; p0_transpose_item<true>(w_pa, DM, 64 * kb, 64 * nb, WB2, DM, 64 * nb, 0, scr, F.lane); continue; } r -= IA;
                if (r < IB) { const int kb = r / 64, nb = r % 64; p0_transpose_item<true>(w_pb, DM, 64 * kb, 64 * nb, WB2, DM, 64 * nb, 2048, scr, F.lane); continue; } r -= IB;
                { const int kb = r / 64, nb = r % 64; p0_transpose_item<true>(w_out, DM, 64 * kb, 64 * nb, WB3, DM, 64 * nb, 0, scr, F.lane); }
            }
        }
    }
}
__device__ __forceinline__ void phase1(Frame& F, const Args& A, unsigned* ctl) {
    if (F.blk < 192) p1_modgemm(F, A);
    transpose_queue<0>(F, A, ctl + CW_TRN);
    const float* w_in = FIN(10); bf16* WB1 = (bf16*)(F.ws + WS_WB1);
    const size_t gt = (size_t)F.blk * 512 + F.tid, NT = (size_t)F.G * 512;
    for (size_t i = gt; i < (size_t)16 * DM; i += NT) { const int k = (int)(i >> 4), j = (int)(i & 15); WB1[(size_t)(18944 + j) * DM + k] = f2bf(w_in[(size_t)k * PROJ + 10752 + j]); }
    { v4u* z = (v4u*)(WB1 + (size_t)18960 * DM); const v4u zero = {0u, 0u, 0u, 0u}; for (size_t i = gt; i < (size_t)240 * DM * 2 / 16; i += NT) z[i] = zero; }
}

__device__ __forceinline__ const float* xrow_ptr(const float* xp, const float* xs, int row) { return (row < NPR) ? xp + (size_t)row * DM : xs + (size_t)(row - NPR) * DM; }
__device__ __forceinline__ void phase2(Frame& F, const Args& A) {
    const float* xp = FIN(0); const float* xs = FIN(1); const float* ng = FIN(9);
    const float* MOD = (const float*)(F.ws + WS_MOD); bf16* H = (bf16*)(F.ws + WS_H);
    const int gw = F.blk * NWAVES + F.wave, NGW = F.G * NWAVES;
    if (gw >= NROW) return;
    f32x4 v[16], vn[16];
    { const float* xr = xrow_ptr(xp, xs, gw) + 4 * F.lane;
#pragma unroll
      for (int q = 0; q < 16; ++q) v[q] = __builtin_nontemporal_load((const f32x4*)(xr + 256 * q)); }
#pragma unroll 1
    for (int row = gw; row < NROW; row += NGW) {
        { const int rn = (row + NGW < NROW) ? row + NGW : row; const float* xr = xrow_ptr(xp, xs, rn) + 4 * F.lane;
#pragma unroll
          for (int q = 0; q < 16; ++q) vn[q] = __builtin_nontemporal_load((const f32x4*)(xr + 256 * q)); }
        const int seq = (row < NPR) ? (row >> 12) : 2 + ((row - NPR) >> 3);
        const float* sh = MOD + (size_t)seq * 12288; const float* sc = sh + 4096;
        float s = 0.f;
#pragma unroll
        for (int q = 0; q < 16; ++q) s += (v[q][0] * v[q][0] + v[q][1] * v[q][1]) + (v[q][2] * v[q][2] + v[q][3] * v[q][3]);
        const float rstd = rsqrtf(wave_sum(s) * (1.0f / DM) + EPS);
#pragma unroll
        for (int q = 0; q < 16; ++q) { const int c = 4 * (F.lane + 64 * q);
            const f32x4 g = *(const f32x4*)(ng + c), a = *(const f32x4*)(sc + c), b = *(const f32x4*)(sh + c);
            const f32x4 h = (v[q] * rstd * g) * (a + 1.0f) + b;
            v2u o; o.x = pk2(h[0], h[1]); o.y = pk2(h[2], h[3]);
            *(v2u*)(H + (size_t)row * DM + c) = o;
            if ((q & 3) == 3) asm volatile("" ::: "memory"); }
#pragma unroll
        for (int q = 0; q < 16; ++q) v[q] = vn[q];
    }
}

#define MFMA16(a, b, c) __builtin_amdgcn_mfma_f32_16x16x32_bf16((a), (b), (c), 0, 0, 0)

constexpr int SWA_VS = 280;
__device__ __forceinline__ void swa_prompt_unit(Frame& F, const Args& A, int unit) {
    const int b = unit >> 7, i = (unit >> 2) & 31, g = unit & 3;
    const bf16* QA = (const bf16*)(F.ws + WS_QA); const bf16* KA = (const bf16*)(F.ws + WS_KA); const bf16* VA = (const bf16*)(F.ws + WS_VA);
    const bf16* ZA = (const bf16*)(F.ws + WS_ZA); bf16* AB = (bf16*)(F.ws + WS_AB);
    LAS unsigned char* Ks = F.lds;
    LAS bf16* VTs = (LAS bf16*)(F.lds + 36864);
    __syncthreads();
#pragma unroll
    for (int q = 0; q < 4; ++q) { const int p = F.tid + 512 * q, row = p >> 3, c = p & 7; const int tok = (i - 1) * 128 + row;
        v4u kv = {0u, 0u, 0u, 0u}, vv = {0u, 0u, 0u, 0u};
        if (tok >= 0) { const size_t off = (size_t)(b * SEQ + tok) * 256 + g * 64 + c * 8; kv = *(const v4u*)(KA + off); vv = *(const v4u*)(VA + off); }
        *(LAS v4u*)(Ks + row * 144 + c * 16) = kv;
        LAS bf16* vt = VTs + (c * 8) * SWA_VS + row;
        vt[0 * SWA_VS] = (bf16)(vv.x & 0xffff); vt[1 * SWA_VS] = (bf16)(vv.x >> 16); vt[2 * SWA_VS] = (bf16)(vv.y & 0xffff); vt[3 * SWA_VS] = (bf16)(vv.y >> 16);
        vt[4 * SWA_VS] = (bf16)(vv.z & 0xffff); vt[5 * SWA_VS] = (bf16)(vv.z >> 16); vt[6 * SWA_VS] = (bf16)(vv.w & 0xffff); vt[7 * SWA_VS] = (bf16)(vv.w >> 16); }
    if (F.tid < 192) { const int d = F.tid / 3, q = F.tid % 3; *(LAS v4u*)(VTs + d * SWA_VS + 256 + 8 * q) = (v4u){0u, 0u, 0u, 0u}; }
    __syncthreads();
    const int hq = g * 8 + F.wave, c = F.lane & 15, gg = F.lane >> 4;
    const float sink = FIN(11)[hq];
    const size_t qbase = (size_t)b * SEQ + i * 128;
    bf16x8 bq[2], bqn[2];
#pragma unroll
    for (int ks = 0; ks < 2; ++ks) bq[ks] = *(const bf16x8*)(QA + (qbase + c) * 2048 + hq * 64 + ks * 32 + 8 * gg);
#pragma unroll 1
    for (int sub = 0; sub < 8; ++sub) {
        const size_t qrow = qbase + sub * 16 + c;
        { const int sn = (sub < 7) ? sub + 1 : sub;
#pragma unroll
          for (int ks = 0; ks < 2; ++ks) bqn[ks] = *(const bf16x8*)(QA + (qbase + sn * 16 + c) * 2048 + hq * 64 + ks * 32 + 8 * gg); }
        v2u zaw[4];
#pragma unroll
        for (int nt = 0; nt < 4; ++nt) zaw[nt] = *(const v2u*)(ZA + qrow * 2048 + hq * 64 + 16 * nt + 4 * gg);
        f32x4 s[10];
        const LAS unsigned char* kp = Ks + (16 * sub + c) * 144 + 16 * gg;
#pragma unroll
        for (int x = 0; x < 9; ++x) { f32x4 a = {0.f, 0.f, 0.f, 0.f};
#pragma unroll
            for (int ks = 0; ks < 2; ++ks) { const bf16x8 ak = *(const LAS bf16x8*)(kp + x * 16 * 144 + ks * 64); a = MFMA16(ak, bq[ks], a); }
            s[x] = a; if ((x & 3) == 3) asm volatile("" ::: "memory"); }
        s[9] = (f32x4){0.f, 0.f, 0.f, 0.f};
        float m = sink;
#pragma unroll
        for (int x = 0; x < 9; ++x) { const bool tile_ok = (i > 0) || (sub + x >= 8);
#pragma unroll
            for (int r = 0; r < 4; ++r) { bool valid = tile_ok; if (x == 0) valid = valid && (4 * gg + r >= c); if (x == 8) valid = valid && (4 * gg + r <= c);
                const float v = valid ? s[x][r] * 0.125f : -1e30f; s[x][r] = v; m = fmaxf(m, v); } }
        m = fmaxf(m, __shfl_xor(m, 16)); m = fmaxf(m, __shfl_xor(m, 32));
        float sum = 0.f;
#pragma unroll
        for (int x = 0; x < 9; ++x)
#pragma unroll
            for (int r = 0; r < 4; ++r) { const float p = (s[x][r] > -1e29f) ? __expf(s[x][r] - m) : 0.f; s[x][r] = p; sum += p; }
        sum += __shfl_xor(sum, 16); sum += __shfl_xor(sum, 32);
        const float inv = 1.0f / (sum + __expf(sink - m));
        f32x4 o[4];
#pragma unroll
        for (int nt = 0; nt < 4; ++nt) o[nt] = (f32x4){0.f, 0.f, 0.f, 0.f};
        const LAS bf16* vbase = VTs + c * SWA_VS + 16 * sub + 4 * gg;
#pragma unroll
        for (int jp = 0; jp < 5; ++jp) { v4u pw; pw.x = pk2(s[2 * jp][0], s[2 * jp][1]); pw.y = pk2(s[2 * jp][2], s[2 * jp][3]); pw.z = pk2(s[2 * jp + 1][0], s[2 * jp + 1][1]); pw.w = pk2(s[2 * jp + 1][2], s[2 * jp + 1][3]);
            const bf16x8 pb = __builtin_bit_cast(bf16x8, pw);
#pragma unroll
            for (int nt = 0; nt < 4; ++nt) { const LAS bf16* vp = vbase + 16 * nt * SWA_VS + 32 * jp;
                const v2u v0 = *(const LAS v2u*)(vp), v1 = *(const LAS v2u*)(vp + 16);
                v4u vw; vw.x = v0.x; vw.y = v0.y; vw.z = v1.x; vw.w = v1.y;
                o[nt] = MFMA16(__builtin_bit_cast(bf16x8, vw), pb, o[nt]); }
            asm volatile("" ::: "memory"); }
#pragma unroll
        for (int nt = 0; nt < 4; ++nt) { v2u w; w.x = pk2(o[nt][0] * inv * bflo(zaw[nt].x), o[nt][1] * inv * bfhi(zaw[nt].x)); w.y = pk2(o[nt][2] * inv * bflo(zaw[nt].y), o[nt][3] * inv * bfhi(zaw[nt].y));
            *(v2u*)(AB + qrow * DM + hq * 64 + 16 * nt + 4 * gg) = w; }
        bq[0] = bqn[0]; bq[1] = bqn[1];
    }
}

__device__ __forceinline__ void swa_sample_unit(Frame& F, const Args& A, int unit) {
    const int n = unit >> 2, g = unit & 3;
    const bf16* QA = (const bf16*)(F.ws + WS_QA); const bf16* KA = (const bf16*)(F.ws + WS_KA); const bf16* VA = (const bf16*)(F.ws + WS_VA);
    const bf16* ZA = (const bf16*)(F.ws + WS_ZA); bf16* AB = (bf16*)(F.ws + WS_AB);
    const float* ck = FIN(2); const float* cv = FIN(3);
    LAS unsigned char* Ks = F.lds;
    LAS bf16* VTs = (LAS bf16*)(F.lds + 23040);
    const int hq = g * 8 + F.wave, c = F.lane & 15, gg = F.lane >> 4, tq = c & 7;
    const size_t qrow0 = (size_t)NPR + n * 8;
    bf16x8 bq[2]; v2u zaw[4];
#pragma unroll
    for (int ks = 0; ks < 2; ++ks) bq[ks] = *(const bf16x8*)(QA + (qrow0 + tq) * 2048 + hq * 64 + ks * 32 + 8 * gg);
#pragma unroll
    for (int nt = 0; nt < 4; ++nt) zaw[nt] = *(const v2u*)(ZA + (qrow0 + tq) * 2048 + hq * 64 + 16 * nt + 4 * gg);
    __syncthreads();
#pragma unroll
    for (int q = 0; q < 4; ++q) { const int p = F.tid + 512 * q, row = p >> 4, c4 = p & 15;
        const size_t off = ((size_t)(n * 128 + row) * 4 + g) * 64 + c4 * 4;
        const f32x4 kv = *(const f32x4*)(ck + off), vv = *(const f32x4*)(cv + off);
        v2u kw; kw.x = pk2(kv[0], kv[1]); kw.y = pk2(kv[2], kv[3]);
        *(LAS v2u*)(Ks + row * 144 + c4 * 8) = kw;
        LAS bf16* vt = VTs + (c4 * 4) * 168 + row;
        vt[0] = f2bf(vv[0]); vt[168] = f2bf(vv[1]); vt[336] = f2bf(vv[2]); vt[504] = f2bf(vv[3]);
        if (row >= 8) { const size_t oo = ((size_t)(n * 128 + row - 8) * 4 + g) * 64 + c4 * 4; *(f32x4*)(F.out + OUT_KWS + oo) = kv; *(f32x4*)(F.out + OUT_VWS + oo) = vv; } }
    if (F.tid < 256) { const int row = 128 + (F.tid >> 3), c = F.tid & 7;
        v4u kv = {0u, 0u, 0u, 0u}, vv = {0u, 0u, 0u, 0u};
        if (row < 136) { const size_t off = (size_t)(NPR + n * 8 + row - 128) * 256 + g * 64 + c * 8; kv = *(const v4u*)(KA + off); vv = *(const v4u*)(VA + off);
            const size_t oo = ((size_t)(n * 128 + row - 8) * 4 + g) * 64 + c * 8;
            *(f32x4*)(F.out + OUT_KWS + oo) = (f32x4){bflo(kv.x), bfhi(kv.x), bflo(kv.y), bfhi(kv.y)}; *(f32x4*)(F.out + OUT_KWS + oo + 4) = (f32x4){bflo(kv.z), bfhi(kv.z), bflo(kv.w), bfhi(kv.w)};
            *(f32x4*)(F.out + OUT_VWS + oo) = (f32x4){bflo(vv.x), bfhi(vv.x), bflo(vv.y), bfhi(vv.y)}; *(f32x4*)(F.out + OUT_VWS + oo + 4) = (f32x4){bflo(vv.z), bfhi(vv.z), bflo(vv.w), bfhi(vv.w)}; }
        *(LAS v4u*)(Ks + row * 144 + c * 16) = kv;
        LAS bf16* vt = VTs + (c * 8) * 168 + row;
        vt[0 * 168] = (bf16)(vv.x & 0xffff); vt[1 * 168] = (bf16)(vv.x >> 16); vt[2 * 168] = (bf16)(vv.y & 0xffff); vt[3 * 168] = (bf16)(vv.y >> 16);
        vt[4 * 168] = (bf16)(vv.z & 0xffff); vt[5 * 168] = (bf16)(vv.z >> 16); vt[6 * 168] = (bf16)(vv.w & 0xffff); vt[7 * 168] = (bf16)(vv.w >> 16); }
    __syncthreads();
    const float sink = FIN(11)[hq];
    f32x4 s[10];
#pragma unroll
    for (int kt = 0; kt < 10; ++kt) { f32x4 a = {0.f, 0.f, 0.f, 0.f};
#pragma unroll
        for (int ks = 0; ks < 2; ++ks) { const bf16x8 ak = *(const LAS bf16x8*)(Ks + (16 * kt + c) * 144 + (ks * 32 + 8 * gg) * 2); a = MFMA16(ak, bq[ks], a); }
        s[kt] = a; if ((kt & 3) == 3) asm volatile("" ::: "memory"); }
    float m = sink;
#pragma unroll
    for (int kt = 0; kt < 10; ++kt)
#pragma unroll
        for (int r = 0; r < 4; ++r) { const int kk = 16 * kt + 4 * gg + r; const bool valid = (kk >= tq) && (kk <= tq + 128) && (kk < 136);
            const float v = valid ? s[kt][r] * 0.125f : -1e30f; s[kt][r] = v; m = fmaxf(m, v); }
    m = fmaxf(m, __shfl_xor(m, 16)); m = fmaxf(m, __shfl_xor(m, 32));
    float sum = 0.f;
#pragma unroll
    for (int kt = 0; kt < 10; ++kt)
#pragma unroll
        for (int r = 0; r < 4; ++r) { const float p = (s[kt][r] > -1e29f) ? __expf(s[kt][r] - m) : 0.f; s[kt][r] = p; sum += p; }
    sum += __shfl_xor(sum, 16); sum += __shfl_xor(sum, 32);
    const float inv = 1.0f / (sum + __expf(sink - m));
    f32x4 o[4];
#pragma unroll
    for (int nt = 0; nt < 4; ++nt) o[nt] = (f32x4){0.f, 0.f, 0.f, 0.f};
#pragma unroll
    for (int j = 0; j < 5; ++j) { v4u pw; pw.x = pk2(s[2 * j][0], s[2 * j][1]); pw.y = pk2(s[2 * j][2], s[2 * j][3]); pw.z = pk2(s[2 * j + 1][0], s[2 * j + 1][1]); pw.w = pk2(s[2 * j + 1][2], s[2 * j + 1][3]);
        const bf16x8 pa = __builtin_bit_cast(bf16x8, pw);
#pragma unroll
        for (int nt = 0; nt < 4; ++nt) { const LAS bf16* vp = VTs + (16 * nt + c) * 168 + 32 * j + 4 * gg;
            const v2u v0 = *(const LAS v2u*)(vp), v1 = *(const LAS v2u*)(vp + 16);
            v4u vw; vw.x = v0.x; vw.y = v0.y; vw.z = v1.x; vw.w = v1.y;
            o[nt] = MFMA16(__builtin_bit_cast(bf16x8, vw), pa, o[nt]); }
        asm volatile("" ::: "memory"); }
    if (c < 8) {
#pragma unroll
        for (int nt = 0; nt < 4; ++nt) { v2u w; w.x = pk2(o[nt][0] * inv * bflo(zaw[nt].x), o[nt][1] * inv * bfhi(zaw[nt].x)); w.y = pk2(o[nt][2] * inv * bflo(zaw[nt].y), o[nt][3] * inv * bfhi(zaw[nt].y));
            *(v2u*)(AB + (qrow0 + c) * DM + hq * 64 + 16 * nt + 4 * gg) = w; } }
}

__device__ __forceinline__ float log_sigmoid_(float x) { return fminf(x, 0.f) - __logf(1.0f + __expf(-fabsf(x))); }

__device__ __forceinline__ void gla_prep_unit(Frame& F, const Args& A, int unit) {
    const int n = unit >> 8, h = (unit >> 6) & 3, ch = unit & 63;
    const size_t row0 = (size_t)n * SEQ + ch * 64;
    const bf16* QB = (const bf16*)(F.ws + WS_QB); const bf16* KB = (const bf16*)(F.ws + WS_KB); const bf16* VB = (const bf16*)(F.ws + WS_VB);
    const float* R = (const float*)(F.ws + WS_R); const float* w2 = FIN(12); const float* ba = FIN(13);
    bf16* QT = (bf16*)(F.ws + WS_QT) + (size_t)unit * 64 * 256; bf16* KDT = (bf16*)(F.ws + WS_KDT) + (size_t)unit * 256 * 64;
    bf16* ATT = (bf16*)(F.ws + WS_ATT) + (size_t)unit * 64 * 64; bf16* VT = (bf16*)(F.ws + WS_VT) + (size_t)unit * 512 * 64; float* DEC = (float*)(F.ws + WS_DEC) + (size_t)unit * 256;
    LAS float* Rs = (LAS float*)F.lds;
    LAS float* TOT = (LAS float*)(F.lds + 4096);
    LAS unsigned char* Vs = F.lds + 8192;
    LAS bf16* QS = (LAS bf16*)(F.lds + 8192);
    LAS bf16* KS = (LAS bf16*)(F.lds + 8192 + 33792);
    LAS float* BS = (LAS float*)(F.lds + 8192 + 67584);
    int tz = F.tid; asm volatile("" : "+v"(tz));
    v4u vreg[8], qreg[4], kreg[4]; f32x4 rreg = {0.f, 0.f, 0.f, 0.f};
#pragma unroll
    for (int q = 0; q < 8; ++q) { const int p = tz + 512 * q, row = p >> 6, c = p & 63; vreg[q] = *(const v4u*)(VB + (row0 + row) * 2048 + h * 512 + c * 8); }
#pragma unroll
    for (int q = 0; q < 4; ++q) { const int p = tz + 512 * q, row = p >> 5, c = p & 31; const size_t off = (row0 + row) * 1024 + h * 256 + c * 8; qreg[q] = *(const v4u*)(QB + off); kreg[q] = *(const v4u*)(KB + off); }
    if (tz < 256) rreg = *(const f32x4*)(R + row0 * 16 + tz * 4);
    __syncthreads();
    if (tz < 256) *(LAS f32x4*)(Rs + tz * 4) = rreg;
#pragma unroll
    for (int q = 0; q < 8; ++q) { const int p = tz + 512 * q, row = p >> 6, c = p & 63; *(LAS v4u*)(Vs + row * 1040 + c * 16) = vreg[q]; }
    __syncthreads();
    { const LAS bf16* vcol = (const LAS bf16*)Vs + tz;
#pragma unroll
      for (int t8 = 0; t8 < 8; ++t8) { unsigned e[8];
#pragma unroll
          for (int k = 0; k < 8; ++k) e[k] = vcol[(t8 * 8 + k) * 520];
          v4u o; o.x = e[0] | (e[1] << 16); o.y = e[2] | (e[3] << 16); o.z = e[4] | (e[5] << 16); o.w = e[6] | (e[7] << 16);
          *(v4u*)(VT + (size_t)tz * 64 + t8 * 8) = o; } }
    const int dk = tz & 255, half = tz >> 8;
    { float wv[16];
#pragma unroll
      for (int j = 0; j < 16; ++j) wv[j] = w2[j * 1024 + h * 256 + dk];
      const float bias = ba[h * 256 + dk];
      float run = 0.f;
#pragma unroll 4
      for (int tt = 0; tt < 32; ++tt) { const int t = half * 32 + tt; const LAS float* rr = Rs + t * 16; float x = bias;
#pragma unroll
          for (int j4 = 0; j4 < 4; ++j4) { const f32x4 rv = *(const LAS f32x4*)(rr + 4 * j4); x += rv[0] * wv[4 * j4] + rv[1] * wv[4 * j4 + 1] + rv[2] * wv[4 * j4 + 2] + rv[3] * wv[4 * j4 + 3]; }
          run += log_sigmoid_(x) * 0.0625f; BS[t * 256 + dk] = run; }
      TOT[half * 256 + dk] = run; }
    __syncthreads();
#pragma unroll
    for (int q = 0; q < 4; ++q) { const int p = tz + 512 * q, row = p >> 5, c = p & 31; *(LAS v4u*)(QS + row * 264 + c * 8) = qreg[q]; *(LAS v4u*)(KS + row * 264 + c * 8) = kreg[q]; }
    __syncthreads();
    { const float tot0 = TOT[dk], tot1 = TOT[256 + dk];
      const float off = half ? tot0 : 0.f, blast = tot0 + tot1;
#pragma unroll 1
      for (int q8 = 0; q8 < 4; ++q8) { unsigned kd[4];
#pragma unroll
          for (int e = 0; e < 8; ++e) { const int t = half * 32 + q8 * 8 + e;
              const float b = BS[t * 256 + dk] + off;
              const float q = bf2f(QS[t * 264 + dk]), k = bf2f(KS[t * 264 + dk]);
              const bf16 qt = f2bf(q * __expf(b) * 0.0625f), kt = f2bf(k * __expf(-b)); const unsigned kdv = f2bf(k * __expf(blast - b));
              QS[t * 264 + dk] = qt; KS[t * 264 + dk] = kt;
              if (e & 1) kd[e >> 1] |= kdv << 16; else kd[e >> 1] = kdv; }
          v4u o; o.x = kd[0]; o.y = kd[1]; o.z = kd[2]; o.w = kd[3]; *(v4u*)(KDT + (size_t)dk * 64 + half * 32 + 8 * q8) = o; }
      if (half == 0) DEC[dk] = __expf(blast); }
    __syncthreads();
#pragma unroll
    for (int q = 0; q < 4; ++q) { const int p = tz + 512 * q, t = p >> 5, c = p & 31, jb = c >> 2, g4 = c & 3;
        const LAS bf16* sp = QS + t * 264 + 32 * jb + 4 * g4;
        const v2u lo = *(const LAS v2u*)(sp), hi = *(const LAS v2u*)(sp + 16);
        v4u o; o.x = lo.x; o.y = lo.y; o.z = hi.x; o.w = hi.y;
        *(v4u*)(QT + (size_t)t * 256 + c * 8) = o; }
    { const int c = tz & 15, gg = (tz >> 4) & 3;
#pragma unroll
      for (int x = 0; x < 2; ++x) { const int id = F.wave * 2 + x, ti = id >> 2, si = id & 3;
          f32x4 a = {0.f, 0.f, 0.f, 0.f};
          if (si <= ti) {
#pragma unroll
              for (int ks = 0; ks < 8; ++ks) { const bf16x8 ak = *(const LAS bf16x8*)(KS + (16 * si + c) * 264 + ks * 32 + 8 * gg), bqv = *(const LAS bf16x8*)(QS + (16 * ti + c) * 264 + ks * 32 + 8 * gg);
                  a = MFMA16(ak, bqv, a); } }
          const int t = 16 * ti + c, s0 = 16 * si + 4 * gg;
          v2u o; o.x = pk2(s0 <= t ? a[0] : 0.f, s0 + 1 <= t ? a[1] : 0.f); o.y = pk2(s0 + 2 <= t ? a[2] : 0.f, s0 + 3 <= t ? a[3] : 0.f);
          *(v2u*)(ATT + (size_t)t * 64 + s0) = o; } }
}

__device__ __forceinline__ void win_prompt(Frame& F, const Args& A) {
    const bf16* KA = (const bf16*)(F.ws + WS_KA); const bf16* VA = (const bf16*)(F.ws + WS_VA);
    const size_t gt = (size_t)F.blk * 512 + F.tid, NT = (size_t)F.G * 512;
    for (size_t i = gt; i < 65536; i += NT) { const int b = (int)(i >> 15), rem = (int)(i & 32767); const size_t src = (size_t)(b * SEQ + SEQ - 128) * 256 + rem;
        F.out[OUT_KWP + i] = bf2f(KA[src]); F.out[OUT_VWP + i] = bf2f(VA[src]); }
}

constexpr int SEQ_QT = 0, SEQ_KD = 32768, SEQ_AT = 65536, SEQ_DC = 73728, SEQ_BUF = 74752;
constexpr int SEQ_CW = 2;
constexpr int SEQ_DVG = 512 / (16 * SEQ_CW);
#define SEQ_BARRIER() do { asm volatile("s_waitcnt lgkmcnt(0)" ::: "memory"); __builtin_amdgcn_s_barrier(); asm volatile("" ::: "memory"); } while (0)
__device__ __forceinline__ void gla_seq_unit(Frame& F, const Args& A, int unit) {
    const int nh = unit & 7, dvg = unit >> 3, n = nh >> 2, h = nh & 3;
    const bf16* QTg = (const bf16*)(F.ws + WS_QT) + (size_t)nh * 64 * 16384;
    const bf16* KDg = (const bf16*)(F.ws + WS_KDT) + (size_t)nh * 64 * 16384;
    const bf16* ATg = (const bf16*)(F.ws + WS_ATT) + (size_t)nh * 64 * 4096;
    const float* DCg = (const float*)(F.ws + WS_DEC) + (size_t)nh * 64 * 256;
    const bf16* VTg = (const bf16*)(F.ws + WS_VT) + (size_t)nh * 64 * 32768;
    __syncthreads();
    if (F.wave >= 4) {
        const int lt = F.tid - 256;
        v4u rq[2][8], rk[2][8], ra[2][2]; f32x4 rd[2] = {{0.f, 0.f, 0.f, 0.f}, {0.f, 0.f, 0.f, 0.f}};
#define SEQ_LOAD(sx, chx) do { const bf16* q_ = QTg + (size_t)(chx) * 16384; const bf16* k_ = KDg + (size_t)(chx) * 16384; const bf16* a_ = ATg + (size_t)(chx) * 4096; \
        _Pragma("unroll") for (int i = 0; i < 8; ++i) { rq[sx][i] = *(const v4u*)(q_ + (size_t)(lt + 256 * i) * 8); rk[sx][i] = *(const v4u*)(k_ + (size_t)(lt + 256 * i) * 8); } \
        _Pragma("unroll") for (int i = 0; i < 2; ++i) ra[sx][i] = *(const v4u*)(a_ + (size_t)(lt + 256 * i) * 8); \
        if (lt < 64) rd[sx] = *(const f32x4*)(DCg + (size_t)(chx) * 256 + lt * 4); } while (0)
#define SEQ_WRITE(sx, bufx) do { LAS unsigned char* b_ = F.lds + (bufx) * SEQ_BUF; \
        _Pragma("unroll") for (int i = 0; i < 8; ++i) { const int p = lt + 256 * i; \
            { const int row = p >> 5, slot = p & 31; *(LAS v4u*)(b_ + SEQ_QT + row * 512 + ((slot ^ (row & 15)) << 4)) = rq[sx][i]; } \
            { const int row = p >> 3, slot = p & 7;  *(LAS v4u*)(b_ + SEQ_KD + row * 128 + ((slot ^ ((row >> 1) & 7)) << 4)) = rk[sx][i]; } } \
        _Pragma("unroll") for (int i = 0; i < 2; ++i) { const int p = lt + 256 * i, row = p >> 3, slot = p & 7; *(LAS v4u*)(b_ + SEQ_AT + row * 128 + ((slot ^ ((row >> 1) & 7)) << 4)) = ra[sx][i]; } \
        if (lt < 64) *(LAS f32x4*)(b_ + SEQ_DC + lt * 16) = rd[sx]; } while (0)
        SEQ_LOAD(0, 0); SEQ_WRITE(0, 0); SEQ_LOAD(1, 1); SEQ_LOAD(0, 2);
        SEQ_BARRIER();
        for (int ch = 0; ch < 64; ch += 2) {
            SEQ_WRITE(1, 1); if (ch + 3 < 64) SEQ_LOAD(1, ch + 3);
            SEQ_BARRIER();
            if (ch + 2 < 64) { SEQ_WRITE(0, 0); if (ch + 4 < 64) SEQ_LOAD(0, ch + 4); }
            SEQ_BARRIER();
        }
#undef SEQ_LOAD
#undef SEQ_WRITE
    } else if (F.wave >= SEQ_CW) {
        for (int ch = 0; ch < 65; ++ch) SEQ_BARRIER();
    } else {
        const int c = F.lane & 15, gg = F.lane >> 4, sa = (c >> 1) & 7;
        const int dv0 = dvg * (16 * SEQ_CW) + F.wave * 16;
        float* OB = (float*)(F.ws + WS_OB);
        f32x4 S[16];
#pragma unroll
        for (int i = 0; i < 16; ++i) S[i] = (f32x4){0.f, 0.f, 0.f, 0.f};
        const bf16* vtp = VTg + (size_t)(dv0 + c) * 64 + 8 * gg;
        bf16x8 vf[2], vn[2];
#pragma unroll
        for (int j = 0; j < 2; ++j) vf[j] = *(const bf16x8*)(vtp + 32 * j);
        SEQ_BARRIER();
        for (int ch = 0; ch < 64; ++ch) {
            const LAS unsigned char* b_ = F.lds + (ch & 1) * SEQ_BUF;
            { const int cn = (ch + 1 < 64) ? ch + 1 : ch;
#pragma unroll
              for (int j = 0; j < 2; ++j) vn[j] = *(const bf16x8*)(vtp + (size_t)cn * 32768 + 32 * j); }
#define SEQ_LDQ(dst, jx) do { _Pragma("unroll") for (int mt = 0; mt < 4; ++mt) dst[mt] = *(const LAS bf16x8*)(b_ + SEQ_QT + (16 * mt + c) * 512 + (((4 * (jx) + gg) ^ c) << 4)); } while (0)
#define SEQ_LDK(kd_, dd_, gx) do { _Pragma("unroll") for (int e = 0; e < 2; ++e) { dd_[e] = *(const LAS f32x4*)(b_ + SEQ_DC + (16 * (2 * (gx) + e) + 4 * gg) * 4); \
            _Pragma("unroll") for (int j = 0; j < 2; ++j) kd_[e][j] = *(const LAS bf16x8*)(b_ + SEQ_KD + (16 * (2 * (gx) + e) + c) * 128 + (((4 * j + gg) ^ sa) << 4)); } } while (0)
            f32x4 o[4];
            bf16x8 af[4][2], qf[2][4];
#pragma unroll
            for (int mt = 0; mt < 4; ++mt)
#pragma unroll
                for (int j = 0; j < 2; ++j) af[mt][j] = *(const LAS bf16x8*)(b_ + SEQ_AT + (16 * mt + c) * 128 + (((4 * j + gg) ^ sa) << 4));
            SEQ_LDQ(qf[0], 0);
            __builtin_amdgcn_sched_barrier(0);
#pragma unroll
            for (int mt = 0; mt < 4; ++mt) { f32x4 a = {0.f, 0.f, 0.f, 0.f}; a = MFMA16(af[mt][0], vf[0], a); a = MFMA16(af[mt][1], vf[1], a); o[mt] = a; }
            bf16x8 kf[2][2][2]; f32x4 dd[2][2];
#pragma unroll
            for (int j = 0; j < 8; ++j) {
                if (j < 7) SEQ_LDQ(qf[(j + 1) & 1], j + 1); else SEQ_LDK(kf[0], dd[0], 0);
                v4u sw; sw.x = pk2(S[2 * j][0], S[2 * j][1]); sw.y = pk2(S[2 * j][2], S[2 * j][3]); sw.z = pk2(S[2 * j + 1][0], S[2 * j + 1][1]); sw.w = pk2(S[2 * j + 1][2], S[2 * j + 1][3]);
                const bf16x8 sb = __builtin_bit_cast(bf16x8, sw);
                __builtin_amdgcn_sched_barrier(0);
#pragma unroll
                for (int mt = 0; mt < 4; ++mt) o[mt] = MFMA16(qf[j & 1][mt], sb, o[mt]);
                __builtin_amdgcn_sched_barrier(0);
            }
#pragma unroll
            for (int g2 = 0; g2 < 8; ++g2) {
                if (g2 < 7) SEQ_LDK(kf[(g2 + 1) & 1], dd[(g2 + 1) & 1], g2 + 1);
                __builtin_amdgcn_sched_barrier(0);
#pragma unroll
                for (int e = 0; e < 2; ++e) { f32x4 a = S[2 * g2 + e] * dd[g2 & 1][e]; a = MFMA16(kf[g2 & 1][e][0], vf[0], a); a = MFMA16(kf[g2 & 1][e][1], vf[1], a); S[2 * g2 + e] = a; }
                __builtin_amdgcn_sched_barrier(0);
            }
#undef SEQ_LDQ
#undef SEQ_LDK
#pragma unroll
            for (int mt = 0; mt < 4; ++mt)
#pragma unroll
                for (int r = 0; r < 4; ++r) OB[((size_t)n * SEQ + ch * 64 + 16 * mt + 4 * gg + r) * 2048 + h * 512 + dv0 + c] = o[mt][r];
            vf[0] = vn[0]; vf[1] = vn[1];
            SEQ_BARRIER();
        }
        float* gsp = F.out + OUT_GSP + (size_t)nh * 256 * 512;
#pragma unroll
        for (int i = 0; i < 16; ++i)
#pragma unroll
            for (int r = 0; r < 4; ++r) gsp[(size_t)(16 * i + 4 * gg + r) * 512 + dv0 + c] = S[i][r];
    }
}

__device__ __forceinline__ void gla_sample_unit(Frame& F, const Args& A, int unit) {
    const int n = unit >> 2, h = unit & 3;
    const size_t row0 = (size_t)NPR + n * 8;
    const bf16* QB = (const bf16*)(F.ws + WS_QB); const bf16* KB = (const bf16*)(F.ws + WS_KB); const bf16* VB = (const bf16*)(F.ws + WS_VB); const bf16* ZB = (const bf16*)(F.ws + WS_ZB);
    const float* R = (const float*)(F.ws + WS_R); const float* w2 = FIN(12); const float* ba = FIN(13); const float* gg_ = FIN(14);
    bf16* AB = (bf16*)(F.ws + WS_AB);
    LAS float* QTs = (LAS float*)F.lds;
    LAS float* KDs = (LAS float*)(F.lds + 8192);
    LAS float* KTs = (LAS float*)(F.lds + 16384);
    LAS float* DCs = (LAS float*)(F.lds + 24576);
    LAS float* ATs = (LAS float*)(F.lds + 25600);
    LAS float* Rs  = (LAS float*)(F.lds + 25856);
    LAS float* RED = (LAS float*)(F.lds + 26624);
    int tz = F.tid; asm volatile("" : "+v"(tz));
    const int dv4 = (tz & 127) * 4, dkq = tz >> 7;
    const float* s0p = FIN(4) + (size_t)unit * 256 * 512 + (size_t)dkq * 512 + dv4;
    float* s1p = F.out + OUT_GSS + (size_t)unit * 256 * 512 + (size_t)dkq * 512 + dv4;
    f32x4 sb[8];
    const float* lp = s0p;
#pragma unroll
    for (int k = 0; k < 8; ++k) { sb[k] = __builtin_nontemporal_load((const f32x4*)lp); lp += 2048; asm volatile("" : "+v"(lp)); }
    SEQ_BARRIER();
    if (F.tid < 32) *(LAS f32x4*)(Rs + F.tid * 4) = *(const f32x4*)(R + row0 * 16 + F.tid * 4);
    SEQ_BARRIER();
    if (F.tid < 256) { const int dk = F.tid;
        float wv[16];
#pragma unroll
        for (int j = 0; j < 16; ++j) wv[j] = w2[j * 1024 + h * 256 + dk];
        const float bias = ba[h * 256 + dk];
        float b[8]; float run = 0.f;
#pragma unroll
        for (int t = 0; t < 8; ++t) { const LAS float* rr = Rs + t * 16; float x = bias;
#pragma unroll
            for (int j4 = 0; j4 < 4; ++j4) { const f32x4 rv = *(const LAS f32x4*)(rr + 4 * j4); x += rv[0] * wv[4 * j4] + rv[1] * wv[4 * j4 + 1] + rv[2] * wv[4 * j4 + 2] + rv[3] * wv[4 * j4 + 3]; }
            run += log_sigmoid_(x) * 0.0625f; b[t] = run; asm volatile("" ::: "memory"); }
        const float blast = run;
#pragma unroll
        for (int t = 0; t < 8; ++t) { const float q = bf2f(QB[(row0 + t) * 1024 + h * 256 + dk]), k = bf2f(KB[(row0 + t) * 1024 + h * 256 + dk]);
            QTs[dk * 8 + t] = q * __expf(b[t]) * 0.0625f; KTs[dk * 8 + t] = k * __expf(-b[t]); KDs[dk * 8 + t] = k * __expf(blast - b[t]); }
        DCs[dk] = __expf(blast);
    }
    SEQ_BARRIER();
    { const int t = F.wave; float a[8];
#pragma unroll
      for (int s = 0; s < 8; ++s) a[s] = 0.f;
#pragma unroll
      for (int q = 0; q < 4; ++q) { const int dk = F.lane + 64 * q; const float qv = QTs[dk * 8 + t];
#pragma unroll
          for (int s = 0; s < 8; ++s) a[s] += qv * KTs[dk * 8 + s]; }
#pragma unroll
      for (int s = 0; s < 8; ++s) { const float v = wave_sum(a[s]); if (F.lane == 0) ATs[t * 8 + s] = (s <= t) ? v : 0.f; } }
    f32x4 vv[8];
#pragma unroll
    for (int s = 0; s < 8; ++s) { const v2u w = *(const v2u*)(VB + (row0 + s) * 2048 + h * 512 + dv4); vv[s] = (f32x4){bflo(w.x), bfhi(w.x), bflo(w.y), bfhi(w.y)}; }
    f32x4 oa[8];
#pragma unroll
    for (int t = 0; t < 8; ++t) oa[t] = (f32x4){0.f, 0.f, 0.f, 0.f};
    float* sp = s1p;
#define SMP_BATCH(PF) do { _Pragma("unroll") for (int k = 0; k < 8; ++k) { const int dk = (bt * 8 + k) * 4 + dkq; \
            const f32x4 s0 = sb[k]; \
            if (PF) { sb[k] = __builtin_nontemporal_load((const f32x4*)lp); lp += 2048; asm volatile("" : "+v"(lp)); } \
            const f32x4 q0 = *(const LAS f32x4*)(QTs + dk * 8), q1 = *(const LAS f32x4*)(QTs + dk * 8 + 4); \
            const f32x4 k0 = *(const LAS f32x4*)(KDs + dk * 8), k1 = *(const LAS f32x4*)(KDs + dk * 8 + 4); \
            const float d = DCs[dk]; \
            oa[0] += s0 * q0[0]; oa[1] += s0 * q0[1]; oa[2] += s0 * q0[2]; oa[3] += s0 * q0[3]; \
            oa[4] += s0 * q1[0]; oa[5] += s0 * q1[1]; oa[6] += s0 * q1[2]; oa[7] += s0 * q1[3]; \
            f32x4 sn = s0 * d; \
            sn += vv[0] * k0[0]; sn += vv[1] * k0[1]; sn += vv[2] * k0[2]; sn += vv[3] * k0[3]; \
            sn += vv[4] * k1[0]; sn += vv[5] * k1[1]; sn += vv[6] * k1[2]; sn += vv[7] * k1[3]; \
            __builtin_nontemporal_store(sn, (f32x4*)sp); sp += 2048; asm volatile("" : "+v"(sp)); \
            if (k & 1) asm volatile("" ::: "memory"); } } while (0)
    { int bt = 0;
#pragma unroll 1
      for (; bt < 7; ++bt) SMP_BATCH(true);
      SMP_BATCH(false); }
#undef SMP_BATCH
#pragma unroll
    for (int t = 0; t < 8; ++t) *(LAS f32x4*)(RED + ((dkq * 8 + t) * 512 + dv4)) = oa[t];
    SEQ_BARRIER();
    { const int t = F.tid >> 6, d8 = (F.tid & 63) * 8;
      float o[8];
#pragma unroll
      for (int e = 0; e < 8; ++e) o[e] = 0.f;
#pragma unroll
      for (int q = 0; q < 4; ++q) { const f32x4 a = *(const LAS f32x4*)(RED + (q * 8 + t) * 512 + d8), b = *(const LAS f32x4*)(RED + (q * 8 + t) * 512 + d8 + 4);
          o[0] += a[0]; o[1] += a[1]; o[2] += a[2]; o[3] += a[3]; o[4] += b[0]; o[5] += b[1]; o[6] += b[2]; o[7] += b[3]; }
#pragma unroll
      for (int s = 0; s < 8; ++s) { const float at = ATs[t * 8 + s]; const v4u w = *(const v4u*)(VB + (row0 + s) * 2048 + h * 512 + d8);
          o[0] += at * bflo(w.x); o[1] += at * bfhi(w.x); o[2] += at * bflo(w.y); o[3] += at * bfhi(w.y); o[4] += at * bflo(w.z); o[5] += at * bfhi(w.z); o[6] += at * bflo(w.w); o[7] += at * bfhi(w.w); }
      float ss = 0.f;
#pragma unroll
      for (int e = 0; e < 8; ++e) ss += o[e] * o[e];
      ss = wave_sum(ss);
      const float rstd = rsqrtf(ss * (1.0f / 512.0f) + EPS);
      const v4u zw = *(const v4u*)(ZB + (row0 + t) * 2048 + h * 512 + d8);
      const f32x4 g0 = *(const f32x4*)(gg_ + h * 512 + d8), g1 = *(const f32x4*)(gg_ + h * 512 + d8 + 4);
      v4u w; w.x = pk2(o[0] * rstd * g0[0] * bflo(zw.x), o[1] * rstd * g0[1] * bfhi(zw.x)); w.y = pk2(o[2] * rstd * g0[2] * bflo(zw.y), o[3] * rstd * g0[3] * bfhi(zw.y));
      w.z = pk2(o[4] * rstd * g1[0] * bflo(zw.z), o[5] * rstd * g1[1] * bfhi(zw.z)); w.w = pk2(o[6] * rstd * g1[2] * bflo(zw.w), o[7] * rstd * g1[3] * bfhi(zw.w));
      *(v4u*)(AB + (row0 + t) * DM + 2048 + h * 512 + d8) = w; }
}
__device__ __forceinline__ void gla_sample_loop(Frame& F, const Args& A, unsigned* ctr) {
    volatile LAS unsigned* MISC = (volatile LAS unsigned*)(F.lds + MISC_OFF);
    for (;;) {
        __syncthreads();
        if (F.tid == 0) MISC[16] = __hip_atomic_fetch_add(ctr, 1u, __ATOMIC_RELAXED, __HIP_MEMORY_SCOPE_AGENT);
        __syncthreads();
        const int u = __builtin_amdgcn_readfirstlane((int)MISC[16]);
        if (u >= 512) break;
        gla_sample_unit(F, A, u);
    }
}

__device__ __forceinline__ void phase6(Frame& F, const Args& A) {
    const float* OB = (const float*)(F.ws + WS_OB); const bf16* ZB = (const bf16*)(F.ws + WS_ZB); const float* gn = FIN(14); bf16* AB = (bf16*)(F.ws + WS_AB);
    const int gw = F.blk * NWAVES + F.wave, NGW = F.G * NWAVES;
    if (gw >= NPR) return;
    f32x4 a[4][2], an[4][2]; v4u z[4], zn[4];
#pragma unroll
    for (int hh = 0; hh < 4; ++hh) { const size_t o = (size_t)gw * 2048 + hh * 512 + F.lane * 8; a[hh][0] = *(const f32x4*)(OB + o); a[hh][1] = *(const f32x4*)(OB + o + 4); z[hh] = *(const v4u*)(ZB + o); }
#pragma unroll 1
    for (int row = gw; row < NPR; row += NGW) {
        { const int rn = (row + NGW < NPR) ? row + NGW : row;
#pragma unroll
          for (int hh = 0; hh < 4; ++hh) { const size_t o = (size_t)rn * 2048 + hh * 512 + F.lane * 8; an[hh][0] = *(const f32x4*)(OB + o); an[hh][1] = *(const f32x4*)(OB + o + 4); zn[hh] = *(const v4u*)(ZB + o); } }
#pragma unroll
        for (int hh = 0; hh < 4; ++hh) { const int col = hh * 512 + F.lane * 8;
            const f32x4 x0 = a[hh][0], x1 = a[hh][1];
            float ss = (x0[0] * x0[0] + x0[1] * x0[1]) + (x0[2] * x0[2] + x0[3] * x0[3]) + (x1[0] * x1[0] + x1[1] * x1[1]) + (x1[2] * x1[2] + x1[3] * x1[3]);
            ss = wave_sum(ss);
            const float rstd = rsqrtf(ss * (1.0f / 512.0f) + EPS);
            const v4u zw = z[hh];
            const f32x4 g0 = *(const f32x4*)(gn + col), g1 = *(const f32x4*)(gn + col + 4);
            v4u w; w.x = pk2(x0[0] * rstd * g0[0] * bflo(zw.x), x0[1] * rstd * g0[1] * bfhi(zw.x)); w.y = pk2(x0[2] * rstd * g0[2] * bflo(zw.y), x0[3] * rstd * g0[3] * bfhi(zw.y));
            w.z = pk2(x1[0] * rstd * g1[0] * bflo(zw.z), x1[1] * rstd * g1[1] * bfhi(zw.z)); w.w = pk2(x1[2] * rstd * g1[2] * bflo(zw.w), x1[3] * rstd * g1[3] * bfhi(zw.w));
            *(v4u*)(AB + (size_t)row * DM + 2048 + col) = w; }
#pragma unroll
        for (int hh = 0; hh < 4; ++hh) { a[hh][0] = an[hh][0]; a[hh][1] = an[hh][1]; z[hh] = zn[hh]; }
    }
}

__device__ __forceinline__ void phase9(Frame& F, const Args& A) {
    const float* SSQ = (const float*)(F.ws + WS_SSQ); const float* fg = FIN(18); float* Y = F.out + OUT_Y; const bf16* XN = (const bf16*)(F.ws + WS_XN);
    const int gw = F.blk * NWAVES + F.wave, NGW = F.G * NWAVES;
    if (gw >= NROW) return;
    v4u v[8], vn[8]; float sq, sqn;
    { const bf16* xr = XN + (size_t)gw * DM + 8 * F.lane;
#pragma unroll
      for (int q = 0; q < 8; ++q) v[q] = *(const v4u*)(xr + 512 * q);
      sq = SSQ[(size_t)gw * 64 + F.lane]; }
#pragma unroll 1
    for (int row = gw; row < NROW; row += NGW) {
        { const int rn = (row + NGW < NROW) ? row + NGW : row; const bf16* xr = XN + (size_t)rn * DM + 8 * F.lane;
#pragma unroll
          for (int q = 0; q < 8; ++q) vn[q] = *(const v4u*)(xr + 512 * q);
          sqn = SSQ[(size_t)rn * 64 + F.lane]; }
        const float rstd = rsqrtf(wave_sum(sq) * (1.0f / DM) + EPS);
        float* yw = Y + (size_t)row * DM;
#pragma unroll
        for (int q = 0; q < 8; ++q) { const int c = 8 * (F.lane + 64 * q); const f32x4 g0 = *(const f32x4*)(fg + c), g1 = *(const f32x4*)(fg + c + 4);
            const f32x4 a = {bflo(v[q].x), bfhi(v[q].x), bflo(v[q].y), bfhi(v[q].y)}, b = {bflo(v[q].z), bfhi(v[q].z), bflo(v[q].w), bfhi(v[q].w)};
            __builtin_nontemporal_store(a * rstd * g0, (f32x4*)(yw + c)); __builtin_nontemporal_store(b * rstd * g1, (f32x4*)(yw + c + 4)); }
#pragma unroll
        for (int q = 0; q < 8; ++q) v[q] = vn[q];
        sq = sqn;
    }
}

constexpr int N_PHASES = 10;
constexpr int P3_NCG = 3;

__global__ void __launch_bounds__(NWAVES * 64, 2) mk_fwd(Args args) {
    extern __shared__ __attribute__((aligned(16))) unsigned char lds[];
    Frame F;
    F.lds = (LAS unsigned char*)lds;
    F.tid = threadIdx.x; F.lane = F.tid & 63; F.wave = __builtin_amdgcn_readfirstlane(F.tid >> 6);
    F.G = gridDim.x; F.blk = blockIdx.x;
    const Args& A = args;
    F.out = args.out; F.ws = args.ws;
    volatile LAS unsigned* MISC = (volatile LAS unsigned*)(F.lds + MISC_OFF);
    if (F.tid < 32) MISC[F.tid] = 0u;
    __syncthreads();
    unsigned* ctl = (unsigned*)(F.ws + WS_CTL);
    XcdBarrier bar; bar.bar = ctl + CW_BAR; bar.x = 0; bar.st = nullptr;
    if (MK_N_LAUNCHES == 1) bar = xcd_barrier_post(ctl + CW_BAR, MISC + 8);
    const int lo = args.ph_lo, hi = args.ph_hi;
#ifdef ONLY
#define IN(k) ((k) == ONLY)
#else
#define IN(k) (lo <= (k) && (k) < hi)
#endif
#define SEAM(k) do { if (IN(k) && IN((k) + 1)) xcd_barrier(bar); } while (0)
#ifndef PROBE_REPEAT
#define PROBE_REPEAT -1
#endif
#define PH(k, ...) do { if (IN(k)) { const int reps_ = (PROBE_REPEAT == (k)) ? args.ph_rep : 1; _Pragma("nounroll") for (int r_ = 0; r_ < reps_; ++r_) { { __VA_ARGS__ } if (r_ + 1 < reps_) xcd_barrier(bar); } } SEAM(k); } while (0)

    PH(0, phase0(F, A););
    PH(1, phase1(F, A, ctl););
    PH(2, phase2(F, A););
    PH(3,
        pg8::Gemm g{(const bf16*)(F.ws + WS_H), (const bf16*)(F.ws + WS_WB1), NROW, N1, DM}; pg8::GroupedOrder S; S.init(NROW, N1, F.G, F.blk, P3_NCG);
        EpiProj E{F.ws};
        pg8::gemm_phase<EpiProj, pg8::GroupedOrder>(F.lds, g, S, E);
        transpose_queue<1>(F, A, ctl + CW_TRN2);
    );
    int p5_pass = 0;
    PH(4,
        for (int u = F.blk; u < 256; u += F.G) swa_prompt_unit(F, A, u);
        for (int u = F.blk; u < 512; u += F.G) gla_prep_unit(F, A, u);
        for (int u = F.blk; u < 512; u += F.G) swa_sample_unit(F, A, u);
        win_prompt(F, A);
    );
    PH(5,
        for (int u = F.blk; u < 8 * SEQ_DVG; u += F.G) gla_seq_unit(F, A, u);
        gla_sample_loop(F, A, ctl + CW_SMP + 64 * p5_pass); ++p5_pass;
    );
    if (PROBE_REPEAT == 40) { for (int u = F.blk; u < 256; u += F.G) swa_prompt_unit(F, A, u); xcd_barrier(bar); }
    if (PROBE_REPEAT == 41) { for (int u = F.blk; u < 512; u += F.G) gla_prep_unit(F, A, u); xcd_barrier(bar); }
    if (PROBE_REPEAT == 42) { for (int u = F.blk; u < 512; u += F.G) swa_sample_unit(F, A, u); xcd_barrier(bar); }
    if (PROBE_REPEAT == 50) { for (int u = F.blk; u < 8 * SEQ_DVG; u += F.G) gla_seq_unit(F, A, u); xcd_barrier(bar); }
    if (PROBE_REPEAT == 51) { gla_sample_loop(F, A, ctl + CW_SMP + 64 * p5_pass); xcd_barrier(bar); }
    PH(6, phase6(F, A););
    PH(7,
        pg8::Gemm g{(const bf16*)(F.ws + WS_AB), (const bf16*)(F.ws + WS_WB2), NROW, DM, DM}; pg8::StaticOrder S; S.init(NROW, DM, F.G, F.blk, 192);
        EpiMerge E{(const bf16*)(F.ws + WS_SGA), (const bf16*)(F.ws + WS_SGB), (bf16*)(F.ws + WS_MERGED)};
        pg8::gemm_phase<EpiMerge>(F.lds, g, S, E);
    );
    PH(8,
        pg8::Gemm g{(const bf16*)(F.ws + WS_MERGED), (const bf16*)(F.ws + WS_WB3), NROW, DM, DM}; pg8::StaticOrder S; S.init(NROW, DM, F.G, F.blk, 192);
        EpiOut E{A.in[0], A.in[1], (const float*)(F.ws + WS_MOD), (bf16*)(F.ws + WS_XN), (float*)(F.ws + WS_SSQ)};
        pg8::gemm_phase<EpiOut>(F.lds, g, S, E);
    );
    if (IN(9)) { phase9(F, A); }
    if (PROBE_REPEAT == 900) { for (int i = 0; i < 8; ++i) xcd_barrier(bar); }
#undef IN
#undef SEAM
#undef PH
}

extern "C" void kernel_launch(void* const* d_in, const int* in_sizes, int n_in, void* d_out, int out_size, void* d_ws, size_t ws_size, hipStream_t stream) {
    static int grid = 0;
    if (grid == 0) {
        if (n_in != 19 || (size_t)out_size != OUT_TOTAL || ws_size < WS_END) { fprintf(stderr, "kernel_launch: unexpected sizes n_in %d out %d ws %zu (need %zu)\n", n_in, out_size, ws_size, (size_t)WS_END); grid = -1; return; }
        int dev = 0, cus = 0, per_cu = 0;
        if (hipGetDevice(&dev) != hipSuccess || hipDeviceGetAttribute(&cus, hipDeviceAttributeMultiprocessorCount, dev) != hipSuccess) { grid = -1; return; }
        if (hipFuncSetAttribute((const void*)mk_fwd, hipFuncAttributeMaxDynamicSharedMemorySize, LDS_BYTES) != hipSuccess) { fprintf(stderr, "kernel_launch: hipFuncSetAttribute failed\n"); grid = -1; return; }
        if (hipOccupancyMaxActiveBlocksPerMultiprocessor(&per_cu, (const void*)mk_fwd, NWAVES * 64, LDS_BYTES) != hipSuccess || per_cu < 1) fprintf(stderr, "kernel_launch: occupancy query reports %d\n", per_cu);
        (void)hipGetLastError();
        grid = cus;
    }
    if (grid < 0) return;
    (void)hipMemsetAsync((char*)d_ws + WS_CTL, 0, CTL_ZERO_BYTES, stream);
    Args a{};
    for (int i = 0; i < 19; ++i) a.in[i] = (const float*)d_in[i];
    a.out = (float*)d_out; a.ws = (unsigned char*)d_ws;
    a.ph_rep = 2; a.pad_ = 0;
    if (MK_N_LAUNCHES == 1) { a.ph_lo = 0; a.ph_hi = N_PHASES; hipLaunchKernelGGL(mk_fwd, dim3(grid), dim3(NWAVES * 64), LDS_BYTES, stream, a); }
    else for (int li = 0; li < N_PHASES; ++li) { a.ph_lo = li; a.ph_hi = li + 1; hipLaunchKernelGGL(mk_fwd, dim3(grid), dim3(NWAVES * 64), LDS_BYTES, stream, a); }
}
```

```cpp
#include <hip/hip_runtime.h>
#include <cstdio>
#include <cstdint>

#ifndef MK_N_LAUNCHES
#define MK_N_LAUNCHES 1
#endif

#define GAS __attribute__((address_space(1)))
#define LAS __attribute__((address_space(3)))
typedef unsigned short bf16;
typedef unsigned v4u __attribute__((ext_vector_type(4)));
typedef unsigned v2u __attribute__((ext_vector_type(2)));
typedef float f32x2 __attribute__((ext_vector_type(2)));
typedef float f32x4 __attribute__((ext_vector_type(4)));
typedef float f32x16 __attribute__((ext_vector_type(16)));
typedef short bf16x8 __attribute__((ext_vector_type(8)));
typedef __bf16 bf16x2_t __attribute__((ext_vector_type(2)));
#define LDS_WAIT() asm volatile("s_waitcnt lgkmcnt(0)" ::: "memory")
#define VM_WAIT() asm volatile("s_waitcnt vmcnt(0)" ::: "memory")

__device__ __forceinline__ unsigned pk2(float lo, float hi) { f32x2 v = {lo, hi}; bf16x2_t b = __builtin_convertvector(v, bf16x2_t); return __builtin_bit_cast(unsigned, b); }
__device__ __forceinline__ bf16 f2bf(float f) { return (bf16)(pk2(f, 0.f) & 0xffffu); }
__device__ __forceinline__ float bf2f(bf16 b) { return __uint_as_float(((unsigned)b) << 16); }
__device__ __forceinline__ float bflo(unsigned w) { return __uint_as_float(w << 16); }
__device__ __forceinline__ float bfhi(unsigned w) { return __uint_as_float(w & 0xffff0000u); }
__device__ __forceinline__ float wave_sum(float v) {
#pragma unroll
    for (int o = 1; o < 64; o <<= 1) v += __shfl_xor(v, o);
    return v;
}
__device__ __forceinline__ float sigmoidf_(float x) { return __builtin_amdgcn_rcpf(1.0f + __builtin_amdgcn_exp2f(-1.44269504089f * x)); }

#define XB_TMO      128
#define XB_XCNT(j)  (256  + 64 * (j))
#define XB_XSUB(j)  (1280 + 64 * (j))
#define XB_XGEN(j)  (2304 + 64 * (j))
#define XB_TOP      3328
#define XB_TOPGEN   3392
#define XCD_BAR_WORDS 3456
#define XB_SPIN_CAP (1u << 18)

__device__ __forceinline__ unsigned xb_ld(unsigned* p)              { return __hip_atomic_load(p, __ATOMIC_RELAXED, __HIP_MEMORY_SCOPE_AGENT); }
__device__ __forceinline__ unsigned xb_add(unsigned* p, unsigned v) { return __hip_atomic_fetch_add(p, v, __ATOMIC_RELAXED, __HIP_MEMORY_SCOPE_AGENT); }
__device__ __forceinline__ unsigned xb_xcc_id() { return (unsigned)__builtin_amdgcn_s_getreg((3 << 11) | 20) & 0xFu; }
#define XB_SPIN(cond, bar) do { unsigned _sp = 0; while (cond) { __builtin_amdgcn_s_sleep(1); \
    if ((++_sp & 255u) == 0u) { if (xb_ld(&(bar)[XB_TMO])) break; if (_sp > XB_SPIN_CAP) { atomicAdd(&(bar)[XB_TMO], 1u); break; } } } } while (0)

struct XcdBarrier { unsigned* bar; unsigned x; volatile LAS unsigned* st; };

__device__ __forceinline__ XcdBarrier xcd_barrier_post(unsigned* bar, volatile LAS unsigned* st) {
    XcdBarrier b; b.bar = bar; b.x = xb_xcc_id(); b.st = st;
    if (threadIdx.x == 0) (void)xb_add(&bar[XB_XCNT(b.x)], 1u);
    return b;
}
__device__ __forceinline__ void xcd_barrier_complete(unsigned* bar, unsigned x, unsigned& nloc, unsigned& nx) {
    const unsigned G = gridDim.x * gridDim.y * gridDim.z;
    unsigned sum, cnt, mine, sp = 0u;
    for (;;) {
        sum = 0u; cnt = 0u; mine = 0u;
#pragma unroll
        for (unsigned j = 0; j < 16; ++j) { const unsigned c = xb_ld(&bar[XB_XCNT(j)]); sum += c; cnt += (c > 0u) ? 1u : 0u; mine = (j == x) ? c : mine; }
        if (sum == G) break;
        __builtin_amdgcn_s_sleep(1);
        if ((++sp & 255u) == 0u) { if (xb_ld(&bar[XB_TMO])) break; if (sp > XB_SPIN_CAP) { atomicAdd(&bar[XB_TMO], 1u); break; } }
    }
    nloc = mine > 0u ? mine : 1u; nx = cnt > 0u ? cnt : 1u;
}
__device__ __forceinline__ void xcd_barrier(const XcdBarrier& b) {
    asm volatile("s_waitcnt vmcnt(0)" ::: "memory");
    __syncthreads();
    if (threadIdx.x == 0) {
        unsigned* bar = b.bar;
        __builtin_amdgcn_s_waitcnt(0);
        unsigned nloc = b.st[0], nx = b.st[1];
        if (nloc == 0u) { xcd_barrier_complete(bar, b.x, nloc, nx); b.st[0] = nloc; b.st[1] = nx; }
        const unsigned old = xb_add(&bar[XB_XSUB(b.x)], 1u);
        const unsigned gen = old / nloc;
        if (old + 1u == (gen + 1u) * nloc) {
            __builtin_amdgcn_fence(__ATOMIC_RELEASE, "agent");
            asm volatile("s_waitcnt vmcnt(0)" ::: "memory");
            const unsigned og = xb_add(&bar[XB_TOP], 1u);
            const unsigned tg = og / nx;
            if (og + 1u == (tg + 1u) * nx) xb_add(&bar[XB_TOPGEN], 1u);
            else XB_SPIN(xb_ld(&bar[XB_TOPGEN]) == tg, bar);
            __builtin_amdgcn_fence(__ATOMIC_ACQUIRE, "agent");
            xb_add(&bar[XB_XGEN(b.x)], 1u);
            asm volatile("s_waitcnt vmcnt(0)" ::: "memory");
        } else {
            XB_SPIN(xb_ld(&bar[XB_XGEN(b.x)]) == gen, bar);
            __builtin_amdgcn_fence(__ATOMIC_ACQUIRE, "agent");
            asm volatile("s_waitcnt vmcnt(0)" ::: "memory");
        }
    }
    __syncthreads();
}

constexpr int DM = 4096;
constexpr int NPR = 8192, NSR = 1024, NROW = NPR + NSR;
constexpr int SEQ = 4096, NSEQ_S = 128, TS = 8;
constexpr int N1 = 19200, NT1 = 75;
constexpr int PROJ = 18960;
constexpr int NMOD = 130;
constexpr float EPS = 1e-6f;

constexpr size_t MiB = 1u << 20;
constexpr size_t WS_CTL = 0, CTL_ZERO_BYTES = 1 * MiB;
constexpr size_t WS_WB1 = 1 * MiB;
constexpr size_t WS_WB2 = WS_WB1 + (size_t)N1 * DM * 2;
constexpr size_t WS_WB3 = WS_WB2 + (size_t)DM * DM * 2;
constexpr size_t WS_CS  = WS_WB3 + (size_t)DM * DM * 2;
constexpr size_t WS_MOD = WS_CS + (size_t)160 * DM * 2;
constexpr size_t WS_H   = WS_MOD + (size_t)132 * 12288 * 4;
constexpr size_t WS_QA  = WS_H + (size_t)NROW * DM * 2;
constexpr size_t WS_KA  = WS_QA + (size_t)NROW * 2048 * 2;
constexpr size_t WS_VA  = WS_KA + (size_t)NROW * 256 * 2;
constexpr size_t WS_ZA  = WS_VA + (size_t)NROW * 256 * 2;
constexpr size_t WS_QB  = WS_ZA + (size_t)NROW * 2048 * 2;
constexpr size_t WS_KB  = WS_QB + (size_t)NROW * 1024 * 2;
constexpr size_t WS_VB  = WS_KB + (size_t)NROW * 1024 * 2;
constexpr size_t WS_ZB  = WS_VB + (size_t)NROW * 2048 * 2;
constexpr size_t WS_SGA = WS_ZB + (size_t)NROW * 2048 * 2;
constexpr size_t WS_SGB = WS_SGA + (size_t)NROW * DM * 2;
constexpr size_t WS_R   = WS_SGB + (size_t)NROW * DM * 2;
constexpr size_t WS_QT  = WS_R + (size_t)NROW * 16 * 4;
constexpr size_t WS_KDT = WS_QT + (size_t)512 * 64 * 256 * 2;
constexpr size_t WS_ATT = WS_KDT + (size_t)512 * 64 * 256 * 2;
constexpr size_t WS_VT  = WS_ATT + (size_t)512 * 64 * 64 * 2;
constexpr size_t WS_DEC = WS_VT + (size_t)512 * 512 * 64 * 2;
constexpr size_t WS_OB  = WS_DEC + (size_t)512 * 256 * 4;
constexpr size_t WS_AB  = WS_OB + (size_t)NPR * 2048 * 4;
constexpr size_t WS_SSQ = WS_AB + (size_t)NROW * DM * 2;
constexpr size_t WS_END = WS_SSQ + (size_t)NROW * 64 * 4;
constexpr size_t WS_MERGED = WS_H;
constexpr size_t WS_XN = WS_AB;
constexpr int CW_BAR = 4096;

constexpr size_t OUT_Y = 0;
constexpr size_t OUT_KWP = (size_t)NROW * DM;
constexpr size_t OUT_VWP = OUT_KWP + 65536;
constexpr size_t OUT_GSP = OUT_VWP + 65536;
constexpr size_t OUT_KWS = OUT_GSP + 1048576;
constexpr size_t OUT_VWS = OUT_KWS + 4194304;
constexpr size_t OUT_GSS = OUT_VWS + 4194304;
constexpr size_t OUT_TOTAL = OUT_GSS + 67108864;

constexpr int RING_BYTES = 131072;
constexpr int LDS_BYTES = 155648;
constexpr int MISC_OFF = LDS_BYTES - 256;
constexpr int SMP_P4 = 0;
constexpr int CW_SMP = 64;
constexpr int NWAVES = 8;

namespace pg8 {
constexpr int BM = 256, BK = 64, HALF = 128, HTB = HALF * BK * 2, STAGE_BYTES = 8 * HTB, NXCD = 8, WGM = 8;
__host__ __device__ __forceinline__ int lds_byte(int r, int c) { const int st = (r >> 4) * 2 + (c >> 5), rr = r & 15, cc = c & 31, ob = rr * 64 + cc * 2; return st * 1024 + (ob ^ (((ob >> 9) & 1) << 5)); }
__host__ __device__ __forceinline__ void stage_rc(int b, int& R, int& C) { const int st = b / 1024, sb = b % 1024, swz = sb ^ (((sb >> 9) & 1) << 5); R = (st >> 1) * 16 + swz / 64; C = (st & 1) * 32 + (swz % 64) / 2; }
__host__ __device__ __forceinline__ int perm32(int rho) { const int n = rho >> 4, i = rho & 15; return 8 * (i >> 2) + 4 * n + (i & 3); }

struct Unit { int pm, pn; };
struct Gemm { const bf16* A; const bf16* Bt; int M, N, K; };

struct StaticOrder {
    int nM, nN, nwg, G, c;
    __host__ __device__ void init(int M, int N, int G_, int c_, int bm_rows = BM) { nM = M / bm_rows; nN = N / BM; nwg = nM * nN; G = G_; c = c_; }
    __host__ __device__ bool next(int i, Unit& u) const {
        const long L = (long)i * G + c; if (L >= nwg) return false;
        int wgid = (int)L; { const int q = nwg / NXCD, r = nwg % NXCD, xcd = wgid % NXCD, off = wgid / NXCD; wgid = (xcd < r ? xcd * (q + 1) : r * (q + 1) + (xcd - r) * q) + off; }
        const int nig = WGM * nN, gid = wgid / nig, fm = gid * WGM, gsz = (nM - fm) < WGM ? (nM - fm) : WGM;
        u.pm = fm + ((wgid % nig) % gsz); u.pn = (wgid % nig) / gsz; return true;
    }
};

struct GroupedOrder {
    int nM, nNg, ncg, per, G, c;
    __host__ __device__ void init(int M, int N, int G_, int c_, int ncg_) { nM = M / BM; ncg = ncg_; nNg = (N / BM) / ncg_; per = nM * nNg; G = G_; c = c_; }
    __host__ __device__ bool next(int i, Unit& u) const {
        const long L = (long)i * G + c; if (L >= (long)per * ncg) return false;
        const int grp = (int)(L / per); int wgid = (int)(L % per);
        { const int q = per / NXCD, r = per % NXCD, xcd = wgid % NXCD, off = wgid / NXCD; wgid = (xcd < r ? xcd * (q + 1) : r * (q + 1) + (xcd - r) * q) + off; }
        const int nig = WGM * nNg, gid = wgid / nig, fm = gid * WGM, gsz = (nM - fm) < WGM ? (nM - fm) : WGM;
        u.pm = fm + ((wgid % nig) % gsz); u.pn = grp * nNg + (wgid % nig) / gsz; return true;
    }
};

template <class Epi, class Sched = StaticOrder>
__device__ __forceinline__ void gemm_phase(LAS unsigned char* lds, const Gemm g, const Sched& S, const Epi& E) {
    const int tid = threadIdx.x, wid = __builtin_amdgcn_readfirstlane(tid >> 6), lane = tid & 63, wr = wid >> 2, wc = wid & 3, fr = lane & 15, fq = lane >> 4;
    constexpr int MT = Epi::MT;
    const int K = g.K, nt = K / BK;
    unsigned voffA[2], voffB[2];
#pragma unroll
    for (int i = 0; i < 2; ++i) { int R, C; stage_rc(tid * 16 + i * 8192, R, C); const int Rb = Epi::PERM ? ((R & ~31) + perm32(R & 31)) : R;
        const int Ra = (MT == 3 && R >= 96) ? R - 32 : R;
        voffA[i] = (unsigned)(Ra * K + C) * 2u; voffB[i] = (unsigned)(Rb * K + C) * 2u; }
    const size_t kstep = (size_t)(BK * 2);
    const size_t hstep = (size_t)HALF * K * 2;
    const size_t tstep = 2 * hstep;
    const size_t hstepA = (size_t)(32 * MT) * K * 2;
    const size_t tstepA = 2 * hstepA;
    const unsigned ldsw = (unsigned)wid * 1024u;
    const int aoff = lds_byte(wr * 16 * MT + fr, fq * 8), boff = lds_byte(wc * 32 + fr, fq * 8);
#define PG8_SA(b, h) (((b) * 2 + (h)) * HTB)
#define PG8_SB(b, h) ((4 + (b) * 2 + (h)) * HTB)
#define PG8_STAGE(bufoff, gbase, voff) do { _Pragma("unroll") for (int _i = 0; _i < 2; ++_i) \
        __builtin_amdgcn_global_load_lds((const unsigned*)((const char*)(gbase) + (voff)[_i]), (LAS unsigned*)(lds + (bufoff) + ldsw + _i * 8192), 16, 0, 0); } while (0)
#define PG8_STAGEB(bufoff, gbase, voff) do { _Pragma("unroll") for (int _i = 0; _i < 2; ++_i) \
        __builtin_amdgcn_global_load_lds((const unsigned*)((const char*)(gbase) + (voff)[_i]), (LAS unsigned*)(lds + (bufoff) + ldsw + _i * 8192), 16, 0, Epi::AUXB); } while (0)
#define PG8_LDA(dst, b, h) do { _Pragma("unroll") for (int m = 0; m < MT; ++m) _Pragma("unroll") for (int k = 0; k < 2; ++k) dst[m][k] = *(const LAS bf16x8*)(lds + PG8_SA(b, h) + aoff + m * 2048 + k * 1024); } while (0)
#define PG8_LDB(dst, b, h) do { _Pragma("unroll") for (int n = 0; n < 2; ++n) _Pragma("unroll") for (int k = 0; k < 2; ++k) dst[n][k] = *(const LAS bf16x8*)(lds + PG8_SB(b, h) + boff + n * 2048 + k * 1024); } while (0)
#define PG8_MMA(ai, bj, At, Bt) do { __builtin_amdgcn_s_setprio(1); _Pragma("unroll") for (int m = 0; m < MT; ++m) _Pragma("unroll") for (int n = 0; n < 2; ++n) _Pragma("unroll") for (int k = 0; k < 2; ++k) \
        acc[ai][bj][m][n] = __builtin_amdgcn_mfma_f32_16x16x32_bf16(Bt[n][k], At[m][k], acc[ai][bj][m][n], 0, 0, 0); __builtin_amdgcn_s_setprio(0); } while (0)
#define PG8_WAIT_V(n) asm volatile("s_waitcnt vmcnt(" #n ")" ::: "memory")
#define PG8_WAIT_L(n) asm volatile("s_waitcnt lgkmcnt(" #n ")" ::: "memory")
#define PG8_BAR __builtin_amdgcn_s_barrier()
#define PG8_SCHED __builtin_amdgcn_sched_barrier(0)
    Unit cur, nxt; int ui = 0;
    if (!S.next(0, cur)) return;
    f32x4 acc[2][2][MT][2];
#pragma unroll
    for (int a = 0; a < 2; ++a)
#pragma unroll
        for (int b = 0; b < 2; ++b)
#pragma unroll
            for (int m = 0; m < MT; ++m)
#pragma unroll
                for (int n = 0; n < 2; ++n) acc[a][b][m][n] = (f32x4){0.f, 0.f, 0.f, 0.f};
    bf16x8 At[MT][2], B0[2][2], B1[2][2];
    const char* cA = (const char*)g.A + (size_t)cur.pm * tstepA; const char* cB = (const char*)g.Bt + (size_t)cur.pn * tstep;
    PG8_STAGEB(PG8_SB(0, 0), cB, voffB); PG8_STAGEB(PG8_SB(0, 1), cB + hstep, voffB); PG8_STAGE(PG8_SA(0, 0), cA, voffA); PG8_STAGE(PG8_SA(0, 1), cA + hstepA, voffA);
    if (wr == 1) PG8_BAR;
    PG8_WAIT_V(2); PG8_BAR;
    PG8_STAGEB(PG8_SB(1, 0), cB + kstep, voffB); PG8_STAGE(PG8_SA(1, 0), cA + kstep, voffA); PG8_STAGEB(PG8_SB(1, 1), cB + hstep + kstep, voffB);
    PG8_WAIT_V(6); PG8_BAR;
    for (;;) {
        const bool has_next = S.next(ui + 1, nxt);
        const char* nA = has_next ? (const char*)g.A + (size_t)nxt.pm * tstepA : cA; const char* nB = has_next ? (const char*)g.Bt + (size_t)nxt.pn * tstep : cB;
        for (int t = 0; t < nt; t += 2) {
            const bool last = (t == nt - 2);
            const char* a1 = cA + (size_t)(t + 1) * kstep;
            const char* a2 = last ? nA : cA + (size_t)(t + 2) * kstep; const char* b2 = last ? nB : cB + (size_t)(t + 2) * kstep;
            const char* a3 = a2 + kstep; const char* b3 = b2 + kstep;
            if constexpr (Epi::HAS_MID) { if (t == nt / 2) E.mid(acc, cur, wr, wc, fr, fq); }
            PG8_LDB(B0, 0, 0); PG8_LDB(B1, 0, 1); PG8_SCHED; PG8_LDA(At, 0, 0); PG8_STAGE(PG8_SA(1, 1), a1 + hstepA, voffA);
            PG8_WAIT_V(8); PG8_WAIT_L(0); PG8_BAR; PG8_MMA(0, 0, At, B0); PG8_MMA(0, 1, At, B1); PG8_BAR; PG8_SCHED;
            PG8_LDA(At, 0, 1); PG8_STAGEB(PG8_SB(0, 0), b2, voffB); PG8_STAGEB(PG8_SB(0, 1), b2 + hstep, voffB); PG8_STAGE(PG8_SA(0, 0), a2, voffA);
            PG8_WAIT_V(8); PG8_WAIT_L(0); PG8_BAR; PG8_MMA(1, 0, At, B0); PG8_MMA(1, 1, At, B1); PG8_BAR; PG8_SCHED;
            PG8_LDB(B0, 1, 0); PG8_LDB(B1, 1, 1); PG8_SCHED; PG8_LDA(At, 1, 0); PG8_STAGE(PG8_SA(0, 1), a2 + hstepA, voffA);
            PG8_WAIT_V(8); PG8_WAIT_L(0); PG8_BAR; PG8_MMA(0, 0, At, B0); PG8_MMA(0, 1, At, B1); PG8_BAR; PG8_SCHED;
            PG8_LDA(At, 1, 1); PG8_STAGEB(PG8_SB(1, 0), b3, voffB); PG8_STAGEB(PG8_SB(1, 1), b3 + hstep, voffB); PG8_STAGE(PG8_SA(1, 0), a3, voffA);
            PG8_WAIT_V(8); PG8_WAIT_L(0); PG8_BAR; PG8_MMA(1, 0, At, B0); PG8_MMA(1, 1, At, B1); PG8_BAR; PG8_SCHED;
        }
        if (wr == 0) PG8_BAR;
        E(acc, cur, wr, wc, fr, fq);
        if (!has_next) break;
#pragma unroll
        for (int a = 0; a < 2; ++a)
#pragma unroll
            for (int b = 0; b < 2; ++b)
#pragma unroll
                for (int m = 0; m < MT; ++m)
#pragma unroll
                    for (int n = 0; n < 2; ++n) acc[a][b][m][n] = (f32x4){0.f, 0.f, 0.f, 0.f};
        cur = nxt; cA = nA; cB = nB; ++ui;
        if (wr == 1) PG8_BAR;
    }
    PG8_WAIT_V(0);
    PG8_BAR;
#undef PG8_SA
#undef PG8_SB
#undef PG8_STAGE
#undef PG8_STAGEB
#undef PG8_LDA
#undef PG8_LDB
#undef PG8_MMA
#undef PG8_WAIT_V
#undef PG8_WAIT_L
#undef PG8_BAR
#undef PG8_SCHED
}
}

struct EpiProj {
    static constexpr bool PERM = true, HAS_MID = false; static constexpr int MT = 4, AUXB = 0;
    unsigned char* ws;
    __device__ __forceinline__ void operator()(const f32x4 (&acc)[2][2][4][2], const pg8::Unit& u, int wr, int wc, int fr, int fq) const {
        const int pn = u.pn;
        const int row0 = u.pm * 256 + wr * 64 + fr;
        if (pn == 74) {
            if (wc == 0 && fq < 2) {
                float* R = (float*)(ws + WS_R);
#pragma unroll
                for (int ai = 0; ai < 2; ++ai)
#pragma unroll
                    for (int m = 0; m < 4; ++m) { float* rp = R + (size_t)(row0 + ai * 128 + m * 16) * 16 + 8 * fq;
                        *(f32x4*)(rp) = acc[ai][0][m][0]; *(f32x4*)(rp + 4) = acc[ai][0][m][1]; }
            }
            return;
        }
        if (pn >= 42) {
            bf16* RT = (bf16*)(ws + WS_SGA); bf16* SB = (bf16*)(ws + WS_SGB);
            const int col0 = (pn - 42) * 128 + wc * 32 + 8 * fq;
#pragma unroll
            for (int ai = 0; ai < 2; ++ai)
#pragma unroll
                for (int m = 0; m < 4; ++m) { const size_t off = (size_t)(row0 + ai * 128 + m * 16) * DM + col0;
                    float rt[8], sb[8];
#pragma unroll
                    for (int n = 0; n < 2; ++n)
#pragma unroll
                        for (int j = 0; j < 4; ++j) { const float ea = __builtin_amdgcn_exp2f(-1.44269504089f * acc[ai][0][m][n][j]), eb = __builtin_amdgcn_exp2f(-1.44269504089f * acc[ai][1][m][n][j]);
                            sb[4 * n + j] = __builtin_amdgcn_rcpf(1.0f + eb); rt[4 * n + j] = (1.0f + eb) * __builtin_amdgcn_rcpf(1.0f + ea); }
                    v4u w; w.x = pk2(rt[0], rt[1]); w.y = pk2(rt[2], rt[3]); w.z = pk2(rt[4], rt[5]); w.w = pk2(rt[6], rt[7]);
                    __builtin_nontemporal_store(w, (v4u*)(RT + off));
                    w.x = pk2(sb[0], sb[1]); w.y = pk2(sb[2], sb[3]); w.z = pk2(sb[4], sb[5]); w.w = pk2(sb[6], sb[7]);
                    __builtin_nontemporal_store(w, (v4u*)(SB + off)); }
            return;
        }
        size_t boff; int ldc, ct, act;
        if (pn < 8)       { boff = WS_QA;  ldc = 2048; ct = pn;      act = 0; }
        else if (pn == 8) { boff = WS_KA;  ldc = 256;  ct = 0;       act = 0; }
        else if (pn == 9) { boff = WS_VA;  ldc = 256;  ct = 0;       act = 0; }
        else if (pn < 18) { boff = WS_ZA;  ldc = 2048; ct = pn - 10; act = 1; }
        else if (pn < 22) { boff = WS_QB;  ldc = 1024; ct = pn - 18; act = 0; }
        else if (pn < 26) { boff = WS_KB;  ldc = 1024; ct = pn - 22; act = 0; }
        else if (pn < 34) { boff = WS_VB;  ldc = 2048; ct = pn - 26; act = 0; }
        else              { boff = WS_ZB;  ldc = 2048; ct = pn - 34; act = 1; }
        bf16* base = (bf16*)(ws + boff);
        const int col0 = ct * 256 + wc * 32 + 8 * fq;
#pragma unroll
        for (int ai = 0; ai < 2; ++ai)
#pragma unroll
            for (int m = 0; m < 4; ++m) { bf16* rowp = base + (size_t)(row0 + ai * 128 + m * 16) * ldc + col0;
#pragma unroll
                for (int bj = 0; bj < 2; ++bj) { f32x4 v0 = acc[ai][bj][m][0], v1 = acc[ai][bj][m][1];
                    if (act != 0) {
#pragma unroll
                        for (int j = 0; j < 4; ++j) { v0[j] *= sigmoidf_(v0[j]); v1[j] *= sigmoidf_(v1[j]); }
                    }
                    v4u w; w.x = pk2(v0[0], v0[1]); w.y = pk2(v0[2], v0[3]); w.z = pk2(v1[0], v1[1]); w.w = pk2(v1[2], v1[3]);
                    __builtin_nontemporal_store(w, (v4u*)(rowp + bj * 128)); } }
    }
};
struct EpiMerge {
    static constexpr bool PERM = true, HAS_MID = true; static constexpr int MT = 3, AUXB = 0;
    const bf16* sga; const bf16* sgb; bf16* out;
    __device__ __forceinline__ void mid(f32x4 (&acc)[2][2][MT][2], const pg8::Unit& u, int wr, int wc, int fr, int fq) const {
        int row0 = u.pm * (64 * MT) + wr * (16 * MT) + fr, col0 = u.pn * 256 + wc * 32 + 8 * fq;
        asm volatile("" : "+v"(row0), "+v"(col0));
#pragma unroll
        for (int ai = 0; ai < 2; ++ai)
#pragma unroll
            for (int m = 0; m < MT; ++m) { const size_t off = (size_t)(row0 + ai * (32 * MT) + m * 16) * DM + col0;
#pragma unroll
                for (int bj = 0; bj < 2; ++bj) { const v4u a = *(const v4u*)(sga + off + bj * 128);
                    const f32x4 r0 = {bflo(a.x), bfhi(a.x), bflo(a.y), bfhi(a.y)}, r1 = {bflo(a.z), bfhi(a.z), bflo(a.w), bfhi(a.w)};
                    acc[ai][bj][m][0] *= r0; acc[ai][bj][m][1] *= r1;
                    asm volatile("" ::: "memory"); } }
    }
    __device__ __forceinline__ void operator()(const f32x4 (&acc)[2][2][MT][2], const pg8::Unit& u, int wr, int wc, int fr, int fq) const {
        const int row0 = u.pm * (64 * MT) + wr * (16 * MT) + fr, col0 = u.pn * 256 + wc * 32 + 8 * fq;
#pragma unroll
        for (int ai = 0; ai < 2; ++ai)
#pragma unroll
            for (int m = 0; m < MT; ++m) { const size_t off = (size_t)(row0 + ai * (32 * MT) + m * 16) * DM + col0;
#pragma unroll
                for (int bj = 0; bj < 2; ++bj) { const v4u b = *(const v4u*)(sgb + off + bj * 128);
                    const f32x4 v0 = acc[ai][bj][m][0], v1 = acc[ai][bj][m][1];
                    v4u w; w.x = pk2(v0[0] * bflo(b.x), v0[1] * bfhi(b.x)); w.y = pk2(v0[2] * bflo(b.y), v0[3] * bfhi(b.y));
                    w.z = pk2(v1[0] * bflo(b.z), v1[1] * bfhi(b.z)); w.w = pk2(v1[2] * bflo(b.w), v1[3] * bfhi(b.w));
                    *(v4u*)(out + off + bj * 128) = w; } }
    }
};
struct EpiOut {
    static constexpr bool PERM = false, HAS_MID = false; static constexpr int MT = 3, AUXB = 0;
    const float* xp; const float* xs; const float* mod; bf16* y; float* ssq;
    __device__ __forceinline__ void operator()(const f32x4 (&acc)[2][2][MT][2], const pg8::Unit& u, int wr, int wc, int fr, int fq) const {
        const int col0 = u.pn * 256 + wc * 32 + 4 * fq;
#pragma unroll
        for (int ai = 0; ai < 2; ++ai)
#pragma unroll
            for (int m = 0; m < MT; ++m) { const int row = u.pm * (64 * MT) + ai * (32 * MT) + wr * (16 * MT) + m * 16 + fr;
                const float* xr = (row < NPR) ? xp + (size_t)row * DM : xs + (size_t)(row - NPR) * DM;
                const int seq = (row < NPR) ? (row >> 12) : 2 + ((row - NPR) >> 3);
                const float* gp = mod + (size_t)seq * 12288 + 8192;
                float s = 0.f;
#pragma unroll
                for (int bj = 0; bj < 2; ++bj)
#pragma unroll
                    for (int n = 0; n < 2; ++n) { const int c = col0 + bj * 128 + n * 16;
                        const f32x4 xv = *(const f32x4*)(xr + c), gv = *(const f32x4*)(gp + c);
                        const f32x4 o = xv + gv * acc[ai][bj][m][n];
                        v2u w; w.x = pk2(o[0], o[1]); w.y = pk2(o[2], o[3]);
                        *(v2u*)(y + (size_t)row * DM + c) = w;
                        s += (o[0] * o[0] + o[1] * o[1]) + (o[2] * o[2] + o[3] * o[3]); }
                s += __shfl_xor(s, 16); s += __shfl_xor(s, 32);
                if (fq == 0) ssq[(size_t)row * 64 + u.pn * 4 + wc] = s;
            }
    }
};

struct Args { const float* in[19]; float* out; unsigned char* ws; int ph_lo, ph_hi, ph_rep, pad_; };
#define FIN(k) (A.in[k])
struct Frame {
    LAS unsigned char* lds;
    int tid, lane, wave, blk, G;
    float* out; unsigned char* ws;
};

template <bool NTS>
__device__ __forceinline__ void p0_transpose_item(const float* W, int ldw, int k0, int n_src0, bf16* WT, int ldt, int drow0, int koff, LAS float* scr, int lane) {
    f32x4 v[16];
    const float* wp = W + (size_t)(k0 + (lane >> 4)) * ldw + n_src0 + (lane & 15) * 4;
#pragma unroll
    for (int i = 0; i < 16; ++i) v[i] = __builtin_nontemporal_load((const f32x4*)(wp + (size_t)(4 * i) * ldw));
#pragma unroll
    for (int i = 0; i < 16; ++i) { LAS float* s = scr + (4 * i + (lane >> 4)) * 65 + (lane & 15) * 4; s[0] = v[i][0]; s[1] = v[i][1]; s[2] = v[i][2]; s[3] = v[i][3]; }
    LDS_WAIT(); asm volatile("" ::: "memory");
    const int c = lane & 7;
#pragma unroll
    for (int j = 0; j < 8; ++j) { const int n = (lane >> 3) + 8 * j; const LAS float* s = scr + (8 * c) * 65 + n;
        v4u o; o.x = pk2(s[0 * 65], s[1 * 65]); o.y = pk2(s[2 * 65], s[3 * 65]); o.z = pk2(s[4 * 65], s[5 * 65]); o.w = pk2(s[6 * 65], s[7 * 65]);
        if (NTS) __builtin_nontemporal_store(o, (v4u*)(WT + (size_t)(drow0 + n) * ldt + koff + k0 + 8 * c)); else *(v4u*)(WT + (size_t)(drow0 + n) * ldt + koff + k0 + 8 * c) = o; }
    LDS_WAIT(); asm volatile("" ::: "memory");
}
__device__ __forceinline__ void phase0(Frame& F, const Args& A) {
    const size_t gt = (size_t)F.blk * 512 + F.tid, NT = (size_t)F.G * 512;
    bf16* CS = (bf16*)(F.ws + WS_CS); const float* cp = FIN(5); const float* cs = FIN(6);
    for (size_t i = gt; i < (size_t)160 * DM / 4; i += NT) { const int row = (int)(i >> 10), c4 = (int)(i & 1023) * 4;
        f32x4 v = {0.f, 0.f, 0.f, 0.f};
        if (row < 2) v = *(const f32x4*)(cp + (size_t)row * DM + c4); else if (row < NMOD) v = *(const f32x4*)(cs + (size_t)(row - 2) * DM + c4);
        v2u o; o.x = pk2(v[0] * sigmoidf_(v[0]), v[1] * sigmoidf_(v[1])); o.y = pk2(v[2] * sigmoidf_(v[2]), v[3] * sigmoidf_(v[3]));
        *(v2u*)(CS + (size_t)row * DM + c4) = o; }
    { f32x4* z = (f32x4*)(F.ws + WS_MOD); const f32x4 zero = {0.f, 0.f, 0.f, 0.f}; for (size_t i = gt; i < (size_t)NMOD * 12288 / 4; i += NT) z[i] = zero; }
}
__device__ __forceinline__ void p1_modgemm(Frame& F, const Args& A) {
    const float* w_ada = FIN(7); const float* b_ada = FIN(8);
    const bf16* CS = (const bf16*)(F.ws + WS_CS); float* MOD = (float*)(F.ws + WS_MOD);
    const int kq = F.blk & 3, j = F.lane & 31, hh = F.lane >> 5;
    const int n0 = (F.blk >> 2) * 256 + F.wave * 32;
    f32x16 acc[5];
#pragma unroll
    for (int mt = 0; mt < 5; ++mt)
#pragma unroll
        for (int r = 0; r < 16; ++r) acc[mt][r] = 0.f;
    const float* wp = w_ada + (size_t)(kq * 1024 + 8 * hh) * 12288 + n0 + j;
    const bf16* ap = CS + (size_t)j * DM + kq * 1024 + 8 * hh;
    float bn[32];
#pragma unroll
    for (int e = 0; e < 32; ++e) bn[e] = __builtin_nontemporal_load(wp + (size_t)((e >> 3) * 16 + (e & 7)) * 12288);
#pragma unroll 1
    for (int g4 = 0; g4 < 16; ++g4) {
        float bc[32];
#pragma unroll
        for (int e = 0; e < 32; ++e) bc[e] = bn[e];
        { const int gn = (g4 < 15) ? g4 + 1 : g4; const float* wq = wp + (size_t)(gn * 64) * 12288;
#pragma unroll
          for (int e = 0; e < 32; ++e) bn[e] = __builtin_nontemporal_load(wq + (size_t)((e >> 3) * 16 + (e & 7)) * 12288); }
#pragma unroll
        for (int s4 = 0; s4 < 4; ++s4) { const int ks = g4 * 4 + s4;
            v4u bw; bw.x = pk2(bc[8 * s4], bc[8 * s4 + 1]); bw.y = pk2(bc[8 * s4 + 2], bc[8 * s4 + 3]); bw.z = pk2(bc[8 * s4 + 4], bc[8 * s4 + 5]); bw.w = pk2(bc[8 * s4 + 6], bc[8 * s4 + 7]);
            const bf16x8 bf = __builtin_bit_cast(bf16x8, bw);
#pragma unroll
            for (int mt = 0; mt < 5; ++mt) { const bf16x8 af = *(const bf16x8*)(ap + (size_t)mt * 32 * DM + ks * 16);
                acc[mt] = __builtin_amdgcn_mfma_f32_32x32x16_bf16(af, bf, acc[mt], 0, 0, 0); }
            asm volatile("" ::: "memory"); }
    }
    { const float bias = (kq == 0) ? b_ada[n0 + j] : 0.f;
#pragma unroll
      for (int mt = 0; mt < 5; ++mt)
#pragma unroll
          for (int r = 0; r < 16; ++r) { const int row = 32 * mt + (r & 3) + 8 * (r >> 2) + 4 * hh;
              if (row < NMOD) atomicAdd(MOD + (size_t)row * 12288 + n0 + j, acc[mt][r] + bias); } }
}
constexpr int CW_TRN = 1024, CW_TRN2 = 1088;
template <int WHICH>
__device__ __forceinline__ void transpose_queue(Frame& F, const Args& A, unsigned* ctr) {
    LAS float* scr = (LAS float*)(F.lds + F.wave * 16896);
    const float* w_in = FIN(10); const float* w_pa = FIN(15); const float* w_pb = FIN(16); const float* w_out = FIN(17);
    bf16* WB1 = (bf16*)(F.ws + WS_WB1); bf16* WB2 = (bf16*)(F.ws + WS_WB2); bf16* WB3 = (bf16*)(F.ws + WS_WB3);
    constexpr int I1 = 64 * 168, I2 = 64 * 128, IA = 32 * 64, IB = 32 * 64, IO = 64 * 64;
    constexpr int NITEMS = WHICH == 0 ? (I1 + I2) : (IA + IB + IO);
    volatile LAS unsigned* MISC = (volatile LAS unsigned*)(F.lds + MISC_OFF);
    for (;;) {
        __syncthreads();
        if (F.tid == 0) MISC[17] = __hip_atomic_fetch_add(ctr, 32u, __ATOMIC_RELAXED, __HIP_MEMORY_SCOPE_AGENT);
        __syncthreads();
        const int base = __builtin_amdgcn_readfirstlane((int)MISC[17]);
        if (base >= NITEMS) break;
#pragma unroll 1
        for (int i4 = 0; i4 < 4; ++i4) { const int it = base + i4 * 8 + F.wave; if (it >= NITEMS) break;
            int r = it;
            if (WHICH == 0) {
                if (r < I1) { const int kb = r / 168, nb = r % 168; p0_transpose_item<false>(w_in, PROJ, 64 * kb, 64 * nb, WB1, DM, 64 * nb, 0, scr, F.lane); continue; } r -= I1;
                { const int kb = r / 128, nb = r % 128, gsel = nb >> 6, nb2 = nb & 63;
                  p0_transpose_item<false>(w_in, PROJ, 64 * kb, 10768 + 64 * nb, WB1, DM, 10752 + 256 * (nb2 >> 1) + 128 * gsel + 64 * (nb2 & 1), 0, scr, F.lane); }
            } else {
                if (r < IA) { const int kb = r / 64, nb = r % 64; p0_transpose_item<true>(w_pa, DM, 64 * kb, 64 * nb, WB2, DM, 64 * nb, 0, scr, F.lane); continue; } r -= IA;
                if (r < IB) { const int kb = r / 64, nb = r % 64; p0_transpose_item<true>(w_pb, DM, 64 * kb, 64 * nb, WB2, DM, 64 * nb, 2048, scr, F.lane); continue; } r -= IB;
                { const int kb = r / 64, nb = r % 64; p0_transpose_item<true>(w_out, DM, 64 * kb, 64 * nb, WB3, DM, 64 * nb, 0, scr, F.lane); }
            }
        }
    }
}
__device__ __forceinline__ void phase1(Frame& F, const Args& A, unsigned* ctl) {
    if (F.blk < 192) p1_modgemm(F, A);
    transpose_queue<0>(F, A, ctl + CW_TRN);
    const float* w_in = FIN(10); bf16* WB1 = (bf16*)(F.ws + WS_WB1);
    const size_t gt = (size_t)F.blk * 512 + F.tid, NT = (size_t)F.G * 512;
    for (size_t i = gt; i < (size_t)16 * DM; i += NT) { const int k = (int)(i >> 4), j = (int)(i & 15); WB1[(size_t)(18944 + j) * DM + k] = f2bf(w_in[(size_t)k * PROJ + 10752 + j]); }
    { v4u* z = (v4u*)(WB1 + (size_t)18960 * DM); const v4u zero = {0u, 0u, 0u, 0u}; for (size_t i = gt; i < (size_t)240 * DM * 2 / 16; i += NT) z[i] = zero; }
}

__device__ __forceinline__ const float* xrow_ptr(const float* xp, const float* xs, int row) { return (row < NPR) ? xp + (size_t)row * DM : xs + (size_t)(row - NPR) * DM; }
__device__ __forceinline__ int wave_rows(int nrow, int gw, int ngw, int& extra) {
    const int nfull = nrow / ngw, rem = nrow % ngw;
    const int e0 = (int)(((long)gw * rem) / ngw), e1 = (int)(((long)(gw + 1) * rem) / ngw);
    extra = (e1 > e0) ? nfull * ngw + e0 : -1;
    return nfull + (e1 > e0 ? 1 : 0);
}
__device__ __forceinline__ void phase2(Frame& F, const Args& A) {
    const float* xp = FIN(0); const float* xs = FIN(1); const float* ng = FIN(9);
    const float* MOD = (const float*)(F.ws + WS_MOD); bf16* H = (bf16*)(F.ws + WS_H);
    const int gw = F.blk * NWAVES + F.wave, NGW = F.G * NWAVES, lane = F.lane;
    LAS float* G1s = (LAS float*)F.lds; LAS float* SHs = (LAS float*)(F.lds + 32768);
    __syncthreads();
    for (int i = F.tid; i < 2048; i += 512) { const int sq = i >> 10, c = (i & 1023) * 4;
        const f32x4 g = *(const f32x4*)(ng + c), a = *(const f32x4*)(MOD + (size_t)sq * 12288 + 4096 + c), b = *(const f32x4*)(MOD + (size_t)sq * 12288 + c);
        *(LAS f32x4*)(G1s + sq * 4096 + c) = g * (a + 1.0f); *(LAS f32x4*)(SHs + sq * 4096 + c) = b; }
    __syncthreads();
    int extra; const int nr = wave_rows(NROW, gw, NGW, extra);
    if (nr == 0) return;
    const int nfull = NROW / NGW;
    auto rowof = [&](int i) { const int ic = (i < nr) ? i : nr - 1; return (ic < nfull) ? gw + ic * NGW : extra; };
    auto process = [&](const f32x4 (&v)[16], int row) {
        float s = 0.f;
#pragma unroll
        for (int q = 0; q < 16; ++q) s += (v[q][0] * v[q][0] + v[q][1] * v[q][1]) + (v[q][2] * v[q][2] + v[q][3] * v[q][3]);
        const float rstd = rsqrtf(wave_sum(s) * (1.0f / DM) + EPS);
        if (row < NPR) {
            const int sq = row >> 12;
#pragma unroll
            for (int q = 0; q < 16; ++q) { const int c = 4 * (lane + 64 * q);
                const f32x4 g1 = *(const LAS f32x4*)(G1s + sq * 4096 + c), b = *(const LAS f32x4*)(SHs + sq * 4096 + c);
                const f32x4 h = (v[q] * rstd) * g1 + b;
                v2u o; o.x = pk2(h[0], h[1]); o.y = pk2(h[2], h[3]);
                *(v2u*)(H + (size_t)row * DM + c) = o; }
        } else {
            const int seq = 2 + ((row - NPR) >> 3);
            const float* sh = MOD + (size_t)seq * 12288; const float* sc = sh + 4096;
#pragma unroll
            for (int q = 0; q < 16; ++q) { const int c = 4 * (lane + 64 * q);
                const f32x4 g = *(const f32x4*)(ng + c), a = *(const f32x4*)(sc + c), b = *(const f32x4*)(sh + c);
                const f32x4 h = (v[q] * rstd * g) * (a + 1.0f) + b;
                v2u o; o.x = pk2(h[0], h[1]); o.y = pk2(h[2], h[3]);
                *(v2u*)(H + (size_t)row * DM + c) = o;
                if ((q & 3) == 3) asm volatile("" ::: "memory"); }
        }
    };
#define P2_LOAD(dst, r) do { const float* xr_ = xrow_ptr(xp, xs, (r)) + 4 * lane; _Pragma("unroll") for (int q = 0; q < 16; ++q) dst[q] = __builtin_nontemporal_load((const f32x4*)(xr_ + 256 * q)); } while (0)
    f32x4 va[16], vb[16];
    P2_LOAD(va, rowof(0));
    int i = 0;
#pragma unroll 1
    for (; i + 1 < nr; i += 2) {
        P2_LOAD(vb, rowof(i + 1));
        process(va, rowof(i));
        P2_LOAD(va, rowof(i + 2));
        process(vb, rowof(i + 1));
    }
    if (i < nr) process(va, rowof(i));
#undef P2_LOAD
}

#define MFMA16(a, b, c) __builtin_amdgcn_mfma_f32_16x16x32_bf16((a), (b), (c), 0, 0, 0)

constexpr int SWA_VS = 280;
__device__ __forceinline__ void swa_prompt_unit(Frame& F, const Args& A, int unit) {
    const int b = unit >> 7, i = (unit >> 2) & 31, g = unit & 3;
    const bf16* QA = (const bf16*)(F.ws + WS_QA); const bf16* KA = (const bf16*)(F.ws + WS_KA); const bf16* VA = (const bf16*)(F.ws + WS_VA);
    const bf16* ZA = (const bf16*)(F.ws + WS_ZA); bf16* AB = (bf16*)(F.ws + WS_AB);
    LAS unsigned char* Ks = F.lds;
    LAS bf16* VTs = (LAS bf16*)(F.lds + 36864);
    __syncthreads();
#pragma unroll
    for (int q = 0; q < 4; ++q) { const int p = F.tid + 512 * q, row = p >> 3, c = p & 7; const int tok = (i - 1) * 128 + row;
        v4u kv = {0u, 0u, 0u, 0u}, vv = {0u, 0u, 0u, 0u};
        if (tok >= 0) { const size_t off = (size_t)(b * SEQ + tok) * 256 + g * 64 + c * 8; kv = *(const v4u*)(KA + off); vv = *(const v4u*)(VA + off); }
        *(LAS v4u*)(Ks + row * 144 + c * 16) = kv;
        LAS bf16* vt = VTs + (c * 8) * SWA_VS + row;
        vt[0 * SWA_VS] = (bf16)(vv.x & 0xffff); vt[1 * SWA_VS] = (bf16)(vv.x >> 16); vt[2 * SWA_VS] = (bf16)(vv.y & 0xffff); vt[3 * SWA_VS] = (bf16)(vv.y >> 16);
        vt[4 * SWA_VS] = (bf16)(vv.z & 0xffff); vt[5 * SWA_VS] = (bf16)(vv.z >> 16); vt[6 * SWA_VS] = (bf16)(vv.w & 0xffff); vt[7 * SWA_VS] = (bf16)(vv.w >> 16); }
    if (F.tid < 192) { const int d = F.tid / 3, q = F.tid % 3; *(LAS v4u*)(VTs + d * SWA_VS + 256 + 8 * q) = (v4u){0u, 0u, 0u, 0u}; }
    __syncthreads();
    const int hq = g * 8 + F.wave, c = F.lane & 15, gg = F.lane >> 4;
    const float sink = FIN(11)[hq];
    const size_t qbase = (size_t)b * SEQ + i * 128;
    bf16x8 bq[2], bqn[2];
#pragma unroll
    for (int ks = 0; ks < 2; ++ks) bq[ks] = *(const bf16x8*)(QA + (qbase + c) * 2048 + hq * 64 + ks * 32 + 8 * gg);
#pragma unroll 1
    for (int sub = 0; sub < 8; ++sub) {
        const size_t qrow = qbase + sub * 16 + c;
        { const int sn = (sub < 7) ? sub + 1 : sub;
#pragma unroll
          for (int ks = 0; ks < 2; ++ks) bqn[ks] = *(const bf16x8*)(QA + (qbase + sn * 16 + c) * 2048 + hq * 64 + ks * 32 + 8 * gg); }
        v2u zaw[4];
#pragma unroll
        for (int nt = 0; nt < 4; ++nt) zaw[nt] = *(const v2u*)(ZA + qrow * 2048 + hq * 64 + 16 * nt + 4 * gg);
        f32x4 s[10];
        const LAS unsigned char* kp = Ks + (16 * sub + c) * 144 + 16 * gg;
#pragma unroll
        for (int x = 0; x < 9; ++x) { f32x4 a = {0.f, 0.f, 0.f, 0.f};
#pragma unroll
            for (int ks = 0; ks < 2; ++ks) { const bf16x8 ak = *(const LAS bf16x8*)(kp + x * 16 * 144 + ks * 64); a = MFMA16(ak, bq[ks], a); }
            s[x] = a; if ((x & 3) == 3) asm volatile("" ::: "memory"); }
        s[9] = (f32x4){0.f, 0.f, 0.f, 0.f};
        float m = sink;
#pragma unroll
        for (int x = 0; x < 9; ++x) { const bool tile_ok = (i > 0) || (sub + x >= 8);
#pragma unroll
            for (int r = 0; r < 4; ++r) { bool valid = tile_ok; if (x == 0) valid = valid && (4 * gg + r >= c); if (x == 8) valid = valid && (4 * gg + r <= c);
                const float v = valid ? s[x][r] * 0.125f : -1e30f; s[x][r] = v; m = fmaxf(m, v); } }
        m = fmaxf(m, __shfl_xor(m, 16)); m = fmaxf(m, __shfl_xor(m, 32));
        float sum = 0.f;
#pragma unroll
        for (int x = 0; x < 9; ++x)
#pragma unroll
            for (int r = 0; r < 4; ++r) { const float p = (s[x][r] > -1e29f) ? __expf(s[x][r] - m) : 0.f; s[x][r] = p; sum += p; }
        sum += __shfl_xor(sum, 16); sum += __shfl_xor(sum, 32);
        const float inv = 1.0f / (sum + __expf(sink - m));
        f32x4 o[4];
#pragma unroll
        for (int nt = 0; nt < 4; ++nt) o[nt] = (f32x4){0.f, 0.f, 0.f, 0.f};
        const LAS bf16* vbase = VTs + c * SWA_VS + 16 * sub + 4 * gg;
#pragma unroll
        for (int jp = 0; jp < 5; ++jp) { v4u pw; pw.x = pk2(s[2 * jp][0], s[2 * jp][1]); pw.y = pk2(s[2 * jp][2], s[2 * jp][3]); pw.z = pk2(s[2 * jp + 1][0], s[2 * jp + 1][1]); pw.w = pk2(s[2 * jp + 1][2], s[2 * jp + 1][3]);
            const bf16x8 pb = __builtin_bit_cast(bf16x8, pw);
#pragma unroll
            for (int nt = 0; nt < 4; ++nt) { const LAS bf16* vp = vbase + 16 * nt * SWA_VS + 32 * jp;
                const v2u v0 = *(const LAS v2u*)(vp), v1 = *(const LAS v2u*)(vp + 16);
                v4u vw; vw.x = v0.x; vw.y = v0.y; vw.z = v1.x; vw.w = v1.y;
                o[nt] = MFMA16(__builtin_bit_cast(bf16x8, vw), pb, o[nt]); }
            asm volatile("" ::: "memory"); }
#pragma unroll
        for (int nt = 0; nt < 4; ++nt) { v2u w; w.x = pk2(o[nt][0] * inv * bflo(zaw[nt].x), o[nt][1] * inv * bfhi(zaw[nt].x)); w.y = pk2(o[nt][2] * inv * bflo(zaw[nt].y), o[nt][3] * inv * bfhi(zaw[nt].y));
            *(v2u*)(AB + qrow * DM + hq * 64 + 16 * nt + 4 * gg) = w; }
        bq[0] = bqn[0]; bq[1] = bqn[1];
    }
}

__device__ __forceinline__ void swa_sample_unit(Frame& F, const Args& A, int unit) {
    const int n = unit >> 2, g = unit & 3;
    const bf16* QA = (const bf16*)(F.ws + WS_QA); const bf16* KA = (const bf16*)(F.ws + WS_KA); const bf16* VA = (const bf16*)(F.ws + WS_VA);
    const bf16* ZA = (const bf16*)(F.ws + WS_ZA); bf16* AB = (bf16*)(F.ws + WS_AB);
    const float* ck = FIN(2); const float* cv = FIN(3);
    LAS unsigned char* Ks = F.lds;
    LAS bf16* VTs = (LAS bf16*)(F.lds + 23040);
    const int hq = g * 8 + F.wave, c = F.lane & 15, gg = F.lane >> 4, tq = c & 7;
    const size_t qrow0 = (size_t)NPR + n * 8;
    bf16x8 bq[2]; v2u zaw[4];
#pragma unroll
    for (int ks = 0; ks < 2; ++ks) bq[ks] = *(const bf16x8*)(QA + (qrow0 + tq) * 2048 + hq * 64 + ks * 32 + 8 * gg);
#pragma unroll
    for (int nt = 0; nt < 4; ++nt) zaw[nt] = *(const v2u*)(ZA + (qrow0 + tq) * 2048 + hq * 64 + 16 * nt + 4 * gg);
    __syncthreads();
#pragma unroll
    for (int q = 0; q < 4; ++q) { const int p = F.tid + 512 * q, row = p >> 4, c4 = p & 15;
        const size_t off = ((size_t)(n * 128 + row) * 4 + g) * 64 + c4 * 4;
        const f32x4 kv = *(const f32x4*)(ck + off), vv = *(const f32x4*)(cv + off);
        v2u kw; kw.x = pk2(kv[0], kv[1]); kw.y = pk2(kv[2], kv[3]);
        *(LAS v2u*)(Ks + row * 144 + c4 * 8) = kw;
        LAS bf16* vt = VTs + (c4 * 4) * 168 + row;
        vt[0] = f2bf(vv[0]); vt[168] = f2bf(vv[1]); vt[336] = f2bf(vv[2]); vt[504] = f2bf(vv[3]);
        if (row >= 8) { const size_t oo = ((size_t)(n * 128 + row - 8) * 4 + g) * 64 + c4 * 4; *(f32x4*)(F.out + OUT_KWS + oo) = kv; *(f32x4*)(F.out + OUT_VWS + oo) = vv; } }
    if (F.tid < 256) { const int row = 128 + (F.tid >> 3), c = F.tid & 7;
        v4u kv = {0u, 0u, 0u, 0u}, vv = {0u, 0u, 0u, 0u};
        if (row < 136) { const size_t off = (size_t)(NPR + n * 8 + row - 128) * 256 + g * 64 + c * 8; kv = *(const v4u*)(KA + off); vv = *(const v4u*)(VA + off);
            const size_t oo = ((size_t)(n * 128 + row - 8) * 4 + g) * 64 + c * 8;
            *(f32x4*)(F.out + OUT_KWS + oo) = (f32x4){bflo(kv.x), bfhi(kv.x), bflo(kv.y), bfhi(kv.y)}; *(f32x4*)(F.out + OUT_KWS + oo + 4) = (f32x4){bflo(kv.z), bfhi(kv.z), bflo(kv.w), bfhi(kv.w)};
            *(f32x4*)(F.out + OUT_VWS + oo) = (f32x4){bflo(vv.x), bfhi(vv.x), bflo(vv.y), bfhi(vv.y)}; *(f32x4*)(F.out + OUT_VWS + oo + 4) = (f32x4){bflo(vv.z), bfhi(vv.z), bflo(vv.w), bfhi(vv.w)}; }
        *(LAS v4u*)(Ks + row * 144 + c * 16) = kv;
        LAS bf16* vt = VTs + (c * 8) * 168 + row;
        vt[0 * 168] = (bf16)(vv.x & 0xffff); vt[1 * 168] = (bf16)(vv.x >> 16); vt[2 * 168] = (bf16)(vv.y & 0xffff); vt[3 * 168] = (bf16)(vv.y >> 16);
        vt[4 * 168] = (bf16)(vv.z & 0xffff); vt[5 * 168] = (bf16)(vv.z >> 16); vt[6 * 168] = (bf16)(vv.w & 0xffff); vt[7 * 168] = (bf16)(vv.w >> 16); }
    __syncthreads();
    const float sink = FIN(11)[hq];
    f32x4 s[10];
#pragma unroll
    for (int kt = 0; kt < 10; ++kt) { f32x4 a = {0.f, 0.f, 0.f, 0.f};
#pragma unroll
        for (int ks = 0; ks < 2; ++ks) { const bf16x8 ak = *(const LAS bf16x8*)(Ks + (16 * kt + c) * 144 + (ks * 32 + 8 * gg) * 2); a = MFMA16(ak, bq[ks], a); }
        s[kt] = a; if ((kt & 3) == 3) asm volatile("" ::: "memory"); }
    float m = sink;
#pragma unroll
    for (int kt = 0; kt < 10; ++kt)
#pragma unroll
        for (int r = 0; r < 4; ++r) { const int kk = 16 * kt + 4 * gg + r; const bool valid = (kk >= tq) && (kk <= tq + 128) && (kk < 136);
            const float v = valid ? s[kt][r] * 0.125f : -1e30f; s[kt][r] = v; m = fmaxf(m, v); }
    m = fmaxf(m, __shfl_xor(m, 16)); m = fmaxf(m, __shfl_xor(m, 32));
    float sum = 0.f;
#pragma unroll
    for (int kt = 0; kt < 10; ++kt)
#pragma unroll
        for (int r = 0; r < 4; ++r) { const float p = (s[kt][r] > -1e29f) ? __expf(s[kt][r] - m) : 0.f; s[kt][r] = p; sum += p; }
    sum += __shfl_xor(sum, 16); sum += __shfl_xor(sum, 32);
    const float inv = 1.0f / (sum + __expf(sink - m));
    f32x4 o[4];
#pragma unroll
    for (int nt = 0; nt < 4; ++nt) o[nt] = (f32x4){0.f, 0.f, 0.f, 0.f};
#pragma unroll
    for (int j = 0; j < 5; ++j) { v4u pw; pw.x = pk2(s[2 * j][0], s[2 * j][1]); pw.y = pk2(s[2 * j][2], s[2 * j][3]); pw.z = pk2(s[2 * j + 1][0], s[2 * j + 1][1]); pw.w = pk2(s[2 * j + 1][2], s[2 * j + 1][3]);
        const bf16x8 pa = __builtin_bit_cast(bf16x8, pw);
#pragma unroll
        for (int nt = 0; nt < 4; ++nt) { const LAS bf16* vp = VTs + (16 * nt + c) * 168 + 32 * j + 4 * gg;
            const v2u v0 = *(const LAS v2u*)(vp), v1 = *(const LAS v2u*)(vp + 16);
            v4u vw; vw.x = v0.x; vw.y = v0.y; vw.z = v1.x; vw.w = v1.y;
            o[nt] = MFMA16(__builtin_bit_cast(bf16x8, vw), pa, o[nt]); }
        asm volatile("" ::: "memory"); }
    if (c < 8) {
#pragma unroll
        for (int nt = 0; nt < 4; ++nt) { v2u w; w.x = pk2(o[nt][0] * inv * bflo(zaw[nt].x), o[nt][1] * inv * bfhi(zaw[nt].x)); w.y = pk2(o[nt][2] * inv * bflo(zaw[nt].y), o[nt][3] * inv * bfhi(zaw[nt].y));
            *(v2u*)(AB + (qrow0 + c) * DM + hq * 64 + 16 * nt + 4 * gg) = w; } }
}

__device__ __forceinline__ float log_sigmoid_(float x) { return fminf(x, 0.f) - __logf(1.0f + __expf(-fabsf(x))); }

__device__ __forceinline__ void gla_prep_unit(Frame& F, const Args& A, int unit) {
    const int n = unit >> 8, h = (unit >> 6) & 3, ch = unit & 63;
    const size_t row0 = (size_t)n * SEQ + ch * 64;
    const bf16* QB = (const bf16*)(F.ws + WS_QB); const bf16* KB = (const bf16*)(F.ws + WS_KB); const bf16* VB = (const bf16*)(F.ws + WS_VB);
    const float* R = (const float*)(F.ws + WS_R); const float* w2 = FIN(12); const float* ba = FIN(13);
    bf16* QT = (bf16*)(F.ws + WS_QT) + (size_t)unit * 64 * 256; bf16* KDT = (bf16*)(F.ws + WS_KDT) + (size_t)unit * 256 * 64;
    bf16* ATT = (bf16*)(F.ws + WS_ATT) + (size_t)unit * 64 * 64; bf16* VT = (bf16*)(F.ws + WS_VT) + (size_t)unit * 512 * 64; float* DEC = (float*)(F.ws + WS_DEC) + (size_t)unit * 256;
    LAS float* Rs = (LAS float*)F.lds;
    LAS float* TOT = (LAS float*)(F.lds + 4096);
    LAS unsigned char* Vs = F.lds + 8192;
    LAS bf16* QS = (LAS bf16*)(F.lds + 8192);
    LAS bf16* KS = (LAS bf16*)(F.lds + 8192 + 33792);
    LAS float* BS = (LAS float*)(F.lds + 8192 + 67584);
    int tz = F.tid; asm volatile("" : "+v"(tz));
    v4u vreg[8], qreg[4], kreg[4]; f32x4 rreg = {0.f, 0.f, 0.f, 0.f};
#pragma unroll
    for (int q = 0; q < 8; ++q) { const int p = tz + 512 * q, row = p >> 6, c = p & 63; vreg[q] = *(const v4u*)(VB + (row0 + row) * 2048 + h * 512 + c * 8); }
#pragma unroll
    for (int q = 0; q < 4; ++q) { const int p = tz + 512 * q, row = p >> 5, c = p & 31; const size_t off = (row0 + row) * 1024 + h * 256 + c * 8; qreg[q] = *(const v4u*)(QB + off); kreg[q] = *(const v4u*)(KB + off); }
    if (tz < 256) rreg = *(const f32x4*)(R + row0 * 16 + tz * 4);
    __syncthreads();
    if (tz < 256) *(LAS f32x4*)(Rs + tz * 4) = rreg;
#pragma unroll
    for (int q = 0; q < 8; ++q) { const int p = tz + 512 * q, row = p >> 6, c = p & 63; *(LAS v4u*)(Vs + row * 1040 + c * 16) = vreg[q]; }
    __syncthreads();
    { const LAS bf16* vcol = (const LAS bf16*)Vs + tz;
#pragma unroll
      for (int t8 = 0; t8 < 8; ++t8) { unsigned e[8];
#pragma unroll
          for (int k = 0; k < 8; ++k) e[k] = vcol[(t8 * 8 + k) * 520];
          v4u o; o.x = e[0] | (e[1] << 16); o.y = e[2] | (e[3] << 16); o.z = e[4] | (e[5] << 16); o.w = e[6] | (e[7] << 16);
          *(v4u*)(VT + (size_t)tz * 64 + t8 * 8) = o; } }
    const int dk = tz & 255, half = tz >> 8;
    { float wv[16];
#pragma unroll
      for (int j = 0; j < 16; ++j) wv[j] = w2[j * 1024 + h * 256 + dk];
      const float bias = ba[h * 256 + dk];
      float run = 0.f;
#pragma unroll 4
      for (int tt = 0; tt < 32; ++tt) { const int t = half * 32 + tt; const LAS float* rr = Rs + t * 16; float x = bias;
#pragma unroll
          for (int j4 = 0; j4 < 4; ++j4) { const f32x4 rv = *(const LAS f32x4*)(rr + 4 * j4); x += rv[0] * wv[4 * j4] + rv[1] * wv[4 * j4 + 1] + rv[2] * wv[4 * j4 + 2] + rv[3] * wv[4 * j4 + 3]; }
          run += log_sigmoid_(x) * 0.0625f; BS[t * 256 + dk] = run; }
      TOT[half * 256 + dk] = run; }
    __syncthreads();
#pragma unroll
    for (int q = 0; q < 4; ++q) { const int p = tz + 512 * q, row = p >> 5, c = p & 31; *(LAS v4u*)(QS + row * 264 + c * 8) = qreg[q]; *(LAS v4u*)(KS + row * 264 + c * 8) = kreg[q]; }
    __syncthreads();
    { const float tot0 = TOT[dk], tot1 = TOT[256 + dk];
      const float off = half ? tot0 : 0.f, blast = tot0 + tot1;
#pragma unroll 1
      for (int q8 = 0; q8 < 4; ++q8) { unsigned kd[4];
#pragma unroll
          for (int e = 0; e < 8; ++e) { const int t = half * 32 + q8 * 8 + e;
              const float b = BS[t * 256 + dk] + off;
              const float q = bf2f(QS[t * 264 + dk]), k = bf2f(KS[t * 264 + dk]);
              const bf16 qt = f2bf(q * __expf(b) * 0.0625f), kt = f2bf(k * __expf(-b)); const unsigned kdv = f2bf(k * __expf(blast - b));
              QS[t * 264 + dk] = qt; KS[t * 264 + dk] = kt;
              if (e & 1) kd[e >> 1] |= kdv << 16; else kd[e >> 1] = kdv; }
          v4u o; o.x = kd[0]; o.y = kd[1]; o.z = kd[2]; o.w = kd[3]; *(v4u*)(KDT + (size_t)dk * 64 + half * 32 + 8 * q8) = o; }
      if (half == 0) DEC[dk] = __expf(blast); }
    __syncthreads();
#pragma unroll
    for (int q = 0; q < 4; ++q) { const int p = tz + 512 * q, t = p >> 5, c = p & 31, jb = c >> 2, g4 = c & 3;
        const LAS bf16* sp = QS + t * 264 + 32 * jb + 4 * g4;
        const v2u lo = *(const LAS v2u*)(sp), hi = *(const LAS v2u*)(sp + 16);
        v4u o; o.x = lo.x; o.y = lo.y; o.z = hi.x; o.w = hi.y;
        *(v4u*)(QT + (size_t)t * 256 + c * 8) = o; }
    { const int c = tz & 15, gg = (tz >> 4) & 3;
#pragma unroll
      for (int x = 0; x < 2; ++x) { const int id = F.wave * 2 + x, ti = id >> 2, si = id & 3;
          f32x4 a = {0.f, 0.f, 0.f, 0.f};
          if (si <= ti) {
#pragma unroll
              for (int ks = 0; ks < 8; ++ks) { const bf16x8 ak = *(const LAS bf16x8*)(KS + (16 * si + c) * 264 + ks * 32 + 8 * gg), bqv = *(const LAS bf16x8*)(QS + (16 * ti + c) * 264 + ks * 32 + 8 * gg);
                  a = MFMA16(ak, bqv, a); } }
          const int t = 16 * ti + c, s0 = 16 * si + 4 * gg;
          v2u o; o.x = pk2(s0 <= t ? a[0] : 0.f, s0 + 1 <= t ? a[1] : 0.f); o.y = pk2(s0 + 2 <= t ? a[2] : 0.f, s0 + 3 <= t ? a[3] : 0.f);
          *(v2u*)(ATT + (size_t)t * 64 + s0) = o; } }
}

__device__ __forceinline__ void win_prompt(Frame& F, const Args& A) {
    const bf16* KA = (const bf16*)(F.ws + WS_KA); const bf16* VA = (const bf16*)(F.ws + WS_VA);
    const size_t gt = (size_t)F.blk * 512 + F.tid, NT = (size_t)F.G * 512;
    for (size_t i = gt; i < 65536; i += NT) { const int b = (int)(i >> 15), rem = (int)(i & 32767); const size_t src = (size_t)(b * SEQ + SEQ - 128) * 256 + rem;
        F.out[OUT_KWP + i] = bf2f(KA[src]); F.out[OUT_VWP + i] = bf2f(VA[src]); }
}

constexpr int SEQ_QT = 0, SEQ_KD = 32768, SEQ_AT = 65536, SEQ_DC = 73728, SEQ_BUF = 74752;
constexpr int SEQ_CW = 2;
constexpr int SEQ_DVG = 512 / (16 * SEQ_CW);
#define SEQ_BARRIER() do { asm volatile("s_waitcnt lgkmcnt(0)" ::: "memory"); __builtin_amdgcn_s_barrier(); asm volatile("" ::: "memory"); } while (0)
__device__ __forceinline__ void gla_seq_unit(Frame& F, const Args& A, int unit) {
    const int nh = unit & 7, dvg = unit >> 3, n = nh >> 2, h = nh & 3;
    const bf16* QTg = (const bf16*)(F.ws + WS_QT) + (size_t)nh * 64 * 16384;
    const bf16* KDg = (const bf16*)(F.ws + WS_KDT) + (size_t)nh * 64 * 16384;
    const bf16* ATg = (const bf16*)(F.ws + WS_ATT) + (size_t)nh * 64 * 4096;
    const float* DCg = (const float*)(F.ws + WS_DEC) + (size_t)nh * 64 * 256;
    const bf16* VTg = (const bf16*)(F.ws + WS_VT) + (size_t)nh * 64 * 32768;
    __syncthreads();
    if (F.wave >= 4) {
        const int lt = F.tid - 256;
        v4u rq[2][8], rk[2][8], ra[2][2]; f32x4 rd[2] = {{0.f, 0.f, 0.f, 0.f}, {0.f, 0.f, 0.f, 0.f}};
#define SEQ_LOAD(sx, chx) do { const bf16* q_ = QTg + (size_t)(chx) * 16384; const bf16* k_ = KDg + (size_t)(chx) * 16384; const bf16* a_ = ATg + (size_t)(chx) * 4096; \
        _Pragma("unroll") for (int i = 0; i < 8; ++i) { rq[sx][i] = *(const v4u*)(q_ + (size_t)(lt + 256 * i) * 8); rk[sx][i] = *(const v4u*)(k_ + (size_t)(lt + 256 * i) * 8); } \
        _Pragma("unroll") for (int i = 0; i < 2; ++i) ra[sx][i] = *(const v4u*)(a_ + (size_t)(lt + 256 * i) * 8); \
        if (lt < 64) rd[sx] = *(const f32x4*)(DCg + (size_t)(chx) * 256 + lt * 4); } while (0)
#define SEQ_WRITE(sx, bufx) do { LAS unsigned char* b_ = F.lds + (bufx) * SEQ_BUF; \
        _Pragma("unroll") for (int i = 0; i < 8; ++i) { const int p = lt + 256 * i; \
            { const int row = p >> 5, slot = p & 31; *(LAS v4u*)(b_ + SEQ_QT + row * 512 + ((slot ^ (row & 15)) << 4)) = rq[sx][i]; } \
            { const int row = p >> 3, slot = p & 7;  *(LAS v4u*)(b_ + SEQ_KD + row * 128 + ((slot ^ ((row >> 1) & 7)) << 4)) = rk[sx][i]; } } \
        _Pragma("unroll") for (int i = 0; i < 2; ++i) { const int p = lt + 256 * i, row = p >> 3, slot = p & 7; *(LAS v4u*)(b_ + SEQ_AT + row * 128 + ((slot ^ ((row >> 1) & 7)) << 4)) = ra[sx][i]; } \
        if (lt < 64) *(LAS f32x4*)(b_ + SEQ_DC + lt * 16) = rd[sx]; } while (0)
        SEQ_LOAD(0, 0); SEQ_WRITE(0, 0); SEQ_LOAD(1, 1); SEQ_LOAD(0, 2);
        SEQ_BARRIER();
        for (int ch = 0; ch < 64; ch += 2) {
            SEQ_WRITE(1, 1); if (ch + 3 < 64) SEQ_LOAD(1, ch + 3);
            SEQ_BARRIER();
            if (ch + 2 < 64) { SEQ_WRITE(0, 0); if (ch + 4 < 64) SEQ_LOAD(0, ch + 4); }
            SEQ_BARRIER();
        }
#undef SEQ_LOAD
#undef SEQ_WRITE
    } else if (F.wave >= SEQ_CW) {
        for (int ch = 0; ch < 65; ++ch) SEQ_BARRIER();
    } else {
        const int c = F.lane & 15, gg = F.lane >> 4, sa = (c >> 1) & 7;
        const int dv0 = dvg * (16 * SEQ_CW) + F.wave * 16;
        float* OB = (float*)(F.ws + WS_OB);
        f32x4 S[16];
#pragma unroll
        for (int i = 0; i < 16; ++i) S[i] = (f32x4){0.f, 0.f, 0.f, 0.f};
        const bf16* vtp = VTg + (size_t)(dv0 + c) * 64 + 8 * gg;
        bf16x8 vf[2], vn[2];
#pragma unroll
        for (int j = 0; j < 2; ++j) vf[j] = *(const bf16x8*)(vtp + 32 * j);
        SEQ_BARRIER();
        for (int ch = 0; ch < 64; ++ch) {
            const LAS unsigned char* b_ = F.lds + (ch & 1) * SEQ_BUF;
            { const int cn = (ch + 1 < 64) ? ch + 1 : ch;
#pragma unroll
              for (int j = 0; j < 2; ++j) vn[j] = *(const bf16x8*)(vtp + (size_t)cn * 32768 + 32 * j); }
#define SEQ_LDQ(dst, jx) do { _Pragma("unroll") for (int mt = 0; mt < 4; ++mt) dst[mt] = *(const LAS bf16x8*)(b_ + SEQ_QT + (16 * mt + c) * 512 + (((4 * (jx) + gg) ^ c) << 4)); } while (0)
#define SEQ_LDK(kd_, dd_, gx) do { _Pragma("unroll") for (int e = 0; e < 2; ++e) { dd_[e] = *(const LAS f32x4*)(b_ + SEQ_DC + (16 * (2 * (gx) + e) + 4 * gg) * 4); \
            _Pragma("unroll") for (int j = 0; j < 2; ++j) kd_[e][j] = *(const LAS bf16x8*)(b_ + SEQ_KD + (16 * (2 * (gx) + e) + c) * 128 + (((4 * j + gg) ^ sa) << 4)); } } while (0)
            f32x4 o[4];
            bf16x8 af[4][2], qf[2][4];
#pragma unroll
            for (int mt = 0; mt < 4; ++mt)
#pragma unroll
                for (int j = 0; j < 2; ++j) af[mt][j] = *(const LAS bf16x8*)(b_ + SEQ_AT + (16 * mt + c) * 128 + (((4 * j + gg) ^ sa) << 4));
            SEQ_LDQ(qf[0], 0);
            __builtin_amdgcn_sched_barrier(0);
#pragma unroll
            for (int mt = 0; mt < 4; ++mt) { f32x4 a = {0.f, 0.f, 0.f, 0.f}; a = MFMA16(af[mt][0], vf[0], a); a = MFMA16(af[mt][1], vf[1], a); o[mt] = a; }
            bf16x8 kf[2][2][2]; f32x4 dd[2][2];
#pragma unroll
            for (int j = 0; j < 8; ++j) {
                if (j < 7) SEQ_LDQ(qf[(j + 1) & 1], j + 1); else SEQ_LDK(kf[0], dd[0], 0);
                v4u sw; sw.x = pk2(S[2 * j][0], S[2 * j][1]); sw.y = pk2(S[2 * j][2], S[2 * j][3]); sw.z = pk2(S[2 * j + 1][0], S[2 * j + 1][1]); sw.w = pk2(S[2 * j + 1][2], S[2 * j + 1][3]);
                const bf16x8 sb = __builtin_bit_cast(bf16x8, sw);
                __builtin_amdgcn_sched_barrier(0);
#pragma unroll
                for (int mt = 0; mt < 4; ++mt) o[mt] = MFMA16(qf[j & 1][mt], sb, o[mt]);
                __builtin_amdgcn_sched_barrier(0);
            }
#pragma unroll
            for (int g2 = 0; g2 < 8; ++g2) {
                if (g2 < 7) SEQ_LDK(kf[(g2 + 1) & 1], dd[(g2 + 1) & 1], g2 + 1);
                __builtin_amdgcn_sched_barrier(0);
#pragma unroll
                for (int e = 0; e < 2; ++e) { f32x4 a = S[2 * g2 + e] * dd[g2 & 1][e]; a = MFMA16(kf[g2 & 1][e][0], vf[0], a); a = MFMA16(kf[g2 & 1][e][1], vf[1], a); S[2 * g2 + e] = a; }
                __builtin_amdgcn_sched_barrier(0);
            }
#undef SEQ_LDQ
#undef SEQ_LDK
#pragma unroll
            for (int mt = 0; mt < 4; ++mt)
#pragma unroll
                for (int r = 0; r < 4; ++r) OB[((size_t)n * SEQ + ch * 64 + 16 * mt + 4 * gg + r) * 2048 + h * 512 + dv0 + c] = o[mt][r];
            vf[0] = vn[0]; vf[1] = vn[1];
            SEQ_BARRIER();
        }
        float* gsp = F.out + OUT_GSP + (size_t)nh * 256 * 512;
#pragma unroll
        for (int i = 0; i < 16; ++i)
#pragma unroll
            for (int r = 0; r < 4; ++r) gsp[(size_t)(16 * i + 4 * gg + r) * 512 + dv0 + c] = S[i][r];
    }
}

__device__ __forceinline__ void gla_sample_unit(Frame& F, const Args& A, int unit) {
    const int n = unit >> 2, h = unit & 3;
    const size_t row0 = (size_t)NPR + n * 8;
    const bf16* QB = (const bf16*)(F.ws + WS_QB); const bf16* KB = (const bf16*)(F.ws + WS_KB); const bf16* VB = (const bf16*)(F.ws + WS_VB); const bf16* ZB = (const bf16*)(F.ws + WS_ZB);
    const float* R = (const float*)(F.ws + WS_R); const float* w2 = FIN(12); const float* ba = FIN(13); const float* gg_ = FIN(14);
    bf16* AB = (bf16*)(F.ws + WS_AB);
    LAS float* QTs = (LAS float*)F.lds;
    LAS float* KDs = (LAS float*)(F.lds + 8192);
    LAS float* KTs = (LAS float*)(F.lds + 16384);
    LAS float* DCs = (LAS float*)(F.lds + 24576);
    LAS float* ATs = (LAS float*)(F.lds + 25600);
    LAS float* Rs  = (LAS float*)(F.lds + 25856);
    LAS float* RED = (LAS float*)(F.lds + 26624);
    int tz = F.tid; asm volatile("" : "+v"(tz));
    const int dv4 = (tz & 127) * 4, dkq = tz >> 7;
    const float* s0p = FIN(4) + (size_t)unit * 256 * 512 + (size_t)dkq * 512 + dv4;
    float* s1p = F.out + OUT_GSS + (size_t)unit * 256 * 512 + (size_t)dkq * 512 + dv4;
    f32x4 sb[8];
    const float* lp = s0p;
#pragma unroll
    for (int k = 0; k < 8; ++k) { sb[k] = __builtin_nontemporal_load((const f32x4*)lp); lp += 2048; asm volatile("" : "+v"(lp)); }
    SEQ_BARRIER();
    if (F.tid < 32) *(LAS f32x4*)(Rs + F.tid * 4) = *(const f32x4*)(R + row0 * 16 + F.tid * 4);
    SEQ_BARRIER();
    if (F.tid < 256) { const int dk = F.tid;
        float wv[16];
#pragma unroll
        for (int j = 0; j < 16; ++j) wv[j] = w2[j * 1024 + h * 256 + dk];
        const float bias = ba[h * 256 + dk];
        float b[8]; float run = 0.f;
#pragma unroll
        for (int t = 0; t < 8; ++t) { const LAS float* rr = Rs + t * 16; float x = bias;
#pragma unroll
            for (int j4 = 0; j4 < 4; ++j4) { const f32x4 rv = *(const LAS f32x4*)(rr + 4 * j4); x += rv[0] * wv[4 * j4] + rv[1] * wv[4 * j4 + 1] + rv[2] * wv[4 * j4 + 2] + rv[3] * wv[4 * j4 + 3]; }
            run += log_sigmoid_(x) * 0.0625f; b[t] = run; asm volatile("" ::: "memory"); }
        const float blast = run;
#pragma unroll
        for (int t = 0; t < 8; ++t) { const float q = bf2f(QB[(row0 + t) * 1024 + h * 256 + dk]), k = bf2f(KB[(row0 + t) * 1024 + h * 256 + dk]);
            QTs[dk * 8 + t] = q * __expf(b[t]) * 0.0625f; KTs[dk * 8 + t] = k * __expf(-b[t]); KDs[dk * 8 + t] = k * __expf(blast - b[t]); }
        DCs[dk] = __expf(blast);
    }
    SEQ_BARRIER();
    { const int t = F.wave; float a[8];
#pragma unroll
      for (int s = 0; s < 8; ++s) a[s] = 0.f;
#pragma unroll
      for (int q = 0; q < 4; ++q) { const int dk = F.lane + 64 * q; const float qv = QTs[dk * 8 + t];
#pragma unroll
          for (int s = 0; s < 8; ++s) a[s] += qv * KTs[dk * 8 + s]; }
#pragma unroll
      for (int s = 0; s < 8; ++s) { const float v = wave_sum(a[s]); if (F.lane == 0) ATs[t * 8 + s] = (s <= t) ? v : 0.f; } }
    f32x4 vv[8];
#pragma unroll
    for (int s = 0; s < 8; ++s) { const v2u w = *(const v2u*)(VB + (row0 + s) * 2048 + h * 512 + dv4); vv[s] = (f32x4){bflo(w.x), bfhi(w.x), bflo(w.y), bfhi(w.y)}; }
    f32x4 oa[8];
#pragma unroll
    for (int t = 0; t < 8; ++t) oa[t] = (f32x4){0.f, 0.f, 0.f, 0.f};
    float* sp = s1p;
#define SMP_BATCH(PF) do { _Pragma("unroll") for (int k = 0; k < 8; ++k) { const int dk = (bt * 8 + k) * 4 + dkq; \
            const f32x4 s0 = sb[k]; \
            if (PF) { sb[k] = __builtin_nontemporal_load((const f32x4*)lp); lp += 2048; asm volatile("" : "+v"(lp)); } \
            const f32x4 q0 = *(const LAS f32x4*)(QTs + dk * 8), q1 = *(const LAS f32x4*)(QTs + dk * 8 + 4); \
            const f32x4 k0 = *(const LAS f32x4*)(KDs + dk * 8), k1 = *(const LAS f32x4*)(KDs + dk * 8 + 4); \
            const float d = DCs[dk]; \
            oa[0] += s0 * q0[0]; oa[1] += s0 * q0[1]; oa[2] += s0 * q0[2]; oa[3] += s0 * q0[3]; \
            oa[4] += s0 * q1[0]; oa[5] += s0 * q1[1]; oa[6] += s0 * q1[2]; oa[7] += s0 * q1[3]; \
            f32x4 sn = s0 * d; \
            sn += vv[0] * k0[0]; sn += vv[1] * k0[1]; sn += vv[2] * k0[2]; sn += vv[3] * k0[3]; \
            sn += vv[4] * k1[0]; sn += vv[5] * k1[1]; sn += vv[6] * k1[2]; sn += vv[7] * k1[3]; \
            __builtin_nontemporal_store(sn, (f32x4*)sp); sp += 2048; asm volatile("" : "+v"(sp)); \
            if (k & 1) asm volatile("" ::: "memory"); } } while (0)
    { int bt = 0;
#pragma unroll 1
      for (; bt < 7; ++bt) SMP_BATCH(true);
      SMP_BATCH(false); }
#undef SMP_BATCH
#pragma unroll
    for (int t = 0; t < 8; ++t) *(LAS f32x4*)(RED + ((dkq * 8 + t) * 512 + dv4)) = oa[t];
    SEQ_BARRIER();
    { const int t = F.tid >> 6, d8 = (F.tid & 63) * 8;
      float o[8];
#pragma unroll
      for (int e = 0; e < 8; ++e) o[e] = 0.f;
#pragma unroll
      for (int q = 0; q < 4; ++q) { const f32x4 a = *(const LAS f32x4*)(RED + (q * 8 + t) * 512 + d8), b = *(const LAS f32x4*)(RED + (q * 8 + t) * 512 + d8 + 4);
          o[0] += a[0]; o[1] += a[1]; o[2] += a[2]; o[3] += a[3]; o[4] += b[0]; o[5] += b[1]; o[6] += b[2]; o[7] += b[3]; }
#pragma unroll
      for (int s = 0; s < 8; ++s) { const float at = ATs[t * 8 + s]; const v4u w = *(const v4u*)(VB + (row0 + s) * 2048 + h * 512 + d8);
          o[0] += at * bflo(w.x); o[1] += at * bfhi(w.x); o[2] += at * bflo(w.y); o[3] += at * bfhi(w.y); o[4] += at * bflo(w.z); o[5] += at * bfhi(w.z); o[6] += at * bflo(w.w); o[7] += at * bfhi(w.w); }
      float ss = 0.f;
#pragma unroll
      for (int e = 0; e < 8; ++e) ss += o[e] * o[e];
      ss = wave_sum(ss);
      const float rstd = rsqrtf(ss * (1.0f / 512.0f) + EPS);
      const v4u zw = *(const v4u*)(ZB + (row0 + t) * 2048 + h * 512 + d8);
      const f32x4 g0 = *(const f32x4*)(gg_ + h * 512 + d8), g1 = *(const f32x4*)(gg_ + h * 512 + d8 + 4);
      v4u w; w.x = pk2(o[0] * rstd * g0[0] * bflo(zw.x), o[1] * rstd * g0[1] * bfhi(zw.x)); w.y = pk2(o[2] * rstd * g0[2] * bflo(zw.y), o[3] * rstd * g0[3] * bfhi(zw.y));
      w.z = pk2(o[4] * rstd * g1[0] * bflo(zw.z), o[5] * rstd * g1[1] * bfhi(zw.z)); w.w = pk2(o[6] * rstd * g1[2] * bflo(zw.w), o[7] * rstd * g1[3] * bfhi(zw.w));
      *(v4u*)(AB + (row0 + t) * DM + 2048 + h * 512 + d8) = w; }
}
__device__ __forceinline__ void gla_sample_loop(Frame& F, const Args& A, unsigned* ctr) {
    volatile LAS unsigned* MISC = (volatile LAS unsigned*)(F.lds + MISC_OFF);
    for (;;) {
        __syncthreads();
        if (F.tid == 0) MISC[16] = __hip_atomic_fetch_add(ctr, 1u, __ATOMIC_RELAXED, __HIP_MEMORY_SCOPE_AGENT);
        __syncthreads();
        const int u = __builtin_amdgcn_readfirstlane((int)MISC[16]);
        if (u >= 512) break;
        gla_sample_unit(F, A, u);
    }
}

__device__ __forceinline__ void phase6(Frame& F, const Args& A) {
    const float* OB = (const float*)(F.ws + WS_OB); const bf16* ZB = (const bf16*)(F.ws + WS_ZB); const float* gn = FIN(14); bf16* AB = (bf16*)(F.ws + WS_AB);
    const int gw = F.blk * NWAVES + F.wave, NGW = F.G * NWAVES, lane = F.lane;
    if (gw >= NPR) return;
    const int nr = (NPR - gw + NGW - 1) / NGW;
    f32x4 gr[4][2];
#pragma unroll
    for (int hh = 0; hh < 4; ++hh) { gr[hh][0] = *(const f32x4*)(gn + hh * 512 + lane * 8); gr[hh][1] = *(const f32x4*)(gn + hh * 512 + lane * 8 + 4); }
    auto rowof = [&](int i) { const int ic = (i < nr) ? i : nr - 1; return gw + ic * NGW; };
    auto process = [&](const f32x4 (&a)[4][2], const v4u (&z)[4], int row) {
#pragma unroll
        for (int hh = 0; hh < 4; ++hh) { const int col = hh * 512 + lane * 8;
            const f32x4 x0 = a[hh][0], x1 = a[hh][1];
            float ss = (x0[0] * x0[0] + x0[1] * x0[1]) + (x0[2] * x0[2] + x0[3] * x0[3]) + (x1[0] * x1[0] + x1[1] * x1[1]) + (x1[2] * x1[2] + x1[3] * x1[3]);
            ss = wave_sum(ss);
            const float rstd = rsqrtf(ss * (1.0f / 512.0f) + EPS);
            const v4u zw = z[hh];
            const f32x4 g0 = gr[hh][0], g1 = gr[hh][1];
            v4u w; w.x = pk2(x0[0] * rstd * g0[0] * bflo(zw.x), x0[1] * rstd * g0[1] * bfhi(zw.x)); w.y = pk2(x0[2] * rstd * g0[2] * bflo(zw.y), x0[3] * rstd * g0[3] * bfhi(zw.y));
            w.z = pk2(x1[0] * rstd * g1[0] * bflo(zw.z), x1[1] * rstd * g1[1] * bfhi(zw.z)); w.w = pk2(x1[2] * rstd * g1[2] * bflo(zw.w), x1[3] * rstd * g1[3] * bfhi(zw.w));
            *(v4u*)(AB + (size_t)row * DM + 2048 + col) = w; }
    };
#define P6_LOAD(a_, z_, r) do { _Pragma("unroll") for (int hh = 0; hh < 4; ++hh) { const size_t o_ = (size_t)(r) * 2048 + hh * 512 + lane * 8; \
        a_[hh][0] = *(const f32x4*)(OB + o_); a_[hh][1] = *(const f32x4*)(OB + o_ + 4); z_[hh] = *(const v4u*)(ZB + o_); } } while (0)
    f32x4 aa[4][2], ab[4][2]; v4u za[4], zb[4];
    P6_LOAD(aa, za, rowof(0));
    int i = 0;
#pragma unroll 1
    for (; i + 1 < nr; i += 2) {
        P6_LOAD(ab, zb, rowof(i + 1));
        process(aa, za, rowof(i));
        P6_LOAD(aa, za, rowof(i + 2));
        process(ab, zb, rowof(i + 1));
    }
    if (i < nr) process(aa, za, rowof(i));
#undef P6_LOAD
}

__device__ __forceinline__ void phase9(Frame& F, const Args& A) {
    const float* SSQ = (const float*)(F.ws + WS_SSQ); const float* fg = FIN(18); float* Y = F.out + OUT_Y; const bf16* XN = (const bf16*)(F.ws + WS_XN);
    const int gw = F.blk * NWAVES + F.wave, NGW = F.G * NWAVES, lane = F.lane;
    int extra; const int nr = wave_rows(NROW, gw, NGW, extra);
    if (nr == 0) return;
    const int nfull = NROW / NGW;
    f32x4 gr[8][2];
#pragma unroll
    for (int q = 0; q < 8; ++q) { const int c = 8 * (lane + 64 * q); gr[q][0] = *(const f32x4*)(fg + c); gr[q][1] = *(const f32x4*)(fg + c + 4); }
    auto rowof = [&](int i) { const int ic = (i < nr) ? i : nr - 1; return (ic < nfull) ? gw + ic * NGW : extra; };
    auto process = [&](const v4u (&v)[8], float sq, int row) {
        const float rstd = rsqrtf(wave_sum(sq) * (1.0f / DM) + EPS);
        float* yw = Y + (size_t)row * DM;
#pragma unroll
        for (int q = 0; q < 8; ++q) { const int c = 8 * (lane + 64 * q);
            const f32x4 a = {bflo(v[q].x), bfhi(v[q].x), bflo(v[q].y), bfhi(v[q].y)}, b = {bflo(v[q].z), bfhi(v[q].z), bflo(v[q].w), bfhi(v[q].w)};
            __builtin_nontemporal_store(a * rstd * gr[q][0], (f32x4*)(yw + c)); __builtin_nontemporal_store(b * rstd * gr[q][1], (f32x4*)(yw + c + 4)); }
    };
#define P9_LOAD(v_, sq_, r) do { const bf16* xr_ = XN + (size_t)(r) * DM + 8 * lane; _Pragma("unroll") for (int q = 0; q < 8; ++q) v_[q] = *(const v4u*)(xr_ + 512 * q); \
        sq_ = SSQ[(size_t)(r) * 64 + lane]; } while (0)
    v4u va[8], vb[8]; float sa, sb_;
    P9_LOAD(va, sa, rowof(0));
    int i = 0;
#pragma unroll 1
    for (; i + 1 < nr; i += 2) {
        P9_LOAD(vb, sb_, rowof(i + 1));
        process(va, sa, rowof(i));
        P9_LOAD(va, sa, rowof(i + 2));
        process(vb, sb_, rowof(i + 1));
    }
    if (i < nr) process(va, sa, rowof(i));
#undef P9_LOAD
}

constexpr int N_PHASES = 10;
constexpr int P3_NCG = 3;

__global__ void __launch_bounds__(NWAVES * 64, 2) mk_fwd(Args args) {
    extern __shared__ __attribute__((aligned(16))) unsigned char lds[];
    Frame F;
    F.lds = (LAS unsigned char*)lds;
    F.tid = threadIdx.x; F.lane = F.tid & 63; F.wave = __builtin_amdgcn_readfirstlane(F.tid >> 6);
    F.G = gridDim.x; F.blk = blockIdx.x;
    const Args& A = args;
    F.out = args.out; F.ws = args.ws;
    volatile LAS unsigned* MISC = (volatile LAS unsigned*)(F.lds + MISC_OFF);
    if (F.tid < 32) MISC[F.tid] = 0u;
    __syncthreads();
    unsigned* ctl = (unsigned*)(F.ws + WS_CTL);
    XcdBarrier bar; bar.bar = ctl + CW_BAR; bar.x = 0; bar.st = nullptr;
    if (MK_N_LAUNCHES == 1) bar = xcd_barrier_post(ctl + CW_BAR, MISC + 8);
    const int lo = args.ph_lo, hi = args.ph_hi;
#ifdef ONLY
#define IN(k) ((k) == ONLY)
#else
#define IN(k) (lo <= (k) && (k) < hi)
#endif
#define SEAM(k) do { if (IN(k) && IN((k) + 1)) xcd_barrier(bar); } while (0)
#ifndef PROBE_REPEAT
#define PROBE_REPEAT -1
#endif
#define PH(k, ...) do { if (IN(k)) { const int reps_ = (PROBE_REPEAT == (k)) ? args.ph_rep : 1; _Pragma("nounroll") for (int r_ = 0; r_ < reps_; ++r_) { { __VA_ARGS__ } if (r_ + 1 < reps_) xcd_barrier(bar); } } SEAM(k); } while (0)

    PH(0, phase0(F, A););
    PH(1, phase1(F, A, ctl););
    PH(2, phase2(F, A););
    PH(3,
        pg8::Gemm g{(const bf16*)(F.ws + WS_H), (const bf16*)(F.ws + WS_WB1), NROW, N1, DM}; pg8::GroupedOrder S; S.init(NROW, N1, F.G, F.blk, P3_NCG);
        EpiProj E{F.ws};
        pg8::gemm_phase<EpiProj, pg8::GroupedOrder>(F.lds, g, S, E);
        transpose_queue<1>(F, A, ctl + CW_TRN2);
    );
    int p5_pass = 0;
    PH(4,
        for (int u = F.blk; u < 256; u += F.G) swa_prompt_unit(F, A, u);
        for (int u = F.blk; u < 512; u += F.G) gla_prep_unit(F, A, u);
        for (int u = F.blk; u < 512; u += F.G) swa_sample_unit(F, A, u);
        win_prompt(F, A);
    );
    PH(5,
        for (int u = F.blk; u < 8 * SEQ_DVG; u += F.G) gla_seq_unit(F, A, u);
        gla_sample_loop(F, A, ctl + CW_SMP + 64 * p5_pass); ++p5_pass;
    );
    if (PROBE_REPEAT == 40) { for (int u = F.blk; u < 256; u += F.G) swa_prompt_unit(F, A, u); xcd_barrier(bar); }
    if (PROBE_REPEAT == 41) { for (int u = F.blk; u < 512; u += F.G) gla_prep_unit(F, A, u); xcd_barrier(bar); }
    if (PROBE_REPEAT == 42) { for (int u = F.blk; u < 512; u += F.G) swa_sample_unit(F, A, u); xcd_barrier(bar); }
    if (PROBE_REPEAT == 50) { for (int u = F.blk; u < 8 * SEQ_DVG; u += F.G) gla_seq_unit(F, A, u); xcd_barrier(bar); }
    if (PROBE_REPEAT == 51) { gla_sample_loop(F, A, ctl + CW_SMP + 64 * p5_pass); xcd_barrier(bar); }
    PH(6, phase6(F, A););
    PH(7,
        pg8::Gemm g{(const bf16*)(F.ws + WS_AB), (const bf16*)(F.ws + WS_WB2), NROW, DM, DM}; pg8::StaticOrder S; S.init(NROW, DM, F.G, F.blk, 192);
        EpiMerge E{(const bf16*)(F.ws + WS_SGA), (const bf16*)(F.ws + WS_SGB), (bf16*)(F.ws + WS_MERGED)};
        pg8::gemm_phase<EpiMerge>(F.lds, g, S, E);
    );
    PH(8,
        pg8::Gemm g{(const bf16*)(F.ws + WS_MERGED), (const bf16*)(F.ws + WS_WB3), NROW, DM, DM}; pg8::StaticOrder S; S.init(NROW, DM, F.G, F.blk, 192);
        EpiOut E{A.in[0], A.in[1], (const float*)(F.ws + WS_MOD), (bf16*)(F.ws + WS_XN), (float*)(F.ws + WS_SSQ)};
        pg8::gemm_phase<EpiOut>(F.lds, g, S, E);
    );
    if (IN(9)) { phase9(F, A); }
    if (PROBE_REPEAT == 900) { for (int i = 0; i < 8; ++i) xcd_barrier(bar); }
#undef IN
#undef SEAM
#undef PH
}

extern "C" void kernel_launch(void* const* d_in, const int* in_sizes, int n_in, void* d_out, int out_size, void* d_ws, size_t ws_size, hipStream_t stream) {
    static int grid = 0;
    if (grid == 0) {
        if (n_in != 19 || (size_t)out_size != OUT_TOTAL || ws_size < WS_END) { fprintf(stderr, "kernel_launch: unexpected sizes n_in %d out %d ws %zu (need %zu)\n", n_in, out_size, ws_size, (size_t)WS_END); grid = -1; return; }
        int dev = 0, cus = 0, per_cu = 0;
        if (hipGetDevice(&dev) != hipSuccess || hipDeviceGetAttribute(&cus, hipDeviceAttributeMultiprocessorCount, dev) != hipSuccess) { grid = -1; return; }
        if (hipFuncSetAttribute((const void*)mk_fwd, hipFuncAttributeMaxDynamicSharedMemorySize, LDS_BYTES) != hipSuccess) { fprintf(stderr, "kernel_launch: hipFuncSetAttribute failed\n"); grid = -1; return; }
        if (hipOccupancyMaxActiveBlocksPerMultiprocessor(&per_cu, (const void*)mk_fwd, NWAVES * 64, LDS_BYTES) != hipSuccess || per_cu < 1) fprintf(stderr, "kernel_launch: occupancy query reports %d\n", per_cu);
        (void)hipGetLastError();
        grid = cus;
    }
    if (grid < 0) return;
    (void)hipMemsetAsync((char*)d_ws + WS_CTL, 0, CTL_ZERO_BYTES, stream);
    Args a{};
    for (int i = 0; i < 19; ++i) a.in[i] = (const float*)d_in[i];
    a.out = (float*)d_out; a.ws = (unsigned char*)d_ws;
    a.ph_rep = 2; a.pad_ = 0;
    if (MK_N_LAUNCHES == 1) { a.ph_lo = 0; a.ph_hi = N_PHASES; hipLaunchKernelGGL(mk_fwd, dim3(grid), dim3(NWAVES * 64), LDS_BYTES, stream, a); }
    else for (int li = 0; li < N_PHASES; ++li) { a.ph_lo = li; a.ph_hi = li + 1; hipLaunchKernelGGL(mk_fwd, dim3(grid), dim3(NWAVES * 64), LDS_BYTES, stream, a); }
}
```

```cpp
#include <hip/hip_runtime.h>
#include <cstdio>
#include <cstdint>

#ifndef MK_N_LAUNCHES
#define MK_N_LAUNCHES 1
#endif

#define GAS __attribute__((address_space(1)))
#define LAS __attribute__((address_space(3)))
typedef unsigned short bf16;
typedef unsigned v4u __attribute__((ext_vector_type(4)));
typedef unsigned v2u __attribute__((ext_vector_type(2)));
typedef float f32x2 __attribute__((ext_vector_type(2)));
typedef float f32x4 __attribute__((ext_vector_type(4)));
typedef float f32x16 __attribute__((ext_vector_type(16)));
typedef short bf16x8 __attribute__((ext_vector_type(8)));
typedef __bf16 bf16x2_t __attribute__((ext_vector_type(2)));
#define LDS_WAIT() asm volatile("s_waitcnt lgkmcnt(0)" ::: "memory")
#define VM_WAIT() asm volatile("s_waitcnt vmcnt(0)" ::: "memory")

__device__ __forceinline__ unsigned pk2(float lo, float hi) { f32x2 v = {lo, hi}; bf16x2_t b = __builtin_convertvector(v, bf16x2_t); return __builtin_bit_cast(unsigned, b); }
__device__ __forceinline__ bf16 f2bf(float f) { return (bf16)(pk2(f, 0.f) & 0xffffu); }
__device__ __forceinline__ float bf2f(bf16 b) { return __uint_as_float(((unsigned)b) << 16); }
__device__ __forceinline__ float bflo(unsigned w) { return __uint_as_float(w << 16); }
__device__ __forceinline__ float bfhi(unsigned w) { return __uint_as_float(w & 0xffff0000u); }
__device__ __forceinline__ float wave_sum(float v) {
#pragma unroll
    for (int o = 1; o < 64; o <<= 1) v += __shfl_xor(v, o);
    return v;
}
__device__ __forceinline__ float sigmoidf_(float x) { return __builtin_amdgcn_rcpf(1.0f + __builtin_amdgcn_exp2f(-1.44269504089f * x)); }

#define XB_TMO      128
#define XB_XCNT(j)  (256  + 64 * (j))
#define XB_XSUB(j)  (1280 + 64 * (j))
#define XB_XGEN(j)  (2304 + 64 * (j))
#define XB_TOP      3328
#define XB_TOPGEN   3392
#define XCD_BAR_WORDS 3456
#define XB_SPIN_CAP (1u << 18)

__device__ __forceinline__ unsigned xb_ld(unsigned* p)              { return __hip_atomic_load(p, __ATOMIC_RELAXED, __HIP_MEMORY_SCOPE_AGENT); }
__device__ __forceinline__ unsigned xb_add(unsigned* p, unsigned v) { return __hip_atomic_fetch_add(p, v, __ATOMIC_RELAXED, __HIP_MEMORY_SCOPE_AGENT); }
__device__ __forceinline__ unsigned xb_xcc_id() { return (unsigned)__builtin_amdgcn_s_getreg((3 << 11) | 20) & 0xFu; }
#define XB_SPIN(cond, bar) do { unsigned _sp = 0; while (cond) { __builtin_amdgcn_s_sleep(1); \
    if ((++_sp & 255u) == 0u) { if (xb_ld(&(bar)[XB_TMO])) break; if (_sp > XB_SPIN_CAP) { atomicAdd(&(bar)[XB_TMO], 1u); break; } } } } while (0)

struct XcdBarrier { unsigned* bar; unsigned x; volatile LAS unsigned* st; };

__device__ __forceinline__ XcdBarrier xcd_barrier_post(unsigned* bar, volatile LAS unsigned* st) {
    XcdBarrier b; b.bar = bar; b.x = xb_xcc_id(); b.st = st;
    if (threadIdx.x == 0) (void)xb_add(&bar[XB_XCNT(b.x)], 1u);
    return b;
}
__device__ __forceinline__ void xcd_barrier_complete(unsigned* bar, unsigned x, unsigned& nloc, unsigned& nx) {
    const unsigned G = gridDim.x * gridDim.y * gridDim.z;
    unsigned sum, cnt, mine, sp = 0u;
    for (;;) {
        sum = 0u; cnt = 0u; mine = 0u;
#pragma unroll
        for (unsigned j = 0; j < 16; ++j) { const unsigned c = xb_ld(&bar[XB_XCNT(j)]); sum += c; cnt += (c > 0u) ? 1u : 0u; mine = (j == x) ? c : mine; }
        if (sum == G) break;
        __builtin_amdgcn_s_sleep(1);
        if ((++sp & 255u) == 0u) { if (xb_ld(&bar[XB_TMO])) break; if (sp > XB_SPIN_CAP) { atomicAdd(&bar[XB_TMO], 1u); break; } }
    }
    nloc = mine > 0u ? mine : 1u; nx = cnt > 0u ? cnt : 1u;
}
__device__ __forceinline__ void xcd_barrier(const XcdBarrier& b) {
    asm volatile("s_waitcnt vmcnt(0)" ::: "memory");
    __syncthreads();
    if (threadIdx.x == 0) {
        unsigned* bar = b.bar;
        __builtin_amdgcn_s_waitcnt(0);
        unsigned nloc = b.st[0], nx = b.st[1];
        if (nloc == 0u) { xcd_barrier_complete(bar, b.x, nloc, nx); b.st[0] = nloc; b.st[1] = nx; }
        const unsigned old = xb_add(&bar[XB_XSUB(b.x)], 1u);
        const unsigned gen = old / nloc;
        if (old + 1u == (gen + 1u) * nloc) {
            __builtin_amdgcn_fence(__ATOMIC_RELEASE, "agent");
            asm volatile("s_waitcnt vmcnt(0)" ::: "memory");
            const unsigned og = xb_add(&bar[XB_TOP], 1u);
            const unsigned tg = og / nx;
            if (og + 1u == (tg + 1u) * nx) xb_add(&bar[XB_TOPGEN], 1u);
            else XB_SPIN(xb_ld(&bar[XB_TOPGEN]) == tg, bar);
            __builtin_amdgcn_fence(__ATOMIC_ACQUIRE, "agent");
            xb_add(&bar[XB_XGEN(b.x)], 1u);
            asm volatile("s_waitcnt vmcnt(0)" ::: "memory");
        } else {
            XB_SPIN(xb_ld(&bar[XB_XGEN(b.x)]) == gen, bar);
            __builtin_amdgcn_fence(__ATOMIC_ACQUIRE, "agent");
            asm volatile("s_waitcnt vmcnt(0)" ::: "memory");
        }
    }
    __syncthreads();
}

constexpr int DM = 4096;
constexpr int NPR = 8192, NSR = 1024, NROW = NPR + NSR;
constexpr int SEQ = 4096, NSEQ_S = 128, TS = 8;
constexpr int N1 = 19200, NT1 = 75;
constexpr int PROJ = 18960;
constexpr int NMOD = 130;
constexpr float EPS = 1e-6f;

constexpr size_t MiB = 1u << 20;
constexpr size_t WS_CTL = 0, CTL_ZERO_BYTES = 1 * MiB;
constexpr size_t WS_WB1 = 1 * MiB;
constexpr size_t WS_WB2 = WS_WB1 + (size_t)N1 * DM * 2;
constexpr size_t WS_WB3 = WS_WB2 + (size_t)DM * DM * 2;
constexpr size_t WS_CS  = WS_WB3 + (size_t)DM * DM * 2;
constexpr size_t WS_MOD = WS_CS + (size_t)160 * DM * 2;
constexpr size_t WS_H   = WS_MOD + (size_t)132 * 12288 * 4;
constexpr size_t WS_QA  = WS_H + (size_t)NROW * DM * 2;
constexpr size_t WS_KA  = WS_QA + (size_t)NROW * 2048 * 2;
constexpr size_t WS_VA  = WS_KA + (size_t)NROW * 256 * 2;
constexpr size_t WS_ZA  = WS_VA + (size_t)NROW * 256 * 2;
constexpr size_t WS_QB  = WS_ZA + (size_t)NROW * 2048 * 2;
constexpr size_t WS_KB  = WS_QB + (size_t)NROW * 1024 * 2;
constexpr size_t WS_VB  = WS_KB + (size_t)NROW * 1024 * 2;
constexpr size_t WS_ZB  = WS_VB + (size_t)NROW * 2048 * 2;
constexpr size_t WS_SGA = WS_ZB + (size_t)NROW * 2048 * 2;
constexpr size_t WS_SGB = WS_SGA + (size_t)NROW * DM * 2;
constexpr size_t WS_R   = WS_SGB + (size_t)NROW * DM * 2;
constexpr size_t WS_QT  = WS_R + (size_t)NROW * 16 * 4;
constexpr size_t WS_KDT = WS_QT + (size_t)512 * 64 * 256 * 2;
constexpr size_t WS_ATT = WS_KDT + (size_t)512 * 64 * 256 * 2;
constexpr size_t WS_VT  = WS_ATT + (size_t)512 * 64 * 64 * 2;
constexpr size_t WS_DEC = WS_VT + (size_t)512 * 512 * 64 * 2;
constexpr size_t WS_OB  = WS_DEC + (size_t)512 * 256 * 4;
constexpr size_t WS_AB  = WS_OB + (size_t)NPR * 2048 * 4;
constexpr size_t WS_SSQ = WS_AB + (size_t)NROW * DM * 2;
constexpr size_t WS_END = WS_SSQ + (size_t)NROW * 64 * 4;
constexpr size_t WS_MERGED = WS_H;
constexpr size_t WS_XN = WS_AB;
constexpr int CW_BAR = 4096;

constexpr size_t OUT_Y = 0;
constexpr size_t OUT_KWP = (size_t)NROW * DM;
constexpr size_t OUT_VWP = OUT_KWP + 65536;
constexpr size_t OUT_GSP = OUT_VWP + 65536;
constexpr size_t OUT_KWS = OUT_GSP + 1048576;
constexpr size_t OUT_VWS = OUT_KWS + 4194304;
constexpr size_t OUT_GSS = OUT_VWS + 4194304;
constexpr size_t OUT_TOTAL = OUT_GSS + 67108864;

constexpr int RING_BYTES = 131072;
constexpr int LDS_BYTES = 155648;
constexpr int MISC_OFF = LDS_BYTES - 256;
constexpr int SMP_P4 = 0;
constexpr int CW_SMP = 64;
constexpr int NWAVES = 8;

namespace pg8 {
constexpr int BM = 256, BK = 64, HALF = 128, HTB = HALF * BK * 2, STAGE_BYTES = 8 * HTB, NXCD = 8, WGM = 8;
__host__ __device__ __forceinline__ int lds_byte(int r, int c) { const int st = (r >> 4) * 2 + (c >> 5), rr = r & 15, cc = c & 31, ob = rr * 64 + cc * 2; return st * 1024 + (ob ^ (((ob >> 9) & 1) << 5)); }
__host__ __device__ __forceinline__ void stage_rc(int b, int& R, int& C) { const int st = b / 1024, sb = b % 1024, swz = sb ^ (((sb >> 9) & 1) << 5); R = (st >> 1) * 16 + swz / 64; C = (st & 1) * 32 + (swz % 64) / 2; }
__host__ __device__ __forceinline__ int perm32(int rho) { const int n = rho >> 4, i = rho & 15; return 8 * (i >> 2) + 4 * n + (i & 3); }

struct Unit { int pm, pn; };
struct Gemm { const bf16* A; const bf16* Bt; int M, N, K; };

struct StaticOrder {
    int nM, nN, nwg, G, c;
    __host__ __device__ void init(int M, int N, int G_, int c_, int bm_rows = BM) { nM = M / bm_rows; nN = N / BM; nwg = nM * nN; G = G_; c = c_; }
    __host__ __device__ bool next(int i, Unit& u) const {
        const long L = (long)i * G + c; if (L >= nwg) return false;
        int wgid = (int)L; { const int q = nwg / NXCD, r = nwg % NXCD, xcd = wgid % NXCD, off = wgid / NXCD; wgid = (xcd < r ? xcd * (q + 1) : r * (q + 1) + (xcd - r) * q) + off; }
        const int nig = WGM * nN, gid = wgid / nig, fm = gid * WGM, gsz = (nM - fm) < WGM ? (nM - fm) : WGM;
        u.pm = fm + ((wgid % nig) % gsz); u.pn = (wgid % nig) / gsz; return true;
    }
};

struct GroupedOrder {
    int nM, nNg, ncg, per, G, c;
    __host__ __device__ void init(int M, int N, int G_, int c_, int ncg_) { nM = M / BM; ncg = ncg_; nNg = (N / BM) / ncg_; per = nM * nNg; G = G_; c = c_; }
    __host__ __device__ bool next(int i, Unit& u) const {
        const long L = (long)i * G + c; if (L >= (long)per * ncg) return false;
        const int grp = (int)(L / per); int wgid = (int)(L % per);
        { const int q = per / NXCD, r = per % NXCD, xcd = wgid % NXCD, off = wgid / NXCD; wgid = (xcd < r ? xcd * (q + 1) : r * (q + 1) + (xcd - r) * q) + off; }
        const int nig = WGM * nNg, gid = wgid / nig, fm = gid * WGM, gsz = (nM - fm) < WGM ? (nM - fm) : WGM;
        u.pm = fm + ((wgid % nig) % gsz); u.pn = grp * nNg + (wgid % nig) / gsz; return true;
    }
};

template <class Epi, class Sched = StaticOrder>
__device__ __forceinline__ void gemm_phase(LAS unsigned char* lds, const Gemm g, const Sched& S, const Epi& E) {
    const int tid = threadIdx.x, wid = __builtin_amdgcn_readfirstlane(tid >> 6), lane = tid & 63, wr = wid >> 2, wc = wid & 3, fr = lane & 15, fq = lane >> 4;
    constexpr int MT = Epi::MT;
    const int K = g.K, nt = K / BK;
    unsigned voffA[2], voffB[2];
#pragma unroll
    for (int i = 0; i < 2; ++i) { int R, C; stage_rc(tid * 16 + i * 8192, R, C); const int Rb = Epi::PERM ? ((R & ~31) + perm32(R & 31)) : R;
        const int Ra = (MT == 3 && R >= 96) ? R - 32 : R;
        voffA[i] = (unsigned)(Ra * K + C) * 2u; voffB[i] = (unsigned)(Rb * K + C) * 2u; }
    const size_t kstep = (size_t)(BK * 2);
    const size_t hstep = (size_t)HALF * K * 2;
    const size_t tstep = 2 * hstep;
    const size_t hstepA = (size_t)(32 * MT) * K * 2;
    const size_t tstepA = 2 * hstepA;
    const unsigned ldsw = (unsigned)wid * 1024u;
    const int aoff = lds_byte(wr * 16 * MT + fr, fq * 8), boff = lds_byte(wc * 32 + fr, fq * 8);
#define PG8_SA(b, h) (((b) * 2 + (h)) * HTB)
#define PG8_SB(b, h) ((4 + (b) * 2 + (h)) * HTB)
#define PG8_STAGE(bufoff, gbase, voff) do { _Pragma("unroll") for (int _i = 0; _i < 2; ++_i) \
        __builtin_amdgcn_global_load_lds((const unsigned*)((const char*)(gbase) + (voff)[_i]), (LAS unsigned*)(lds + (bufoff) + ldsw + _i * 8192), 16, 0, 0); } while (0)
#define PG8_STAGEB(bufoff, gbase, voff) do { _Pragma("unroll") for (int _i = 0; _i < 2; ++_i) \
        __builtin_amdgcn_global_load_lds((const unsigned*)((const char*)(gbase) + (voff)[_i]), (LAS unsigned*)(lds + (bufoff) + ldsw + _i * 8192), 16, 0, Epi::AUXB); } while (0)
#define PG8_LDA(dst, b, h) do { _Pragma("unroll") for (int m = 0; m < MT; ++m) _Pragma("unroll") for (int k = 0; k < 2; ++k) dst[m][k] = *(const LAS bf16x8*)(lds + PG8_SA(b, h) + aoff + m * 2048 + k * 1024); } while (0)
#define PG8_LDB(dst, b, h) do { _Pragma("unroll") for (int n = 0; n < 2; ++n) _Pragma("unroll") for (int k = 0; k < 2; ++k) dst[n][k] = *(const LAS bf16x8*)(lds + PG8_SB(b, h) + boff + n * 2048 + k * 1024); } while (0)
#define PG8_MMA(ai, bj, At, Bt) do { __builtin_amdgcn_s_setprio(1); _Pragma("unroll") for (int m = 0; m < MT; ++m) _Pragma("unroll") for (int n = 0; n < 2; ++n) _Pragma("unroll") for (int k = 0; k < 2; ++k) \
        acc[ai][bj][m][n] = __builtin_amdgcn_mfma_f32_16x16x32_bf16(Bt[n][k], At[m][k], acc[ai][bj][m][n], 0, 0, 0); __builtin_amdgcn_s_setprio(0); } while (0)
#define PG8_WAIT_V(n) asm volatile("s_waitcnt vmcnt(" #n ")" ::: "memory")
#define PG8_WAIT_L(n) asm volatile("s_waitcnt lgkmcnt(" #n ")" ::: "memory")
#define PG8_BAR __builtin_amdgcn_s_barrier()
#define PG8_SCHED __builtin_amdgcn_sched_barrier(0)
    Unit cur, nxt; int ui = 0;
    if (!S.next(0, cur)) return;
    f32x4 acc[2][2][MT][2];
#pragma unroll
    for (int a = 0; a < 2; ++a)
#pragma unroll
        for (int b = 0; b < 2; ++b)
#pragma unroll
            for (int m = 0; m < MT; ++m)
#pragma unroll
                for (int n = 0; n < 2; ++n) acc[a][b][m][n] = (f32x4){0.f, 0.f, 0.f, 0.f};
    bf16x8 At[MT][2], B0[2][2], B1[2][2];
    const char* cA = (const char*)g.A + (size_t)cur.pm * tstepA; const char* cB = (const char*)g.Bt + (size_t)cur.pn * tstep;
    PG8_STAGEB(PG8_SB(0, 0), cB, voffB); PG8_STAGEB(PG8_SB(0, 1), cB + hstep, voffB); PG8_STAGE(PG8_SA(0, 0), cA, voffA); PG8_STAGE(PG8_SA(0, 1), cA + hstepA, voffA);
    if (wr == 1) PG8_BAR;
    PG8_WAIT_V(2); PG8_BAR;
    PG8_STAGEB(PG8_SB(1, 0), cB + kstep, voffB); PG8_STAGE(PG8_SA(1, 0), cA + kstep, voffA); PG8_STAGEB(PG8_SB(1, 1), cB + hstep + kstep, voffB);
    PG8_WAIT_V(6); PG8_BAR;
    for (;;) {
        const bool has_next = S.next(ui + 1, nxt);
        const char* nA = has_next ? (const char*)g.A + (size_t)nxt.pm * tstepA : cA; const char* nB = has_next ? (const char*)g.Bt + (size_t)nxt.pn * tstep : cB;
        for (int t = 0; t < nt; t += 2) {
            const bool last = (t == nt - 2);
            const char* a1 = cA + (size_t)(t + 1) * kstep;
            const char* a2 = last ? nA : cA + (size_t)(t + 2) * kstep; const char* b2 = last ? nB : cB + (size_t)(t + 2) * kstep;
            const char* a3 = a2 + kstep; const char* b3 = b2 + kstep;
            if constexpr (Epi::HAS_MID) { if (t == nt / 2) E.mid(acc, cur, wr, wc, fr, fq); }
            PG8_LDB(B0, 0, 0); PG8_LDB(B1, 0, 1); PG8_SCHED; PG8_LDA(At, 0, 0); PG8_STAGE(PG8_SA(1, 1), a1 + hstepA, voffA);
            PG8_WAIT_V(8); PG8_WAIT_L(0); PG8_BAR; PG8_MMA(0, 0, At, B0); PG8_MMA(0, 1, At, B1); PG8_BAR; PG8_SCHED;
            PG8_LDA(At, 0, 1); PG8_STAGEB(PG8_SB(0, 0), b2, voffB); PG8_STAGEB(PG8_SB(0, 1), b2 + hstep, voffB); PG8_STAGE(PG8_SA(0, 0), a2, voffA);
            PG8_WAIT_V(8); PG8_WAIT_L(0); PG8_BAR; PG8_MMA(1, 0, At, B0); PG8_MMA(1, 1, At, B1); PG8_BAR; PG8_SCHED;
            PG8_LDB(B0, 1, 0); PG8_LDB(B1, 1, 1); PG8_SCHED; PG8_LDA(At, 1, 0); PG8_STAGE(PG8_SA(0, 1), a2 + hstepA, voffA);
            PG8_WAIT_V(8); PG8_WAIT_L(0); PG8_BAR; PG8_MMA(0, 0, At, B0); PG8_MMA(0, 1, At, B1); PG8_BAR; PG8_SCHED;
            PG8_LDA(At, 1, 1); PG8_STAGEB(PG8_SB(1, 0), b3, voffB); PG8_STAGEB(PG8_SB(1, 1), b3 + hstep, voffB); PG8_STAGE(PG8_SA(1, 0), a3, voffA);
            PG8_WAIT_V(8); PG8_WAIT_L(0); PG8_BAR; PG8_MMA(1, 0, At, B0); PG8_MMA(1, 1, At, B1); PG8_BAR; PG8_SCHED;
        }
        if (wr == 0) PG8_BAR;
        E(acc, cur, wr, wc, fr, fq);
        if (!has_next) break;
#pragma unroll
        for (int a = 0; a < 2; ++a)
#pragma unroll
            for (int b = 0; b < 2; ++b)
#pragma unroll
                for (int m = 0; m < MT; ++m)
#pragma unroll
                    for (int n = 0; n < 2; ++n) acc[a][b][m][n] = (f32x4){0.f, 0.f, 0.f, 0.f};
        cur = nxt; cA = nA; cB = nB; ++ui;
        if (wr == 1) PG8_BAR;
    }
    PG8_WAIT_V(0);
    PG8_BAR;
#undef PG8_SA
#undef PG8_SB
#undef PG8_STAGE
#undef PG8_STAGEB
#undef PG8_LDA
#undef PG8_LDB
#undef PG8_MMA
#undef PG8_WAIT_V
#undef PG8_WAIT_L
#undef PG8_BAR
#undef PG8_SCHED
}
}

struct EpiProj {
    static constexpr bool PERM = true, HAS_MID = false; static constexpr int MT = 4, AUXB = 0;
    unsigned char* ws;
    __device__ __forceinline__ void operator()(const f32x4 (&acc)[2][2][4][2], const pg8::Unit& u, int wr, int wc, int fr, int fq) const {
        const int pn = u.pn;
        const int row0 = u.pm * 256 + wr * 64 + fr;
        if (pn == 74) {
            if (wc == 0 && fq < 2) {
                float* R = (float*)(ws + WS_R);
#pragma unroll
                for (int ai = 0; ai < 2; ++ai)
#pragma unroll
                    for (int m = 0; m < 4; ++m) { float* rp = R + (size_t)(row0 + ai * 128 + m * 16) * 16 + 8 * fq;
                        *(f32x4*)(rp) = acc[ai][0][m][0]; *(f32x4*)(rp + 4) = acc[ai][0][m][1]; }
            }
            return;
        }
        if (pn >= 42) {
            bf16* RT = (bf16*)(ws + WS_SGA); bf16* SB = (bf16*)(ws + WS_SGB);
            const int col0 = (pn - 42) * 128 + wc * 32 + 8 * fq;
#pragma unroll
            for (int ai = 0; ai < 2; ++ai)
#pragma unroll
                for (int m = 0; m < 4; ++m) { const size_t off = (size_t)(row0 + ai * 128 + m * 16) * DM + col0;
                    float rt[8], sb[8];
#pragma unroll
                    for (int n = 0; n < 2; ++n)
#pragma unroll
                        for (int j = 0; j < 4; ++j) { const float ea = __builtin_amdgcn_exp2f(-1.44269504089f * acc[ai][0][m][n][j]), eb = __builtin_amdgcn_exp2f(-1.44269504089f * acc[ai][1][m][n][j]);
                            sb[4 * n + j] = __builtin_amdgcn_rcpf(1.0f + eb); rt[4 * n + j] = (1.0f + eb) * __builtin_amdgcn_rcpf(1.0f + ea); }
                    v4u w; w.x = pk2(rt[0], rt[1]); w.y = pk2(rt[2], rt[3]); w.z = pk2(rt[4], rt[5]); w.w = pk2(rt[6], rt[7]);
                    __builtin_nontemporal_store(w, (v4u*)(RT + off));
                    w.x = pk2(sb[0], sb[1]); w.y = pk2(sb[2], sb[3]); w.z = pk2(sb[4], sb[5]); w.w = pk2(sb[6], sb[7]);
                    __builtin_nontemporal_store(w, (v4u*)(SB + off)); }
            return;
        }
        size_t boff; int ldc, ct, act;
        if (pn < 8)       { boff = WS_QA;  ldc = 2048; ct = pn;      act = 0; }
        else if (pn == 8) { boff = WS_KA;  ldc = 256;  ct = 0;       act = 0; }
        else if (pn == 9) { boff = WS_VA;  ldc = 256;  ct = 0;       act = 0; }
        else if (pn < 18) { boff = WS_ZA;  ldc = 2048; ct = pn - 10; act = 1; }
        else if (pn < 22) { boff = WS_QB;  ldc = 1024; ct = pn - 18; act = 0; }
        else if (pn < 26) { boff = WS_KB;  ldc = 1024; ct = pn - 22; act = 0; }
        else if (pn < 34) { boff = WS_VB;  ldc = 2048; ct = pn - 26; act = 0; }
        else              { boff = WS_ZB;  ldc = 2048; ct = pn - 34; act = 1; }
        bf16* base = (bf16*)(ws + boff);
        const int col0 = ct * 256 + wc * 32 + 8 * fq;
#pragma unroll
        for (int ai = 0; ai < 2; ++ai)
#pragma unroll
            for (int m = 0; m < 4; ++m) { bf16* rowp = base + (size_t)(row0 + ai * 128 + m * 16) * ldc + col0;
#pragma unroll
                for (int bj = 0; bj < 2; ++bj) { f32x4 v0 = acc[ai][bj][m][0], v1 = acc[ai][bj][m][1];
                    if (act != 0) {
#pragma unroll
                        for (int j = 0; j < 4; ++j) { v0[j] *= sigmoidf_(v0[j]); v1[j] *= sigmoidf_(v1[j]); }
                    }
                    v4u w; w.x = pk2(v0[0], v0[1]); w.y = pk2(v0[2], v0[3]); w.z = pk2(v1[0], v1[1]); w.w = pk2(v1[2], v1[3]);
                    __builtin_nontemporal_store(w, (v4u*)(rowp + bj * 128)); } }
    }
};
struct EpiMerge {
    static constexpr bool PERM = true, HAS_MID = true; static constexpr int MT = 3, AUXB = 0;
    const bf16* sga; const bf16* sgb; bf16* out;
    __device__ __forceinline__ void mid(f32x4 (&acc)[2][2][MT][2], const pg8::Unit& u, int wr, int wc, int fr, int fq) const {
        int row0 = u.pm * (64 * MT) + wr * (16 * MT) + fr, col0 = u.pn * 256 + wc * 32 + 8 * fq;
        asm volatile("" : "+v"(row0), "+v"(col0));
#pragma unroll
        for (int ai = 0; ai < 2; ++ai)
#pragma unroll
            for (int m = 0; m < MT; ++m) { const size_t off = (size_t)(row0 + ai * (32 * MT) + m * 16) * DM + col0;
#pragma unroll
                for (int bj = 0; bj < 2; ++bj) { const v4u a = *(const v4u*)(sga + off + bj * 128);
                    const f32x4 r0 = {bflo(a.x), bfhi(a.x), bflo(a.y), bfhi(a.y)}, r1 = {bflo(a.z), bfhi(a.z), bflo(a.w), bfhi(a.w)};
                    acc[ai][bj][m][0] *= r0; acc[ai][bj][m][1] *= r1;
                    asm volatile("" ::: "memory"); } }
    }
    __device__ __forceinline__ void operator()(const f32x4 (&acc)[2][2][MT][2], const pg8::Unit& u, int wr, int wc, int fr, int fq) const {
        const int row0 = u.pm * (64 * MT) + wr * (16 * MT) + fr, col0 = u.pn * 256 + wc * 32 + 8 * fq;
#pragma unroll
        for (int ai = 0; ai < 2; ++ai)
#pragma unroll
            for (int m = 0; m < MT; ++m) { const size_t off = (size_t)(row0 + ai * (32 * MT) + m * 16) * DM + col0;
#pragma unroll
                for (int bj = 0; bj < 2; ++bj) { const v4u b = *(const v4u*)(sgb + off + bj * 128);
                    const f32x4 v0 = acc[ai][bj][m][0], v1 = acc[ai][bj][m][1];
                    v4u w; w.x = pk2(v0[0] * bflo(b.x), v0[1] * bfhi(b.x)); w.y = pk2(v0[2] * bflo(b.y), v0[3] * bfhi(b.y));
                    w.z = pk2(v1[0] * bflo(b.z), v1[1] * bfhi(b.z)); w.w = pk2(v1[2] * bflo(b.w), v1[3] * bfhi(b.w));
                    *(v4u*)(out + off + bj * 128) = w; } }
    }
};
struct EpiOut {
    static constexpr bool PERM = false, HAS_MID = false; static constexpr int MT = 3, AUXB = 0;
    const float* xp; const float* xs; const float* mod; bf16* y; float* ssq;
    __device__ __forceinline__ void operator()(const f32x4 (&acc)[2][2][MT][2], const pg8::Unit& u, int wr, int wc, int fr, int fq) const {
        const int col0 = u.pn * 256 + wc * 32 + 4 * fq;
#pragma unroll
        for (int ai = 0; ai < 2; ++ai)
#pragma unroll
            for (int m = 0; m < MT; ++m) { const int row = u.pm * (64 * MT) + ai * (32 * MT) + wr * (16 * MT) + m * 16 + fr;
                const float* xr = (row < NPR) ? xp + (size_t)row * DM : xs + (size_t)(row - NPR) * DM;
                const int seq = (row < NPR) ? (row >> 12) : 2 + ((row - NPR) >> 3);
                const float* gp = mod + (size_t)seq * 12288 + 8192;
                float s = 0.f;
#pragma unroll
                for (int bj = 0; bj < 2; ++bj)
#pragma unroll
                    for (int n = 0; n < 2; ++n) { const int c = col0 + bj * 128 + n * 16;
                        const f32x4 xv = *(const f32x4*)(xr + c), gv = *(const f32x4*)(gp + c);
                        const f32x4 o = xv + gv * acc[ai][bj][m][n];
                        v2u w; w.x = pk2(o[0], o[1]); w.y = pk2(o[2], o[3]);
                        *(v2u*)(y + (size_t)row * DM + c) = w;
                        s += (o[0] * o[0] + o[1] * o[1]) + (o[2] * o[2] + o[3] * o[3]); }
                s += __shfl_xor(s, 16); s += __shfl_xor(s, 32);
                if (fq == 0) ssq[(size_t)row * 64 + u.pn * 4 + wc] = s;
            }
    }
};

struct Args { const float* in[19]; float* out; unsigned char* ws; int ph_lo, ph_hi, ph_rep, pad_; };
#define FIN(k) (A.in[k])
struct Frame {
    LAS unsigned char* lds;
    int tid, lane, wave, blk, G;
    float* out; unsigned char* ws;
};

template <bool NTS>
__device__ __forceinline__ void p0_transpose_item(const float* W, int ldw, int k0, int n_src0, bf16* WT, int ldt, int drow0, int koff, LAS float* scr, int lane) {
    f32x4 v[16];
    const float* wp = W + (size_t)(k0 + (lane >> 4)) * ldw + n_src0 + (lane & 15) * 4;
#pragma unroll
    for (int i = 0; i < 16; ++i) v[i] = __builtin_nontemporal_load((const f32x4*)(wp + (size_t)(4 * i) * ldw));
#pragma unroll
    for (int i = 0; i < 16; ++i) { LAS float* s = scr + (4 * i + (lane >> 4)) * 65 + (lane & 15) * 4; s[0] = v[i][0]; s[1] = v[i][1]; s[2] = v[i][2]; s[3] = v[i][3]; }
    LDS_WAIT(); asm volatile("" ::: "memory");
    const int c = lane & 7;
#pragma unroll
    for (int j = 0; j < 8; ++j) { const int n = (lane >> 3) + 8 * j; const LAS float* s = scr + (8 * c) * 65 + n;
        v4u o; o.x = pk2(s[0 * 65], s[1 * 65]); o.y = pk2(s[2 * 65], s[3 * 65]); o.z = pk2(s[4 * 65], s[5 * 65]); o.w = pk2(s[6 * 65], s[7 * 65]);
        if (NTS) __builtin_nontemporal_store(o, (v4u*)(WT + (size_t)(drow0 + n) * ldt + koff + k0 + 8 * c)); else *(v4u*)(WT + (size_t)(drow0 + n) * ldt + koff + k0 + 8 * c) = o; }
    LDS_WAIT(); asm volatile("" ::: "memory");
}
__device__ __forceinline__ void phase0(Frame& F, const Args& A) {
    const size_t gt = (size_t)F.blk * 512 + F.tid, NT = (size_t)F.G * 512;
    bf16* CS = (bf16*)(F.ws + WS_CS); const float* cp = FIN(5); const float* cs = FIN(6);
    for (size_t i = gt; i < (size_t)160 * DM / 4; i += NT) { const int row = (int)(i >> 10), c4 = (int)(i & 1023) * 4;
        f32x4 v = {0.f, 0.f, 0.f, 0.f};
        if (row < 2) v = *(const f32x4*)(cp + (size_t)row * DM + c4); else if (row < NMOD) v = *(const f32x4*)(cs + (size_t)(row - 2) * DM + c4);
        v2u o; o.x = pk2(v[0] * sigmoidf_(v[0]), v[1] * sigmoidf_(v[1])); o.y = pk2(v[2] * sigmoidf_(v[2]), v[3] * sigmoidf_(v[3]));
        *(v2u*)(CS + (size_t)row * DM + c4) = o; }
    { f32x4* z = (f32x4*)(F.ws + WS_MOD); const f32x4 zero = {0.f, 0.f, 0.f, 0.f}; for (size_t i = gt; i < (size_t)NMOD * 12288 / 4; i += NT) z[i] = zero; }
}
__device__ __forceinline__ void p1_modgemm(Frame& F, const Args& A) {
    const float* w_ada = FIN(7); const float* b_ada = FIN(8);
    const bf16* CS = (const bf16*)(F.ws + WS_CS); float* MOD = (float*)(F.ws + WS_MOD);
    const int kq = F.blk & 3, j = F.lane & 31, hh = F.lane >> 5;
    const int n0 = (F.blk >> 2) * 256 + F.wave * 32;
    f32x16 acc[5];
#pragma unroll
    for (int mt = 0; mt < 5; ++mt)
#pragma unroll
        for (int r = 0; r < 16; ++r) acc[mt][r] = 0.f;
    const float* wp = w_ada + (size_t)(kq * 1024 + 8 * hh) * 12288 + n0 + j;
    const bf16* ap = CS + (size_t)j * DM + kq * 1024 + 8 * hh;
    float bn[32];
#pragma unroll
    for (int e = 0; e < 32; ++e) bn[e] = __builtin_nontemporal_load(wp + (size_t)((e >> 3) * 16 + (e & 7)) * 12288);
#pragma unroll 1
    for (int g4 = 0; g4 < 16; ++g4) {
        float bc[32];
#pragma unroll
        for (int e = 0; e < 32; ++e) bc[e] = bn[e];
        { const int gn = (g4 < 15) ? g4 + 1 : g4; const float* wq = wp + (size_t)(gn * 64) * 12288;
#pragma unroll
          for (int e = 0; e < 32; ++e) bn[e] = __builtin_nontemporal_load(wq + (size_t)((e >> 3) * 16 + (e & 7)) * 12288); }
#pragma unroll
        for (int s4 = 0; s4 < 4; ++s4) { const int ks = g4 * 4 + s4;
            v4u bw; bw.x = pk2(bc[8 * s4], bc[8 * s4 + 1]); bw.y = pk2(bc[8 * s4 + 2], bc[8 * s4 + 3]); bw.z = pk2(bc[8 * s4 + 4], bc[8 * s4 + 5]); bw.w = pk2(bc[8 * s4 + 6], bc[8 * s4 + 7]);
            const bf16x8 bf = __builtin_bit_cast(bf16x8, bw);
#pragma unroll
            for (int mt = 0; mt < 5; ++mt) { const bf16x8 af = *(const bf16x8*)(ap + (size_t)mt * 32 * DM + ks * 16);
                acc[mt] = __builtin_amdgcn_mfma_f32_32x32x16_bf16(af, bf, acc[mt], 0, 0, 0); }
            asm volatile("" ::: "memory"); }
    }
    { const float bias = (kq == 0) ? b_ada[n0 + j] : 0.f;
#pragma unroll
      for (int mt = 0; mt < 5; ++mt)
#pragma unroll
          for (int r = 0; r < 16; ++r) { const int row = 32 * mt + (r & 3) + 8 * (r >> 2) + 4 * hh;
              if (row < NMOD) atomicAdd(MOD + (size_t)row * 12288 + n0 + j, acc[mt][r] + bias); } }
}
constexpr int CW_TRN = 1024, CW_TRN2 = 1088;
template <int WHICH>
__device__ __forceinline__ void transpose_queue(Frame& F, const Args& A, unsigned* ctr) {
    LAS float* scr = (LAS float*)(F.lds + F.wave * 16896);
    const float* w_in = FIN(10); const float* w_pa = FIN(15); const float* w_pb = FIN(16); const float* w_out = FIN(17);
    bf16* WB1 = (bf16*)(F.ws + WS_WB1); bf16* WB2 = (bf16*)(F.ws + WS_WB2); bf16* WB3 = (bf16*)(F.ws + WS_WB3);
    constexpr int I1 = 64 * 168, I2 = 64 * 128, IA = 32 * 64, IB = 32 * 64, IO = 64 * 64;
    constexpr int NITEMS = WHICH == 0 ? (I1 + I2) : (IA + IB + IO);
    volatile LAS unsigned* MISC = (volatile LAS unsigned*)(F.lds + MISC_OFF);
    for (;;) {
        __syncthreads();
        if (F.tid == 0) MISC[17] = __hip_atomic_fetch_add(ctr, 32u, __ATOMIC_RELAXED, __HIP_MEMORY_SCOPE_AGENT);
        __syncthreads();
        const int base = __builtin_amdgcn_readfirstlane((int)MISC[17]);
        if (base >= NITEMS) break;
#pragma unroll 1
        for (int i4 = 0; i4 < 4; ++i4) { const int it = base + i4 * 8 + F.wave; if (it >= NITEMS) break;
            int r = it;
            if (WHICH == 0) {
                if (r < I1) { const int kb = r / 168, nb = r % 168; p0_transpose_item<false>(w_in, PROJ, 64 * kb, 64 * nb, WB1, DM, 64 * nb, 0, scr, F.lane); continue; } r -= I1;
                { const int kb = r / 128, nb = r % 128, gsel = nb >> 6, nb2 = nb & 63;
                  p0_transpose_item<false>(w_in, PROJ, 64 * kb, 10768 + 64 * nb, WB1, DM, 10752 + 256 * (nb2 >> 1) + 128 * gsel + 64 * (nb2 & 1), 0, scr, F.lane); }
            } else {
                if (r < IA) { const int kb = r / 64, nb = r % 64; p0_transpose_item<true>(w_pa, DM, 64 * kb, 64 * nb, WB2, DM, 64 * nb, 0, scr, F.lane); continue; } r -= IA;
                if (r < IB) { const int kb = r / 64, nb = r % 64; p0_transpose_item<true>(w_pb, DM, 64 * kb, 64 * nb, WB2, DM, 64 * nb, 2048, scr, F.lane); continue; } r -= IB;
                { const int kb = r / 64, nb = r % 64; p0_transpose_item<true>(w_out, DM, 64 * kb, 64 * nb, WB3, DM, 64 * nb, 0, scr, F.lane); }
            }
        }
    }
}
__device__ __forceinline__ void phase1(Frame& F, const Args& A, unsigned* ctl) {
    if (F.blk < 192) p1_modgemm(F, A);
    transpose_queue<0>(F, A, ctl + CW_TRN);
    const float* w_in = FIN(10); bf16* WB1 = (bf16*)(F.ws + WS_WB1);
    const size_t gt = (size_t)F.blk * 512 + F.tid, NT = (size_t)F.G * 512;
    for (size_t i = gt; i < (size_t)16 * DM; i += NT) { const int k = (int)(i >> 4), j = (int)(i & 15); WB1[(size_t)(18944 + j) * DM + k] = f2bf(w_in[(size_t)k * PROJ + 10752 + j]); }
    { v4u* z = (v4u*)(WB1 + (size_t)18960 * DM); const v4u zero = {0u, 0u, 0u, 0u}; for (size_t i = gt; i < (size_t)240 * DM * 2 / 16; i += NT) z[i] = zero; }
}

__device__ __forceinline__ const float* xrow_ptr(const float* xp, const float* xs, int row) { return (row < NPR) ? xp + (size_t)row * DM : xs + (size_t)(row - NPR) * DM; }
__device__ __forceinline__ int wave_rows(int nrow, int gw, int ngw, int& extra) {
    const int nfull = nrow / ngw, rem = nrow % ngw;
    const int e0 = (int)(((long)gw * rem) / ngw), e1 = (int)(((long)(gw + 1) * rem) / ngw);
    extra = (e1 > e0) ? nfull * ngw + e0 : -1;
    return nfull + (e1 > e0 ? 1 : 0);
}
__device__ __forceinline__ void phase2(Frame& F, const Args& A) {
    const float* xp = FIN(0); const float* xs = FIN(1); const float* ng = FIN(9);
    const float* MOD = (const float*)(F.ws + WS_MOD); bf16* H = (bf16*)(F.ws + WS_H);
    const int gw = F.blk * NWAVES + F.wave, NGW = F.G * NWAVES, lane = F.lane;
    LAS float* G1s = (LAS float*)F.lds; LAS float* SHs = (LAS float*)(F.lds + 32768);
    __syncthreads();
    for (int i = F.tid; i < 2048; i += 512) { const int sq = i >> 10, c = (i & 1023) * 4;
        const f32x4 g = *(const f32x4*)(ng + c), a = *(const f32x4*)(MOD + (size_t)sq * 12288 + 4096 + c), b = *(const f32x4*)(MOD + (size_t)sq * 12288 + c);
        *(LAS f32x4*)(G1s + sq * 4096 + c) = g * (a + 1.0f); *(LAS f32x4*)(SHs + sq * 4096 + c) = b; }
    __syncthreads();
    int extra; const int nr = wave_rows(NROW, gw, NGW, extra);
    if (nr == 0) return;
    const int nfull = NROW / NGW;
    auto rowof = [&](int i) { const int ic = (i < nr) ? i : nr - 1; return (ic < nfull) ? gw + ic * NGW : extra; };
    auto process = [&](const f32x4 (&v)[16], int row) {
        float s = 0.f;
#pragma unroll
        for (int q = 0; q < 16; ++q) s += (v[q][0] * v[q][0] + v[q][1] * v[q][1]) + (v[q][2] * v[q][2] + v[q][3] * v[q][3]);
        const float rstd = rsqrtf(wave_sum(s) * (1.0f / DM) + EPS);
        if (row < NPR) {
            const int sq = row >> 12;
#pragma unroll
            for (int q = 0; q < 16; ++q) { const int c = 4 * (lane + 64 * q);
                const f32x4 g1 = *(const LAS f32x4*)(G1s + sq * 4096 + c), b = *(const LAS f32x4*)(SHs + sq * 4096 + c);
                const f32x4 h = (v[q] * rstd) * g1 + b;
                v2u o; o.x = pk2(h[0], h[1]); o.y = pk2(h[2], h[3]);
                *(v2u*)(H + (size_t)row * DM + c) = o; }
        } else {
            const int seq = 2 + ((row - NPR) >> 3);
            const float* sh = MOD + (size_t)seq * 12288; const float* sc = sh + 4096;
#pragma unroll
            for (int q = 0; q < 16; ++q) { const int c = 4 * (lane + 64 * q);
                const f32x4 g = *(const f32x4*)(ng + c), a = *(const f32x4*)(sc + c), b = *(const f32x4*)(sh + c);
                const f32x4 h = (v[q] * rstd * g) * (a + 1.0f) + b;
                v2u o; o.x = pk2(h[0], h[1]); o.y = pk2(h[2], h[3]);
                *(v2u*)(H + (size_t)row * DM + c) = o;
                if ((q & 3) == 3) asm volatile("" ::: "memory"); }
        }
    };
#define P2_LOAD(dst, r) do { const float* xr_ = xrow_ptr(xp, xs, (r)) + 4 * lane; _Pragma("unroll") for (int q = 0; q < 16; ++q) dst[q] = __builtin_nontemporal_load((const f32x4*)(xr_ + 256 * q)); } while (0)
    f32x4 va[16], vb[16];
    P2_LOAD(va, rowof(0));
    int i = 0;
#pragma unroll 1
    for (; i + 1 < nr; i += 2) {
        P2_LOAD(vb, rowof(i + 1));
        process(va, rowof(i));
        P2_LOAD(va, rowof(i + 2));
        process(vb, rowof(i + 1));
    }
    if (i < nr) process(va, rowof(i));
#undef P2_LOAD
}

#define MFMA16(a, b, c) __builtin_amdgcn_mfma_f32_16x16x32_bf16((a), (b), (c), 0, 0, 0)

constexpr int SWA_VS = 280;
__device__ __forceinline__ void swa_prompt_unit(Frame& F, const Args& A, int unit) {
    const int b = unit >> 7, i = (unit >> 2) & 31, g = unit & 3;
    const bf16* QA = (const bf16*)(F.ws + WS_QA); const bf16* KA = (const bf16*)(F.ws + WS_KA); const bf16* VA = (const bf16*)(F.ws + WS_VA);
    const bf16* ZA = (const bf16*)(F.ws + WS_ZA); bf16* AB = (bf16*)(F.ws + WS_AB);
    LAS unsigned char* Ks = F.lds;
    LAS bf16* VTs = (LAS bf16*)(F.lds + 36864);
    __syncthreads();
#pragma unroll
    for (int q = 0; q < 4; ++q) { const int p = F.tid + 512 * q, row = p >> 3, c = p & 7; const int tok = (i - 1) * 128 + row;
        v4u kv = {0u, 0u, 0u, 0u}, vv = {0u, 0u, 0u, 0u};
        if (tok >= 0) { const size_t off = (size_t)(b * SEQ + tok) * 256 + g * 64 + c * 8; kv = *(const v4u*)(KA + off); vv = *(const v4u*)(VA + off); }
        *(LAS v4u*)(Ks + row * 144 + c * 16) = kv;
        LAS bf16* vt = VTs + (c * 8) * SWA_VS + row;
        vt[0 * SWA_VS] = (bf16)(vv.x & 0xffff); vt[1 * SWA_VS] = (bf16)(vv.x >> 16); vt[2 * SWA_VS] = (bf16)(vv.y & 0xffff); vt[3 * SWA_VS] = (bf16)(vv.y >> 16);
        vt[4 * SWA_VS] = (bf16)(vv.z & 0xffff); vt[5 * SWA_VS] = (bf16)(vv.z >> 16); vt[6 * SWA_VS] = (bf16)(vv.w & 0xffff); vt[7 * SWA_VS] = (bf16)(vv.w >> 16); }
    if (F.tid < 192) { const int d = F.tid / 3, q = F.tid % 3; *(LAS v4u*)(VTs + d * SWA_VS + 256 + 8 * q) = (v4u){0u, 0u, 0u, 0u}; }
    __syncthreads();
    const int hq = g * 8 + F.wave, c = F.lane & 15, gg = F.lane >> 4;
    const float sink = FIN(11)[hq];
    const size_t qbase = (size_t)b * SEQ + i * 128;
    bf16x8 bq[2], bqn[2];
#pragma unroll
    for (int ks = 0; ks < 2; ++ks) bq[ks] = *(const bf16x8*)(QA + (qbase + c) * 2048 + hq * 64 + ks * 32 + 8 * gg);
#pragma unroll 1
    for (int sub = 0; sub < 8; ++sub) {
        const size_t qrow = qbase + sub * 16 + c;
        { const int sn = (sub < 7) ? sub + 1 : sub;
#pragma unroll
          for (int ks = 0; ks < 2; ++ks) bqn[ks] = *(const bf16x8*)(QA + (qbase + sn * 16 + c) * 2048 + hq * 64 + ks * 32 + 8 * gg); }
        v2u zaw[4];
#pragma unroll
        for (int nt = 0; nt < 4; ++nt) zaw[nt] = *(const v2u*)(ZA + qrow * 2048 + hq * 64 + 16 * nt + 4 * gg);
        f32x4 s[10];
        const LAS unsigned char* kp = Ks + (16 * sub + c) * 144 + 16 * gg;
#pragma unroll
        for (int x = 0; x < 9; ++x) { f32x4 a = {0.f, 0.f, 0.f, 0.f};
#pragma unroll
            for (int ks = 0; ks < 2; ++ks) { const bf16x8 ak = *(const LAS bf16x8*)(kp + x * 16 * 144 + ks * 64); a = MFMA16(ak, bq[ks], a); }
            s[x] = a; if ((x & 3) == 3) asm volatile("" ::: "memory"); }
        s[9] = (f32x4){0.f, 0.f, 0.f, 0.f};
        float m = sink;
#pragma unroll
        for (int x = 0; x < 9; ++x) { const bool tile_ok = (i > 0) || (sub + x >= 8);
#pragma unroll
            for (int r = 0; r < 4; ++r) { bool valid = tile_ok; if (x == 0) valid = valid && (4 * gg + r >= c); if (x == 8) valid = valid && (4 * gg + r <= c);
                const float v = valid ? s[x][r] * 0.125f : -1e30f; s[x][r] = v; m = fmaxf(m, v); } }
        m = fmaxf(m, __shfl_xor(m, 16)); m = fmaxf(m, __shfl_xor(m, 32));
        float sum = 0.f;
#pragma unroll
        for (int x = 0; x < 9; ++x)
#pragma unroll
            for (int r = 0; r < 4; ++r) { const float p = (s[x][r] > -1e29f) ? __expf(s[x][r] - m) : 0.f; s[x][r] = p; sum += p; }
        sum += __shfl_xor(sum, 16); sum += __shfl_xor(sum, 32);
        const float inv = 1.0f / (sum + __expf(sink - m));
        f32x4 o[4];
#pragma unroll
        for (int nt = 0; nt < 4; ++nt) o[nt] = (f32x4){0.f, 0.f, 0.f, 0.f};
        const LAS bf16* vbase = VTs + c * SWA_VS + 16 * sub + 4 * gg;
#pragma unroll
        for (int jp = 0; jp < 5; ++jp) { v4u pw; pw.x = pk2(s[2 * jp][0], s[2 * jp][1]); pw.y = pk2(s[2 * jp][2], s[2 * jp][3]); pw.z = pk2(s[2 * jp + 1][0], s[2 * jp + 1][1]); pw.w = pk2(s[2 * jp + 1][2], s[2 * jp + 1][3]);
            const bf16x8 pb = __builtin_bit_cast(bf16x8, pw);
#pragma unroll
            for (int nt = 0; nt < 4; ++nt) { const LAS bf16* vp = vbase + 16 * nt * SWA_VS + 32 * jp;
                const v2u v0 = *(const LAS v2u*)(vp), v1 = *(const LAS v2u*)(vp + 16);
                v4u vw; vw.x = v0.x; vw.y = v0.y; vw.z = v1.x; vw.w = v1.y;
                o[nt] = MFMA16(__builtin_bit_cast(bf16x8, vw), pb, o[nt]); }
            asm volatile("" ::: "memory"); }
#pragma unroll
        for (int nt = 0; nt < 4; ++nt) { v2u w; w.x = pk2(o[nt][0] * inv * bflo(zaw[nt].x), o[nt][1] * inv * bfhi(zaw[nt].x)); w.y = pk2(o[nt][2] * inv * bflo(zaw[nt].y), o[nt][3] * inv * bfhi(zaw[nt].y));
            *(v2u*)(AB + qrow * DM + hq * 64 + 16 * nt + 4 * gg) = w; }
        bq[0] = bqn[0]; bq[1] = bqn[1];
    }
}

__device__ __forceinline__ void swa_sample_unit(Frame& F, const Args& A, int unit) {
    const int n = unit >> 2, g = unit & 3;
    const bf16* QA = (const bf16*)(F.ws + WS_QA); const bf16* KA = (const bf16*)(F.ws + WS_KA); const bf16* VA = (const bf16*)(F.ws + WS_VA);
    const bf16* ZA = (const bf16*)(F.ws + WS_ZA); bf16* AB = (bf16*)(F.ws + WS_AB);
    const float* ck = FIN(2); const float* cv = FIN(3);
    LAS unsigned char* Ks = F.lds;
    LAS bf16* VTs = (LAS bf16*)(F.lds + 23040);
    const int hq = g * 8 + F.wave, c = F.lane & 15, gg = F.lane >> 4, tq = c & 7;
    const size_t qrow0 = (size_t)NPR + n * 8;
    bf16x8 bq[2]; v2u zaw[4];
#pragma unroll
    for (int ks = 0; ks < 2; ++ks) bq[ks] = *(const bf16x8*)(QA + (qrow0 + tq) * 2048 + hq * 64 + ks * 32 + 8 * gg);
#pragma unroll
    for (int nt = 0; nt < 4; ++nt) zaw[nt] = *(const v2u*)(ZA + (qrow0 + tq) * 2048 + hq * 64 + 16 * nt + 4 * gg);
    __syncthreads();
#pragma unroll
    for (int q = 0; q < 4; ++q) { const int p = F.tid + 512 * q, row = p >> 4, c4 = p & 15;
        const size_t off = ((size_t)(n * 128 + row) * 4 + g) * 64 + c4 * 4;
        const f32x4 kv = *(const f32x4*)(ck + off), vv = *(const f32x4*)(cv + off);
        v2u kw; kw.x = pk2(kv[0], kv[1]); kw.y = pk2(kv[2], kv[3]);
        *(LAS v2u*)(Ks + row * 144 + c4 * 8) = kw;
        LAS bf16* vt = VTs + (c4 * 4) * 168 + row;
        vt[0] = f2bf(vv[0]); vt[168] = f2bf(vv[1]); vt[336] = f2bf(vv[2]); vt[504] = f2bf(vv[3]);
        if (row >= 8) { const size_t oo = ((size_t)(n * 128 + row - 8) * 4 + g) * 64 + c4 * 4; *(f32x4*)(F.out + OUT_KWS + oo) = kv; *(f32x4*)(F.out + OUT_VWS + oo) = vv; } }
    if (F.tid < 256) { const int row = 128 + (F.tid >> 3), c = F.tid & 7;
        v4u kv = {0u, 0u, 0u, 0u}, vv = {0u, 0u, 0u, 0u};
        if (row < 136) { const size_t off = (size_t)(NPR + n * 8 + row - 128) * 256 + g * 64 + c * 8; kv = *(const v4u*)(KA + off); vv = *(const v4u*)(VA + off);
            const size_t oo = ((size_t)(n * 128 + row - 8) * 4 + g) * 64 + c * 8;
            *(f32x4*)(F.out + OUT_KWS + oo) = (f32x4){bflo(kv.x), bfhi(kv.x), bflo(kv.y), bfhi(kv.y)}; *(f32x4*)(F.out + OUT_KWS + oo + 4) = (f32x4){bflo(kv.z), bfhi(kv.z), bflo(kv.w), bfhi(kv.w)};
            *(f32x4*)(F.out + OUT_VWS + oo) = (f32x4){bflo(vv.x), bfhi(vv.x), bflo(vv.y), bfhi(vv.y)}; *(f32x4*)(F.out + OUT_VWS + oo + 4) = (f32x4){bflo(vv.z), bfhi(vv.z), bflo(vv.w), bfhi(vv.w)}; }
        *(LAS v4u*)(Ks + row * 144 + c * 16) = kv;
        LAS bf16* vt = VTs + (c * 8) * 168 + row;
        vt[0 * 168] = (bf16)(vv.x & 0xffff); vt[1 * 168] = (bf16)(vv.x >> 16); vt[2 * 168] = (bf16)(vv.y & 0xffff); vt[3 * 168] = (bf16)(vv.y >> 16);
        vt[4 * 168] = (bf16)(vv.z & 0xffff); vt[5 * 168] = (bf16)(vv.z >> 16); vt[6 * 168] = (bf16)(vv.w & 0xffff); vt[7 * 168] = (bf16)(vv.w >> 16); }
    __syncthreads();
    const float sink = FIN(11)[hq];
    f32x4 s[10];
#pragma unroll
    for (int kt = 0; kt < 10; ++kt) { f32x4 a = {0.f, 0.f, 0.f, 0.f};
#pragma unroll
        for (int ks = 0; ks < 2; ++ks) { const bf16x8 ak = *(const LAS bf16x8*)(Ks + (16 * kt + c) * 144 + (ks * 32 + 8 * gg) * 2); a = MFMA16(ak, bq[ks], a); }
        s[kt] = a; if ((kt & 3) == 3) asm volatile("" ::: "memory"); }
    float m = sink;
#pragma unroll
    for (int kt = 0; kt < 10; ++kt)
#pragma unroll
        for (int r = 0; r < 4; ++r) { const int kk = 16 * kt + 4 * gg + r; const bool valid = (kk >= tq) && (kk <= tq + 128) && (kk < 136);
            const float v = valid ? s[kt][r] * 0.125f : -1e30f; s[kt][r] = v; m = fmaxf(m, v); }
    m = fmaxf(m, __shfl_xor(m, 16)); m = fmaxf(m, __shfl_xor(m, 32));
    float sum = 0.f;
#pragma unroll
    for (int kt = 0; kt < 10; ++kt)
#pragma unroll
        for (int r = 0; r < 4; ++r) { const float p = (s[kt][r] > -1e29f) ? __expf(s[kt][r] - m) : 0.f; s[kt][r] = p; sum += p; }
    sum += __shfl_xor(sum, 16); sum += __shfl_xor(sum, 32);
    const float inv = 1.0f / (sum + __expf(sink - m));
    f32x4 o[4];
#pragma unroll
    for (int nt = 0; nt < 4; ++nt) o[nt] = (f32x4){0.f, 0.f, 0.f, 0.f};
#pragma unroll
    for (int j = 0; j < 5; ++j) { v4u pw; pw.x = pk2(s[2 * j][0], s[2 * j][1]); pw.y = pk2(s[2 * j][2], s[2 * j][3]); pw.z = pk2(s[2 * j + 1][0], s[2 * j + 1][1]); pw.w = pk2(s[2 * j + 1][2], s[2 * j + 1][3]);
        const bf16x8 pa = __builtin_bit_cast(bf16x8, pw);
#pragma unroll
        for (int nt = 0; nt < 4; ++nt) { const LAS bf16* vp = VTs + (16 * nt + c) * 168 + 32 * j + 4 * gg;
            const v2u v0 = *(const LAS v2u*)(vp), v1 = *(const LAS v2u*)(vp + 16);
            v4u vw; vw.x = v0.x; vw.y = v0.y; vw.z = v1.x; vw.w = v1.y;
            o[nt] = MFMA16(__builtin_bit_cast(bf16x8, vw), pa, o[nt]); }
        asm volatile("" ::: "memory"); }
    if (c < 8) {
#pragma unroll
        for (int nt = 0; nt < 4; ++nt) { v2u w; w.x = pk2(o[nt][0] * inv * bflo(zaw[nt].x), o[nt][1] * inv * bfhi(zaw[nt].x)); w.y = pk2(o[nt][2] * inv * bflo(zaw[nt].y), o[nt][3] * inv * bfhi(zaw[nt].y));
            *(v2u*)(AB + (qrow0 + c) * DM + hq * 64 + 16 * nt + 4 * gg) = w; } }
}

__device__ __forceinline__ float log_sigmoid_(float x) { return fminf(x, 0.f) - __logf(1.0f + __expf(-fabsf(x))); }

__device__ __forceinline__ void gla_prep_unit(Frame& F, const Args& A, int unit) {
    const int n = unit >> 8, h = (unit >> 6) & 3, ch = unit & 63;
    const size_t row0 = (size_t)n * SEQ + ch * 64;
    const bf16* QB = (const bf16*)(F.ws + WS_QB); const bf16* KB = (const bf16*)(F.ws + WS_KB); const bf16* VB = (const bf16*)(F.ws + WS_VB);
    const float* R = (const float*)(F.ws + WS_R); const float* w2 = FIN(12); const float* ba = FIN(13);
    bf16* QT = (bf16*)(F.ws + WS_QT) + (size_t)unit * 64 * 256; bf16* KDT = (bf16*)(F.ws + WS_KDT) + (size_t)unit * 256 * 64;
    bf16* ATT = (bf16*)(F.ws + WS_ATT) + (size_t)unit * 64 * 64; bf16* VT = (bf16*)(F.ws + WS_VT) + (size_t)unit * 512 * 64; float* DEC = (float*)(F.ws + WS_DEC) + (size_t)unit * 256;
    LAS float* Rs = (LAS float*)F.lds;
    LAS float* TOT = (LAS float*)(F.lds + 4096);
    LAS unsigned char* Vs = F.lds + 8192;
    LAS bf16* QS = (LAS bf16*)(F.lds + 8192);
    LAS bf16* KS = (LAS bf16*)(F.lds + 8192 + 33792);
    LAS float* BS = (LAS float*)(F.lds + 8192 + 67584);
    int tz = F.tid; asm volatile("" : "+v"(tz));
    v4u vreg[8], qreg[4], kreg[4]; f32x4 rreg = {0.f, 0.f, 0.f, 0.f};
#pragma unroll
    for (int q = 0; q < 8; ++q) { const int p = tz + 512 * q, row = p >> 6, c = p & 63; vreg[q] = *(const v4u*)(VB + (row0 + row) * 2048 + h * 512 + c * 8); }
#pragma unroll
    for (int q = 0; q < 4; ++q) { const int p = tz + 512 * q, row = p >> 5, c = p & 31; const size_t off = (row0 + row) * 1024 + h * 256 + c * 8; qreg[q] = *(const v4u*)(QB + off); kreg[q] = *(const v4u*)(KB + off); }
    if (tz < 256) rreg = *(const f32x4*)(R + row0 * 16 + tz * 4);
    __syncthreads();
    if (tz < 256) *(LAS f32x4*)(Rs + tz * 4) = rreg;
#pragma unroll
    for (int q = 0; q < 8; ++q) { const int p = tz + 512 * q, row = p >> 6, c = p & 63; *(LAS v4u*)(Vs + row * 1040 + c * 16) = vreg[q]; }
    __syncthreads();
    { const LAS bf16* vcol = (const LAS bf16*)Vs + tz;
#pragma unroll
      for (int t8 = 0; t8 < 8; ++t8) { unsigned e[8];
#pragma unroll
          for (int k = 0; k < 8; ++k) e[k] = vcol[(t8 * 8 + k) * 520];
          v4u o; o.x = e[0] | (e[1] << 16); o.y = e[2] | (e[3] << 16); o.z = e[4] | (e[5] << 16); o.w = e[6] | (e[7] << 16);
          *(v4u*)(VT + (size_t)tz * 64 + t8 * 8) = o; } }
    const int dk = tz & 255, half = tz >> 8;
    { float wv[16];
#pragma unroll
      for (int j = 0; j < 16; ++j) wv[j] = w2[j * 1024 + h * 256 + dk];
      const float bias = ba[h * 256 + dk];
      float run = 0.f;
#pragma unroll 4
      for (int tt = 0; tt < 32; ++tt) { const int t = half * 32 + tt; const LAS float* rr = Rs + t * 16; float x = bias;
#pragma unroll
          for (int j4 = 0; j4 < 4; ++j4) { const f32x4 rv = *(const LAS f32x4*)(rr + 4 * j4); x += rv[0] * wv[4 * j4] + rv[1] * wv[4 * j4 + 1] + rv[2] * wv[4 * j4 + 2] + rv[3] * wv[4 * j4 + 3]; }
          run += log_sigmoid_(x) * 0.0625f; BS[t * 256 + dk] = run; }
      TOT[half * 256 + dk] = run; }
    __syncthreads();
#pragma unroll
    for (int q = 0; q < 4; ++q) { const int p = tz + 512 * q, row = p >> 5, c = p & 31; *(LAS v4u*)(QS + row * 264 + c * 8) = qreg[q]; *(LAS v4u*)(KS + row * 264 + c * 8) = kreg[q]; }
    __syncthreads();
    { const float tot0 = TOT[dk], tot1 = TOT[256 + dk];
      const float off = half ? tot0 : 0.f, blast = tot0 + tot1;
#pragma unroll 1
      for (int q8 = 0; q8 < 4; ++q8) { unsigned kd[4];
#pragma unroll
          for (int e = 0; e < 8; ++e) { const int t = half * 32 + q8 * 8 + e;
              const float b = BS[t * 256 + dk] + off;
              const float q = bf2f(QS[t * 264 + dk]), k = bf2f(KS[t * 264 + dk]);
              const bf16 qt = f2bf(q * __expf(b) * 0.0625f), kt = f2bf(k * __expf(-b)); const unsigned kdv = f2bf(k * __expf(blast - b));
              QS[t * 264 + dk] = qt; KS[t * 264 + dk] = kt;
              if (e & 1) kd[e >> 1] |= kdv << 16; else kd[e >> 1] = kdv; }
          v4u o; o.x = kd[0]; o.y = kd[1]; o.z = kd[2]; o.w = kd[3]; *(v4u*)(KDT + (size_t)dk * 64 + half * 32 + 8 * q8) = o; }
      if (half == 0) DEC[dk] = __expf(blast); }
    __syncthreads();
#pragma unroll
    for (int q = 0; q < 4; ++q) { const int p = tz + 512 * q, t = p >> 5, c = p & 31, jb = c >> 2, g4 = c & 3;
        const LAS bf16* sp = QS + t * 264 + 32 * jb + 4 * g4;
        const v2u lo = *(const LAS v2u*)(sp), hi = *(const LAS v2u*)(sp + 16);
        v4u o; o.x = lo.x; o.y = lo.y; o.z = hi.x; o.w = hi.y;
        *(v4u*)(QT + (size_t)t * 256 + c * 8) = o; }
    { const int c = tz & 15, gg = (tz >> 4) & 3;
#pragma unroll
      for (int x = 0; x < 2; ++x) { const int id = F.wave * 2 + x, ti = id >> 2, si = id & 3;
          f32x4 a = {0.f, 0.f, 0.f, 0.f};
          if (si <= ti) {
#pragma unroll
              for (int ks = 0; ks < 8; ++ks) { const bf16x8 ak = *(const LAS bf16x8*)(KS + (16 * si + c) * 264 + ks * 32 + 8 * gg), bqv = *(const LAS bf16x8*)(QS + (16 * ti + c) * 264 + ks * 32 + 8 * gg);
                  a = MFMA16(ak, bqv, a); } }
          const int t = 16 * ti + c, s0 = 16 * si + 4 * gg;
          v2u o; o.x = pk2(s0 <= t ? a[0] : 0.f, s0 + 1 <= t ? a[1] : 0.f); o.y = pk2(s0 + 2 <= t ? a[2] : 0.f, s0 + 3 <= t ? a[3] : 0.f);
          *(v2u*)(ATT + (size_t)t * 64 + s0) = o; } }
}

__device__ __forceinline__ void win_prompt(Frame& F, const Args& A) {
    const bf16* KA = (const bf16*)(F.ws + WS_KA); const bf16* VA = (const bf16*)(F.ws + WS_VA);
    const size_t gt = (size_t)F.blk * 512 + F.tid, NT = (size_t)F.G * 512;
    for (size_t i = gt; i < 65536; i += NT) { const int b = (int)(i >> 15), rem = (int)(i & 32767); const size_t src = (size_t)(b * SEQ + SEQ - 128) * 256 + rem;
        F.out[OUT_KWP + i] = bf2f(KA[src]); F.out[OUT_VWP + i] = bf2f(VA[src]); }
}

constexpr int SEQ_QT = 0, SEQ_KD = 32768, SEQ_AT = 65536, SEQ_DC = 73728, SEQ_BUF = 74752;
constexpr int SEQ_CW = 2;
constexpr int SEQ_DVG = 512 / (16 * SEQ_CW);
#define SEQ_BARRIER() do { asm volatile("s_waitcnt lgkmcnt(0)" ::: "memory"); __builtin_amdgcn_s_barrier(); asm volatile("" ::: "memory"); } while (0)
__device__ __forceinline__ void gla_seq_unit(Frame& F, const Args& A, int unit) {
    const int nh = unit & 7, dvg = unit >> 3, n = nh >> 2, h = nh & 3;
    const bf16* QTg = (const bf16*)(F.ws + WS_QT) + (size_t)nh * 64 * 16384;
    const bf16* KDg = (const bf16*)(F.ws + WS_KDT) + (size_t)nh * 64 * 16384;
    const bf16* ATg = (const bf16*)(F.ws + WS_ATT) + (size_t)nh * 64 * 4096;
    const float* DCg = (const float*)(F.ws + WS_DEC) + (size_t)nh * 64 * 256;
    const bf16* VTg = (const bf16*)(F.ws + WS_VT) + (size_t)nh * 64 * 32768;
    __syncthreads();
    if (F.wave >= 4) {
        const int lt = F.tid - 256;
        v4u rq[2][8], rk[2][8], ra[2][2]; f32x4 rd[2] = {{0.f, 0.f, 0.f, 0.f}, {0.f, 0.f, 0.f, 0.f}};
#define SEQ_LOAD(sx, chx) do { const bf16* q_ = QTg + (size_t)(chx) * 16384; const bf16* k_ = KDg + (size_t)(chx) * 16384; const bf16* a_ = ATg + (size_t)(chx) * 4096; \
        _Pragma("unroll") for (int i = 0; i < 8; ++i) { rq[sx][i] = *(const v4u*)(q_ + (size_t)(lt + 256 * i) * 8); rk[sx][i] = *(const v4u*)(k_ + (size_t)(lt + 256 * i) * 8); } \
        _Pragma("unroll") for (int i = 0; i < 2; ++i) ra[sx][i] = *(const v4u*)(a_ + (size_t)(lt + 256 * i) * 8); \
        if (lt < 64) rd[sx] = *(const f32x4*)(DCg + (size_t)(chx) * 256 + lt * 4); } while (0)
#define SEQ_WRITE(sx, bufx) do { LAS unsigned char* b_ = F.lds + (bufx) * SEQ_BUF; \
        _Pragma("unroll") for (int i = 0; i < 8; ++i) { const int p = lt + 256 * i; \
            { const int row = p >> 5, slot = p & 31; *(LAS v4u*)(b_ + SEQ_QT + row * 512 + ((slot ^ (row & 15)) << 4)) = rq[sx][i]; } \
            { const int row = p >> 3, slot = p & 7;  *(LAS v4u*)(b_ + SEQ_KD + row * 128 + ((slot ^ ((row >> 1) & 7)) << 4)) = rk[sx][i]; } } \
        _Pragma("unroll") for (int i = 0; i < 2; ++i) { const int p = lt + 256 * i, row = p >> 3, slot = p & 7; *(LAS v4u*)(b_ + SEQ_AT + row * 128 + ((slot ^ ((row >> 1) & 7)) << 4)) = ra[sx][i]; } \
        if (lt < 64) *(LAS f32x4*)(b_ + SEQ_DC + lt * 16) = rd[sx]; } while (0)
        SEQ_LOAD(0, 0); SEQ_WRITE(0, 0); SEQ_LOAD(1, 1); SEQ_LOAD(0, 2);
        SEQ_BARRIER();
        for (int ch = 0; ch < 64; ch += 2) {
            SEQ_WRITE(1, 1); if (ch + 3 < 64) SEQ_LOAD(1, ch + 3);
            SEQ_BARRIER();
            if (ch + 2 < 64) { SEQ_WRITE(0, 0); if (ch + 4 < 64) SEQ_LOAD(0, ch + 4); }
            SEQ_BARRIER();
        }
#undef SEQ_LOAD
#undef SEQ_WRITE
    } else if (F.wave >= SEQ_CW) {
        for (int ch = 0; ch < 65; ++ch) SEQ_BARRIER();
    } else {
        const int c = F.lane & 15, gg = F.lane >> 4, sa = (c >> 1) & 7;
        const int dv0 = dvg * (16 * SEQ_CW) + F.wave * 16;
        float* OB = (float*)(F.ws + WS_OB);
        f32x4 S[16];
#pragma unroll
        for (int i = 0; i < 16; ++i) S[i] = (f32x4){0.f, 0.f, 0.f, 0.f};
        const bf16* vtp = VTg + (size_t)(dv0 + c) * 64 + 8 * gg;
        bf16x8 vf[2], vn[2];
#pragma unroll
        for (int j = 0; j < 2; ++j) vf[j] = *(const bf16x8*)(vtp + 32 * j);
        SEQ_BARRIER();
        for (int ch = 0; ch < 64; ++ch) {
            const LAS unsigned char* b_ = F.lds + (ch & 1) * SEQ_BUF;
            { const int cn = (ch + 1 < 64) ? ch + 1 : ch;
#pragma unroll
              for (int j = 0; j < 2; ++j) vn[j] = *(const bf16x8*)(vtp + (size_t)cn * 32768 + 32 * j); }
#define SEQ_LDQ(dst, jx) do { _Pragma("unroll") for (int mt = 0; mt < 4; ++mt) dst[mt] = *(const LAS bf16x8*)(b_ + SEQ_QT + (16 * mt + c) * 512 + (((4 * (jx) + gg) ^ c) << 4)); } while (0)
#define SEQ_LDK(kd_, dd_, gx) do { _Pragma("unroll") for (int e = 0; e < 2; ++e) { dd_[e] = *(const LAS f32x4*)(b_ + SEQ_DC + (16 * (2 * (gx) + e) + 4 * gg) * 4); \
            _Pragma("unroll") for (int j = 0; j < 2; ++j) kd_[e][j] = *(const LAS bf16x8*)(b_ + SEQ_KD + (16 * (2 * (gx) + e) + c) * 128 + (((4 * j + gg) ^ sa) << 4)); } } while (0)
            f32x4 o[4];
            bf16x8 af[4][2], qf[2][4];
#pragma unroll
            for (int mt = 0; mt < 4; ++mt)
#pragma unroll
                for (int j = 0; j < 2; ++j) af[mt][j] = *(const LAS bf16x8*)(b_ + SEQ_AT + (16 * mt + c) * 128 + (((4 * j + gg) ^ sa) << 4));
            SEQ_LDQ(qf[0], 0);
            __builtin_amdgcn_sched_barrier(0);
#pragma unroll
            for (int mt = 0; mt < 4; ++mt) { f32x4 a = {0.f, 0.f, 0.f, 0.f}; a = MFMA16(af[mt][0], vf[0], a); a = MFMA16(af[mt][1], vf[1], a); o[mt] = a; }
            bf16x8 kf[2][2][2]; f32x4 dd[2][2];
#pragma unroll
            for (int j = 0; j < 8; ++j) {
                if (j < 7) SEQ_LDQ(qf[(j + 1) & 1], j + 1); else SEQ_LDK(kf[0], dd[0], 0);
                v4u sw; sw.x = pk2(S[2 * j][0], S[2 * j][1]); sw.y = pk2(S[2 * j][2], S[2 * j][3]); sw.z = pk2(S[2 * j + 1][0], S[2 * j + 1][1]); sw.w = pk2(S[2 * j + 1][2], S[2 * j + 1][3]);
                const bf16x8 sb = __builtin_bit_cast(bf16x8, sw);
                __builtin_amdgcn_sched_barrier(0);
#pragma unroll
                for (int mt = 0; mt < 4; ++mt) o[mt] = MFMA16(qf[j & 1][mt], sb, o[mt]);
                __builtin_amdgcn_sched_barrier(0);
            }
#pragma unroll
            for (int g2 = 0; g2 < 8; ++g2) {
                if (g2 < 7) SEQ_LDK(kf[(g2 + 1) & 1], dd[(g2 + 1) & 1], g2 + 1);
                __builtin_amdgcn_sched_barrier(0);
#pragma unroll
                for (int e = 0; e < 2; ++e) { f32x4 a = S[2 * g2 + e] * dd[g2 & 1][e]; a = MFMA16(kf[g2 & 1][e][0], vf[0], a); a = MFMA16(kf[g2 & 1][e][1], vf[1], a); S[2 * g2 + e] = a; }
                __builtin_amdgcn_sched_barrier(0);
            }
#undef SEQ_LDQ
#undef SEQ_LDK
#pragma unroll
            for (int mt = 0; mt < 4; ++mt)
#pragma unroll
                for (int r = 0; r < 4; ++r) OB[((size_t)n * SEQ + ch * 64 + 16 * mt + 4 * gg + r) * 2048 + h * 512 + dv0 + c] = o[mt][r];
            vf[0] = vn[0]; vf[1] = vn[1];
            SEQ_BARRIER();
        }
        float* gsp = F.out + OUT_GSP + (size_t)nh * 256 * 512;
#pragma unroll
        for (int i = 0; i < 16; ++i)
#pragma unroll
            for (int r = 0; r < 4; ++r) gsp[(size_t)(16 * i + 4 * gg + r) * 512 + dv0 + c] = S[i][r];
    }
}

__device__ __forceinline__ void gla_sample_unit(Frame& F, const Args& A, int unit) {
    const int n = unit >> 2, h = unit & 3;
    const size_t row0 = (size_t)NPR + n * 8;
    const bf16* QB = (const bf16*)(F.ws + WS_QB); const bf16* KB = (const bf16*)(F.ws + WS_KB); const bf16* VB = (const bf16*)(F.ws + WS_VB); const bf16* ZB = (const bf16*)(F.ws + WS_ZB);
    const float* R = (const float*)(F.ws + WS_R); const float* w2 = FIN(12); const float* ba = FIN(13); const float* gg_ = FIN(14);
    bf16* AB = (bf16*)(F.ws + WS_AB);
    LAS float* QTs = (LAS float*)F.lds;
    LAS float* KDs = (LAS float*)(F.lds + 8192);
    LAS float* KTs = (LAS float*)(F.lds + 16384);
    LAS float* DCs = (LAS float*)(F.lds + 24576);
    LAS float* ATs = (LAS float*)(F.lds + 25600);
    LAS float* Rs  = (LAS float*)(F.lds + 25856);
    LAS float* RED = (LAS float*)(F.lds + 26624);
    int tz = F.tid; asm volatile("" : "+v"(tz));
    const int dv4 = (tz & 127) * 4, dkq = tz >> 7;
    const float* s0p = FIN(4) + (size_t)unit * 256 * 512 + (size_t)dkq * 512 + dv4;
    float* s1p = F.out + OUT_GSS + (size_t)unit * 256 * 512 + (size_t)dkq * 512 + dv4;
    const int dkp = tz & 255;
    const f32x4 rreg = *(const GAS f32x4*)((const GAS float*)R + row0 * 16 + (tz & 31) * 4);
    float wv[16];
#pragma unroll
    for (int j = 0; j < 16; ++j) wv[j] = ((const GAS float*)w2)[j * 1024 + h * 256 + dkp];
    const float bias = ((const GAS float*)ba)[h * 256 + dkp];
    bf16 qh[8], kh[8];
#pragma unroll
    for (int t = 0; t < 8; ++t) { qh[t] = ((const GAS bf16*)QB)[(row0 + t) * 1024 + h * 256 + dkp]; kh[t] = ((const GAS bf16*)KB)[(row0 + t) * 1024 + h * 256 + dkp]; }
    f32x4 sb[8];
    const GAS float* lp = (const GAS float*)s0p;
#pragma unroll
    for (int k = 0; k < 8; ++k) { sb[k] = __builtin_nontemporal_load((const GAS f32x4*)lp); lp += 2048; asm volatile("" : "+v"(lp)); }
    v2u vw[8];
    { const GAS bf16* vp = (const GAS bf16*)VB + row0 * 2048 + h * 512 + dv4;
#pragma unroll
      for (int s = 0; s < 8; ++s) vw[s] = *(const GAS v2u*)(vp + s * 2048); }
    SEQ_BARRIER();
    if (F.tid < 32) *(LAS f32x4*)(Rs + F.tid * 4) = rreg;
    SEQ_BARRIER();
    if (F.tid < 256) { const int dk = F.tid;
        float b[8]; float run = 0.f;
#pragma unroll
        for (int t = 0; t < 8; ++t) { const LAS float* rr = Rs + t * 16; float x = bias;
#pragma unroll
            for (int j4 = 0; j4 < 4; ++j4) { const f32x4 rv = *(const LAS f32x4*)(rr + 4 * j4); x += rv[0] * wv[4 * j4] + rv[1] * wv[4 * j4 + 1] + rv[2] * wv[4 * j4 + 2] + rv[3] * wv[4 * j4 + 3]; }
            run += log_sigmoid_(x) * 0.0625f; b[t] = run; asm volatile("" ::: "memory"); }
        const float blast = run;
#pragma unroll
        for (int t = 0; t < 8; ++t) { const float q = bf2f(qh[t]), k = bf2f(kh[t]);
            QTs[dk * 8 + t] = q * __expf(b[t]) * 0.0625f; KTs[dk * 8 + t] = k * __expf(-b[t]); KDs[dk * 8 + t] = k * __expf(blast - b[t]); }
        DCs[dk] = __expf(blast);
    }
    SEQ_BARRIER();
    { const int t = F.wave; float a[8];
#pragma unroll
      for (int s = 0; s < 8; ++s) a[s] = 0.f;
#pragma unroll
      for (int q = 0; q < 4; ++q) { const int dk = F.lane + 64 * q; const float qv = QTs[dk * 8 + t];
#pragma unroll
          for (int s = 0; s < 8; ++s) a[s] += qv * KTs[dk * 8 + s]; }
#pragma unroll
      for (int s = 0; s < 8; ++s) { const float v = wave_sum(a[s]); if (F.lane == 0) ATs[t * 8 + s] = (s <= t) ? v : 0.f; } }
    f32x4 vv[8];
#pragma unroll
    for (int s = 0; s < 8; ++s) { const v2u w = vw[s]; vv[s] = (f32x4){bflo(w.x), bfhi(w.x), bflo(w.y), bfhi(w.y)}; }
    f32x4 oa[8];
#pragma unroll
    for (int t = 0; t < 8; ++t) oa[t] = (f32x4){0.f, 0.f, 0.f, 0.f};
    GAS float* sp = (GAS float*)s1p;
#define SMP_BATCH(PF) do { _Pragma("unroll") for (int k = 0; k < 8; ++k) { const int dk = (bt * 8 + k) * 4 + dkq; \
            const f32x4 s0 = sb[k]; \
            const f32x4 q0 = *(const LAS f32x4*)(QTs + dk * 8), q1 = *(const LAS f32x4*)(QTs + dk * 8 + 4); \
            const f32x4 k0 = *(const LAS f32x4*)(KDs + dk * 8), k1 = *(const LAS f32x4*)(KDs + dk * 8 + 4); \
            const float d = DCs[dk]; \
            oa[0] += s0 * q0[0]; oa[1] += s0 * q0[1]; oa[2] += s0 * q0[2]; oa[3] += s0 * q0[3]; \
            oa[4] += s0 * q1[0]; oa[5] += s0 * q1[1]; oa[6] += s0 * q1[2]; oa[7] += s0 * q1[3]; \
            f32x4 sn = s0 * d; \
            sn += vv[0] * k0[0]; sn += vv[1] * k0[1]; sn += vv[2] * k0[2]; sn += vv[3] * k0[3]; \
            sn += vv[4] * k1[0]; sn += vv[5] * k1[1]; sn += vv[6] * k1[2]; sn += vv[7] * k1[3]; \
            __builtin_nontemporal_store(sn, (GAS f32x4*)sp); sp += 2048; asm volatile("" : "+v"(sp)); \
            if (PF) { sb[k] = __builtin_nontemporal_load((const GAS f32x4*)lp); lp += 2048; asm volatile("" : "+v"(lp)); }     \
            if (k & 1) asm volatile("" ::: "memory"); } } while (0)
    { int bt = 0;
#pragma unroll 1
      for (; bt < 7; ++bt) SMP_BATCH(true);
      SMP_BATCH(false); }
#undef SMP_BATCH
#pragma unroll
    for (int t = 0; t < 8; ++t) *(LAS f32x4*)(RED + ((dkq * 8 + t) * 512 + dv4)) = oa[t];
    SEQ_BARRIER();
    { const int t = F.tid >> 6, d8 = (F.tid & 63) * 8;
      float o[8];
#pragma unroll
      for (int e = 0; e < 8; ++e) o[e] = 0.f;
#pragma unroll
      for (int q = 0; q < 4; ++q) { const f32x4 a = *(const LAS f32x4*)(RED + (q * 8 + t) * 512 + d8), b = *(const LAS f32x4*)(RED + (q * 8 + t) * 512 + d8 + 4);
          o[0] += a[0]; o[1] += a[1]; o[2] += a[2]; o[3] += a[3]; o[4] += b[0]; o[5] += b[1]; o[6] += b[2]; o[7] += b[3]; }
#pragma unroll
      for (int s = 0; s < 8; ++s) { const float at = ATs[t * 8 + s]; const v4u w = *(const v4u*)(VB + (row0 + s) * 2048 + h * 512 + d8);
          o[0] += at * bflo(w.x); o[1] += at * bfhi(w.x); o[2] += at * bflo(w.y); o[3] += at * bfhi(w.y); o[4] += at * bflo(w.z); o[5] += at * bfhi(w.z); o[6] += at * bflo(w.w); o[7] += at * bfhi(w.w); }
      float ss = 0.f;
#pragma unroll
      for (int e = 0; e < 8; ++e) ss += o[e] * o[e];
      ss = wave_sum(ss);
      const float rstd = rsqrtf(ss * (1.0f / 512.0f) + EPS);
      const v4u zw = *(const v4u*)(ZB + (row0 + t) * 2048 + h * 512 + d8);
      const f32x4 g0 = *(const f32x4*)(gg_ + h * 512 + d8), g1 = *(const f32x4*)(gg_ + h * 512 + d8 + 4);
      v4u w; w.x = pk2(o[0] * rstd * g0[0] * bflo(zw.x), o[1] * rstd * g0[1] * bfhi(zw.x)); w.y = pk2(o[2] * rstd * g0[2] * bflo(zw.y), o[3] * rstd * g0[3] * bfhi(zw.y));
      w.z = pk2(o[4] * rstd * g1[0] * bflo(zw.z), o[5] * rstd * g1[1] * bfhi(zw.z)); w.w = pk2(o[6] * rstd * g1[2] * bflo(zw.w), o[7] * rstd * g1[3] * bfhi(zw.w));
      *(v4u*)(AB + (row0 + t) * DM + 2048 + h * 512 + d8) = w; }
}
__device__ __forceinline__ void gla_sample_loop(Frame& F, const Args& A, unsigned* ctr) {
    volatile LAS unsigned* MISC = (volatile LAS unsigned*)(F.lds + MISC_OFF);
    for (;;) {
        __syncthreads();
        if (F.tid == 0) MISC[16] = __hip_atomic_fetch_add(ctr, 1u, __ATOMIC_RELAXED, __HIP_MEMORY_SCOPE_AGENT);
        __syncthreads();
        const int u = __builtin_amdgcn_readfirstlane((int)MISC[16]);
        if (u >= 512) break;
        gla_sample_unit(F, A, u);
    }
}

__device__ __forceinline__ void phase6(Frame& F, const Args& A) {
    const float* OB = (const float*)(F.ws + WS_OB); const bf16* ZB = (const bf16*)(F.ws + WS_ZB); const float* gn = FIN(14); bf16* AB = (bf16*)(F.ws + WS_AB);
    const int gw = F.blk * NWAVES + F.wave, NGW = F.G * NWAVES, lane = F.lane;
    if (gw >= NPR) return;
    const int nr = (NPR - gw + NGW - 1) / NGW;
    f32x4 gr[4][2];
#pragma unroll
    for (int hh = 0; hh < 4; ++hh) { gr[hh][0] = *(const f32x4*)(gn + hh * 512 + lane * 8); gr[hh][1] = *(const f32x4*)(gn + hh * 512 + lane * 8 + 4); }
    auto rowof = [&](int i) { const int ic = (i < nr) ? i : nr - 1; return gw + ic * NGW; };
    auto process = [&](const f32x4 (&a)[4][2], const v4u (&z)[4], int row) {
#pragma unroll
        for (int hh = 0; hh < 4; ++hh) { const int col = hh * 512 + lane * 8;
            const f32x4 x0 = a[hh][0], x1 = a[hh][1];
            float ss = (x0[0] * x0[0] + x0[1] * x0[1]) + (x0[2] * x0[2] + x0[3] * x0[3]) + (x1[0] * x1[0] + x1[1] * x1[1]) + (x1[2] * x1[2] + x1[3] * x1[3]);
            ss = wave_sum(ss);
            const float rstd = rsqrtf(ss * (1.0f / 512.0f) + EPS);
            const v4u zw = z[hh];
            const f32x4 g0 = gr[hh][0], g1 = gr[hh][1];
            v4u w; w.x = pk2(x0[0] * rstd * g0[0] * bflo(zw.x), x0[1] * rstd * g0[1] * bfhi(zw.x)); w.y = pk2(x0[2] * rstd * g0[2] * bflo(zw.y), x0[3] * rstd * g0[3] * bfhi(zw.y));
            w.z = pk2(x1[0] * rstd * g1[0] * bflo(zw.z), x1[1] * rstd * g1[1] * bfhi(zw.z)); w.w = pk2(x1[2] * rstd * g1[2] * bflo(zw.w), x1[3] * rstd * g1[3] * bfhi(zw.w));
            *(v4u*)(AB + (size_t)row * DM + 2048 + col) = w; }
    };
#define P6_LOAD(a_, z_, r) do { _Pragma("unroll") for (int hh = 0; hh < 4; ++hh) { const size_t o_ = (size_t)(r) * 2048 + hh * 512 + lane * 8; \
        a_[hh][0] = *(const f32x4*)(OB + o_); a_[hh][1] = *(const f32x4*)(OB + o_ + 4); z_[hh] = *(const v4u*)(ZB + o_); } } while (0)
    f32x4 aa[4][2], ab[4][2]; v4u za[4], zb[4];
    P6_LOAD(aa, za, rowof(0));
    int i = 0;
#pragma unroll 1
    for (; i + 1 < nr; i += 2) {
        P6_LOAD(ab, zb, rowof(i + 1));
        process(aa, za, rowof(i));
        P6_LOAD(aa, za, rowof(i + 2));
        process(ab, zb, rowof(i + 1));
    }
    if (i < nr) process(aa, za, rowof(i));
#undef P6_LOAD
}

__device__ __forceinline__ void phase9(Frame& F, const Args& A) {
    const float* SSQ = (const float*)(F.ws + WS_SSQ); const float* fg = FIN(18); float* Y = F.out + OUT_Y; const bf16* XN = (const bf16*)(F.ws + WS_XN);
    const int gw = F.blk * NWAVES + F.wave, NGW = F.G * NWAVES, lane = F.lane;
    int extra; const int nr = wave_rows(NROW, gw, NGW, extra);
    if (nr == 0) return;
    const int nfull = NROW / NGW;
    f32x4 gr[8][2];
#pragma unroll
    for (int q = 0; q < 8; ++q) { const int c = 8 * (lane + 64 * q); gr[q][0] = *(const f32x4*)(fg + c); gr[q][1] = *(const f32x4*)(fg + c + 4); }
    auto rowof = [&](int i) { const int ic = (i < nr) ? i : nr - 1; return (ic < nfull) ? gw + ic * NGW : extra; };
    auto process = [&](const v4u (&v)[8], float sq, int row) {
        const float rstd = rsqrtf(wave_sum(sq) * (1.0f / DM) + EPS);
        float* yw = Y + (size_t)row * DM;
#pragma unroll
        for (int q = 0; q < 8; ++q) { const int c = 8 * (lane + 64 * q);
            const f32x4 a = {bflo(v[q].x), bfhi(v[q].x), bflo(v[q].y), bfhi(v[q].y)}, b = {bflo(v[q].z), bfhi(v[q].z), bflo(v[q].w), bfhi(v[q].w)};
            __builtin_nontemporal_store(a * rstd * gr[q][0], (f32x4*)(yw + c)); __builtin_nontemporal_store(b * rstd * gr[q][1], (f32x4*)(yw + c + 4)); }
    };
#define P9_LOAD(v_, sq_, r) do { const bf16* xr_ = XN + (size_t)(r) * DM + 8 * lane; _Pragma("unroll") for (int q = 0; q < 8; ++q) v_[q] = *(const v4u*)(xr_ + 512 * q); \
        sq_ = SSQ[(size_t)(r) * 64 + lane]; } while (0)
    v4u va[8], vb[8]; float sa, sb_;
    P9_LOAD(va, sa, rowof(0));
    int i = 0;
#pragma unroll 1
    for (; i + 1 < nr; i += 2) {
        P9_LOAD(vb, sb_, rowof(i + 1));
        process(va, sa, rowof(i));
        P9_LOAD(va, sa, rowof(i + 2));
        process(vb, sb_, rowof(i + 1));
    }
    if (i < nr) process(va, sa, rowof(i));
#undef P9_LOAD
}

constexpr int N_PHASES = 10;
constexpr int P3_NCG = 3;

__global__ void __launch_bounds__(NWAVES * 64, 2) mk_fwd(Args args) {
    extern __shared__ __attribute__((aligned(16))) unsigned char lds[];
    Frame F;
    F.lds = (LAS unsigned char*)lds;
    F.tid = threadIdx.x; F.lane = F.tid & 63; F.wave = __builtin_amdgcn_readfirstlane(F.tid >> 6);
    F.G = gridDim.x; F.blk = blockIdx.x;
    const Args& A = args;
    F.out = args.out; F.ws = args.ws;
    volatile LAS unsigned* MISC = (volatile LAS unsigned*)(F.lds + MISC_OFF);
    if (F.tid < 32) MISC[F.tid] = 0u;
    __syncthreads();
    unsigned* ctl = (unsigned*)(F.ws + WS_CTL);
    XcdBarrier bar; bar.bar = ctl + CW_BAR; bar.x = 0; bar.st = nullptr;
    if (MK_N_LAUNCHES == 1) bar = xcd_barrier_post(ctl + CW_BAR, MISC + 8);
    const int lo = args.ph_lo, hi = args.ph_hi;
#ifdef ONLY
#define IN(k) ((k) == ONLY)
#else
#define IN(k) (lo <= (k) && (k) < hi)
#endif
#define SEAM(k) do { if (IN(k) && IN((k) + 1)) xcd_barrier(bar); } while (0)
#ifndef PROBE_REPEAT
#define PROBE_REPEAT -1
#endif
#define PH(k, ...) do { if (IN(k)) { const int reps_ = (PROBE_REPEAT == (k)) ? args.ph_rep : 1; _Pragma("nounroll") for (int r_ = 0; r_ < reps_; ++r_) { { __VA_ARGS__ } if (r_ + 1 < reps_) xcd_barrier(bar); } } SEAM(k); } while (0)

    PH(0, phase0(F, A););
    PH(1, phase1(F, A, ctl););
    PH(2, phase2(F, A););
    PH(3,
        pg8::Gemm g{(const bf16*)(F.ws + WS_H), (const bf16*)(F.ws + WS_WB1), NROW, N1, DM}; pg8::GroupedOrder S; S.init(NROW, N1, F.G, F.blk, P3_NCG);
        EpiProj E{F.ws};
        pg8::gemm_phase<EpiProj, pg8::GroupedOrder>(F.lds, g, S, E);
        transpose_queue<1>(F, A, ctl + CW_TRN2);
    );
    int p5_pass = 0;
    PH(4,
        for (int u = F.blk; u < 256; u += F.G) swa_prompt_unit(F, A, u);
        for (int u = F.blk; u < 512; u += F.G) gla_prep_unit(F, A, u);
        for (int u = F.blk; u < 512; u += F.G) swa_sample_unit(F, A, u);
        win_prompt(F, A);
    );
    PH(5,
        for (int u = F.blk; u < 8 * SEQ_DVG; u += F.G) gla_seq_unit(F, A, u);
        gla_sample_loop(F, A, ctl + CW_SMP + 64 * p5_pass); ++p5_pass;
    );
    if (PROBE_REPEAT == 40) { for (int u = F.blk; u < 256; u += F.G) swa_prompt_unit(F, A, u); xcd_barrier(bar); }
    if (PROBE_REPEAT == 41) { for (int u = F.blk; u < 512; u += F.G) gla_prep_unit(F, A, u); xcd_barrier(bar); }
    if (PROBE_REPEAT == 42) { for (int u = F.blk; u < 512; u += F.G) swa_sample_unit(F, A, u); xcd_barrier(bar); }
    if (PROBE_REPEAT == 50) { for (int u = F.blk; u < 8 * SEQ_DVG; u += F.G) gla_seq_unit(F, A, u); xcd_barrier(bar); }
    if (PROBE_REPEAT == 51) { gla_sample_loop(F, A, ctl + CW_SMP + 64 * p5_pass); xcd_barrier(bar); }
    PH(6, phase6(F, A););
    PH(7,
        pg8::Gemm g{(const bf16*)(F.ws + WS_AB), (const bf16*)(F.ws + WS_WB2), NROW, DM, DM}; pg8::StaticOrder S; S.init(NROW, DM, F.G, F.blk, 192);
        EpiMerge E{(const bf16*)(F.ws + WS_SGA), (const bf16*)(F.ws + WS_SGB), (bf16*)(F.ws + WS_MERGED)};
        pg8::gemm_phase<EpiMerge>(F.lds, g, S, E);
    );
    PH(8,
        pg8::Gemm g{(const bf16*)(F.ws + WS_MERGED), (const bf16*)(F.ws + WS_WB3), NROW, DM, DM}; pg8::StaticOrder S; S.init(NROW, DM, F.G, F.blk, 192);
        EpiOut E{A.in[0], A.in[1], (const float*)(F.ws + WS_MOD), (bf16*)(F.ws + WS_XN), (float*)(F.ws + WS_SSQ)};
        pg8::gemm_phase<EpiOut>(F.lds, g, S, E);
    );
    if (IN(9)) { phase9(F, A); }
    if (PROBE_REPEAT == 900) { for (int i = 0; i < 8; ++i) xcd_barrier(bar); }
#undef IN
#undef SEAM
#undef PH
}

extern "C" void kernel_launch(void* const* d_in, const int* in_sizes, int n_in, void* d_out, int out_size, void* d_ws, size_t ws_size, hipStream_t stream) {
    static int grid = 0;
    if (grid == 0) {
        if (n_in != 19 || (size_t)out_size != OUT_TOTAL || ws_size < WS_END) { fprintf(stderr, "kernel_launch: unexpected sizes n_in %d out %d ws %zu (need %zu)\n", n_in, out_size, ws_size, (size_t)WS_END); grid = -1; return; }
        int dev = 0, cus = 0, per_cu = 0;
        if (hipGetDevice(&dev) != hipSuccess || hipDeviceGetAttribute(&cus, hipDeviceAttributeMultiprocessorCount, dev) != hipSuccess) { grid = -1; return; }
        if (hipFuncSetAttribute((const void*)mk_fwd, hipFuncAttributeMaxDynamicSharedMemorySize, LDS_BYTES) != hipSuccess) { fprintf(stderr, "kernel_launch: hipFuncSetAttribute failed\n"); grid = -1; return; }
        if (hipOccupancyMaxActiveBlocksPerMultiprocessor(&per_cu, (const void*)mk_fwd, NWAVES * 64, LDS_BYTES) != hipSuccess || per_cu < 1) fprintf(stderr, "kernel_launch: occupancy query reports %d\n", per_cu);
        (void)hipGetLastError();
        grid = cus;
    }
    if (grid < 0) return;
    (void)hipMemsetAsync((char*)d_ws + WS_CTL, 0, CTL_ZERO_BYTES, stream);
    Args a{};
    for (int i = 0; i < 19; ++i) a.in[i] = (const float*)d_in[i];
    a.out = (float*)d_out; a.ws = (unsigned char*)d_ws;
    a.ph_rep = 2; a.pad_ = 0;
    if (MK_N_LAUNCHES == 1) { a.ph_lo = 0; a.ph_hi = N_PHASES; hipLaunchKernelGGL(mk_fwd, dim3(grid), dim3(NWAVES * 64), LDS_BYTES, stream, a); }
    else for (int li = 0; li < N_PHASES; ++li) { a.ph_lo = li; a.ph_hi = li + 1; hipLaunchKernelGGL(mk_fwd, dim3(grid), dim3(NWAVES * 64), LDS_BYTES, stream, a); }
}
```

```cpp
#include <hip/hip_runtime.h>
#include <cstdio>
#include <cstdint>

#ifndef MK_N_LAUNCHES
#define MK_N_LAUNCHES 1
#endif

#define GAS __attribute__((address_space(1)))
#define LAS __attribute__((address_space(3)))
typedef unsigned short bf16;
typedef unsigned v4u __attribute__((ext_vector_type(4)));
typedef unsigned v2u __attribute__((ext_vector_type(2)));
typedef float f32x2 __attribute__((ext_vector_type(2)));
typedef float f32x4 __attribute__((ext_vector_type(4)));
typedef float f32x16 __attribute__((ext_vector_type(16)));
typedef short bf16x8 __attribute__((ext_vector_type(8)));
typedef __bf16 bf16x2_t __attribute__((ext_vector_type(2)));
#define LDS_WAIT() asm volatile("s_waitcnt lgkmcnt(0)" ::: "memory")
#define VM_WAIT() asm volatile("s_waitcnt vmcnt(0)" ::: "memory")

__device__ __forceinline__ unsigned pk2(float lo, float hi) { f32x2 v = {lo, hi}; bf16x2_t b = __builtin_convertvector(v, bf16x2_t); return __builtin_bit_cast(unsigned, b); }
__device__ __forceinline__ bf16 f2bf(float f) { return (bf16)(pk2(f, 0.f) & 0xffffu); }
__device__ __forceinline__ float bf2f(bf16 b) { return __uint_as_float(((unsigned)b) << 16); }
__device__ __forceinline__ float bflo(unsigned w) { return __uint_as_float(w << 16); }
__device__ __forceinline__ float bfhi(unsigned w) { return __uint_as_float(w & 0xffff0000u); }
__device__ __forceinline__ float wave_sum(float v) {
#pragma unroll
    for (int o = 1; o < 64; o <<= 1) v += __shfl_xor(v, o);
    return v;
}
__device__ __forceinline__ float sigmoidf_(float x) { return __builtin_amdgcn_rcpf(1.0f + __builtin_amdgcn_exp2f(-1.44269504089f * x)); }

#define XB_TMO      128
#define XB_XCNT(j)  (256  + 64 * (j))
#define XB_XSUB(j)  (1280 + 64 * (j))
#define XB_XGEN(j)  (2304 + 64 * (j))
#define XB_TOP      3328
#define XB_TOPGEN   3392
#define XCD_BAR_WORDS 3456
#define XB_SPIN_CAP (1u << 18)

__device__ __forceinline__ unsigned xb_ld(unsigned* p)              { return __hip_atomic_load(p, __ATOMIC_RELAXED, __HIP_MEMORY_SCOPE_AGENT); }
__device__ __forceinline__ unsigned xb_add(unsigned* p, unsigned v) { return __hip_atomic_fetch_add(p, v, __ATOMIC_RELAXED, __HIP_MEMORY_SCOPE_AGENT); }
__device__ __forceinline__ unsigned xb_xcc_id() { return (unsigned)__builtin_amdgcn_s_getreg((3 << 11) | 20) & 0xFu; }
#define XB_SPIN(cond, bar) do { unsigned _sp = 0; while (cond) { __builtin_amdgcn_s_sleep(1); \
    if ((++_sp & 255u) == 0u) { if (xb_ld(&(bar)[XB_TMO])) break; if (_sp > XB_SPIN_CAP) { atomicAdd(&(bar)[XB_TMO], 1u); break; } } } } while (0)

struct XcdBarrier { unsigned* bar; unsigned x; volatile LAS unsigned* st; };

__device__ __forceinline__ XcdBarrier xcd_barrier_post(unsigned* bar, volatile LAS unsigned* st) {
    XcdBarrier b; b.bar = bar; b.x = xb_xcc_id(); b.st = st;
    if (threadIdx.x == 0) (void)xb_add(&bar[XB_XCNT(b.x)], 1u);
    return b;
}
__device__ __forceinline__ void xcd_barrier_complete(unsigned* bar, unsigned x, unsigned& nloc, unsigned& nx) {
    const unsigned G = gridDim.x * gridDim.y * gridDim.z;
    unsigned sum, cnt, mine, sp = 0u;
    for (;;) {
        sum = 0u; cnt = 0u; mine = 0u;
#pragma unroll
        for (unsigned j = 0; j < 16; ++j) { const unsigned c = xb_ld(&bar[XB_XCNT(j)]); sum += c; cnt += (c > 0u) ? 1u : 0u; mine = (j == x) ? c : mine; }
        if (sum == G) break;
        __builtin_amdgcn_s_sleep(1);
        if ((++sp & 255u) == 0u) { if (xb_ld(&bar[XB_TMO])) break; if (sp > XB_SPIN_CAP) { atomicAdd(&bar[XB_TMO], 1u); break; } }
    }
    nloc = mine > 0u ? mine : 1u; nx = cnt > 0u ? cnt : 1u;
}
__device__ __forceinline__ void xcd_barrier(const XcdBarrier& b) {
    asm volatile("s_waitcnt vmcnt(0)" ::: "memory");
    __syncthreads();
    if (threadIdx.x == 0) {
        unsigned* bar = b.bar;
        __builtin_amdgcn_s_waitcnt(0);
        unsigned nloc = b.st[0], nx = b.st[1];
        if (nloc == 0u) { xcd_barrier_complete(bar, b.x, nloc, nx); b.st[0] = nloc; b.st[1] = nx; }
        const unsigned old = xb_add(&bar[XB_XSUB(b.x)], 1u);
        const unsigned gen = old / nloc;
        if (old + 1u == (gen + 1u) * nloc) {
            __builtin_amdgcn_fence(__ATOMIC_RELEASE, "agent");
            asm volatile("s_waitcnt vmcnt(0)" ::: "memory");
            const unsigned og = xb_add(&bar[XB_TOP], 1u);
            const unsigned tg = og / nx;
            if (og + 1u == (tg + 1u) * nx) xb_add(&bar[XB_TOPGEN], 1u);
            else XB_SPIN(xb_ld(&bar[XB_TOPGEN]) == tg, bar);
            __builtin_amdgcn_fence(__ATOMIC_ACQUIRE, "agent");
            xb_add(&bar[XB_XGEN(b.x)], 1u);
            asm volatile("s_waitcnt vmcnt(0)" ::: "memory");
        } else {
            XB_SPIN(xb_ld(&bar[XB_XGEN(b.x)]) == gen, bar);
            __builtin_amdgcn_fence(__ATOMIC_ACQUIRE, "agent");
            asm volatile("s_waitcnt vmcnt(0)" ::: "memory");
        }
    }
    __syncthreads();
}

constexpr int DM = 4096;
constexpr int NPR = 8192, NSR = 1024, NROW = NPR + NSR;
constexpr int SEQ = 4096, NSEQ_S = 128, TS = 8;
constexpr int N1 = 19200, NT1 = 75;
constexpr int PROJ = 18960;
constexpr int NMOD = 130;
constexpr float EPS = 1e-6f;

constexpr size_t MiB = 1u << 20;
constexpr size_t WS_CTL = 0, CTL_ZERO_BYTES = 1 * MiB;
constexpr size_t WS_WB1 = 1 * MiB;
constexpr size_t WS_WB2 = WS_WB1 + (size_t)N1 * DM * 2;
constexpr size_t WS_WB3 = WS_WB2 + (size_t)DM * DM * 2;
constexpr size_t WS_CS  = WS_WB3 + (size_t)DM * DM * 2;
constexpr size_t WS_MOD = WS_CS + (size_t)160 * DM * 2;
constexpr size_t WS_H   = WS_MOD + (size_t)132 * 12288 * 4;
constexpr size_t WS_QA  = WS_H + (size_t)NROW * DM * 2;
constexpr size_t WS_KA  = WS_QA + (size_t)NROW * 2048 * 2;
constexpr size_t WS_VA  = WS_KA + (size_t)NROW * 256 * 2;
constexpr size_t WS_ZA  = WS_VA + (size_t)NROW * 256 * 2;
constexpr size_t WS_QB  = WS_ZA + (size_t)NROW * 2048 * 2;
constexpr size_t WS_KB  = WS_QB + (size_t)NROW * 1024 * 2;
constexpr size_t WS_VB  = WS_KB + (size_t)NROW * 1024 * 2;
constexpr size_t WS_ZB  = WS_VB + (size_t)NROW * 2048 * 2;
constexpr size_t WS_SGA = WS_ZB + (size_t)NROW * 2048 * 2;
constexpr size_t WS_SGB = WS_SGA + (size_t)NROW * DM * 2;
constexpr size_t WS_R   = WS_SGB + (size_t)NROW * DM * 2;
constexpr size_t WS_QT  = WS_R + (size_t)NROW * 16 * 4;
constexpr size_t WS_KDT = WS_QT + (size_t)512 * 64 * 256 * 2;
constexpr size_t WS_ATT = WS_KDT + (size_t)512 * 64 * 256 * 2;
constexpr size_t WS_VT  = WS_ATT + (size_t)512 * 64 * 64 * 2;
constexpr size_t WS_DEC = WS_VT + (size_t)512 * 512 * 64 * 2;
constexpr size_t WS_OB  = WS_DEC + (size_t)512 * 256 * 4;
constexpr size_t WS_AB  = WS_OB + (size_t)NPR * 2048 * 4;
constexpr size_t WS_SSQ = WS_AB + (size_t)NROW * DM * 2;
constexpr size_t WS_END = WS_SSQ + (size_t)NROW * 64 * 4;
constexpr size_t WS_MERGED = WS_H;
constexpr size_t WS_XN = WS_AB;
constexpr int CW_BAR = 4096;

constexpr size_t OUT_Y = 0;
constexpr size_t OUT_KWP = (size_t)NROW * DM;
constexpr size_t OUT_VWP = OUT_KWP + 65536;
constexpr size_t OUT_GSP = OUT_VWP + 65536;
constexpr size_t OUT_KWS = OUT_GSP + 1048576;
constexpr size_t OUT_VWS = OUT_KWS + 4194304;
constexpr size_t OUT_GSS = OUT_VWS + 4194304;
constexpr size_t OUT_TOTAL = OUT_GSS + 67108864;

constexpr int RING_BYTES = 131072;
constexpr int LDS_BYTES = 155648;
constexpr int MISC_OFF = LDS_BYTES - 256;
constexpr int SMP_P4 = 0;
constexpr int CW_SMP = 64;
constexpr int NWAVES = 8;

namespace pg8 {
constexpr int BM = 256, BK = 64, HALF = 128, HTB = HALF * BK * 2, STAGE_BYTES = 8 * HTB, NXCD = 8, WGM = 8;
__host__ __device__ __forceinline__ int lds_byte(int r, int c) { const int st = (r >> 4) * 2 + (c >> 5), rr = r & 15, cc = c & 31, ob = rr * 64 + cc * 2; return st * 1024 + (ob ^ (((ob >> 9) & 1) << 5)); }
__host__ __device__ __forceinline__ void stage_rc(int b, int& R, int& C) { const int st = b / 1024, sb = b % 1024, swz = sb ^ (((sb >> 9) & 1) << 5); R = (st >> 1) * 16 + swz / 64; C = (st & 1) * 32 + (swz % 64) / 2; }
__host__ __device__ __forceinline__ int perm32(int rho) { const int n = rho >> 4, i = rho & 15; return 8 * (i >> 2) + 4 * n + (i & 3); }

struct Unit { int pm, pn; };
struct Gemm { const bf16* A; const bf16* Bt; int M, N, K; };

struct StaticOrder {
    int nM, nN, nwg, G, c;
    __host__ __device__ void init(int M, int N, int G_, int c_, int bm_rows = BM) { nM = M / bm_rows; nN = N / BM; nwg = nM * nN; G = G_; c = c_; }
    __host__ __device__ bool next(int i, Unit& u) const {
        const long L = (long)i * G + c; if (L >= nwg) return false;
        int wgid = (int)L; { const int q = nwg / NXCD, r = nwg % NXCD, xcd = wgid % NXCD, off = wgid / NXCD; wgid = (xcd < r ? xcd * (q + 1) : r * (q + 1) + (xcd - r) * q) + off; }
        const int nig = WGM * nN, gid = wgid / nig, fm = gid * WGM, gsz = (nM - fm) < WGM ? (nM - fm) : WGM;
        u.pm = fm + ((wgid % nig) % gsz); u.pn = (wgid % nig) / gsz; return true;
    }
};

struct GroupedOrder {
    int nM, nNg, ncg, per, G, c;
    __host__ __device__ void init(int M, int N, int G_, int c_, int ncg_) { nM = M / BM; ncg = ncg_; nNg = (N / BM) / ncg_; per = nM * nNg; G = G_; c = c_; }
    __host__ __device__ bool next(int i, Unit& u) const {
        const long L = (long)i * G + c; if (L >= (long)per * ncg) return false;
        const int grp = (int)(L / per); int wgid = (int)(L % per);
        { const int q = per / NXCD, r = per % NXCD, xcd = wgid % NXCD, off = wgid / NXCD; wgid = (xcd < r ? xcd * (q + 1) : r * (q + 1) + (xcd - r) * q) + off; }
        const int nig = WGM * nNg, gid = wgid / nig, fm = gid * WGM, gsz = (nM - fm) < WGM ? (nM - fm) : WGM;
        u.pm = fm + ((wgid % nig) % gsz); u.pn = grp * nNg + (wgid % nig) / gsz; return true;
    }
};

template <class Epi, class Sched = StaticOrder>
__device__ __forceinline__ void gemm_phase(LAS unsigned char* lds, const Gemm g, const Sched& S, const Epi& E) {
    const int tid = threadIdx.x, wid = __builtin_amdgcn_readfirstlane(tid >> 6), lane = tid & 63, wr = wid >> 2, wc = wid & 3, fr = lane & 15, fq = lane >> 4;
    constexpr int MT = Epi::MT;
    const int K = g.K, nt = K / BK;
    unsigned voffA[2], voffB[2];
#pragma unroll
    for (int i = 0; i < 2; ++i) { int R, C; stage_rc(tid * 16 + i * 8192, R, C); const int Rb = Epi::PERM ? ((R & ~31) + perm32(R & 31)) : R;
        const int Ra = (MT == 3 && R >= 96) ? R - 32 : R;
        voffA[i] = (unsigned)(Ra * K + C) * 2u; voffB[i] = (unsigned)(Rb * K + C) * 2u; }
    const size_t kstep = (size_t)(BK * 2);
    const size_t hstep = (size_t)HALF * K * 2;
    const size_t tstep = 2 * hstep;
    const size_t hstepA = (size_t)(32 * MT) * K * 2;
    const size_t tstepA = 2 * hstepA;
    const unsigned ldsw = (unsigned)wid * 1024u;
    const int aoff = lds_byte(wr * 16 * MT + fr, fq * 8), boff = lds_byte(wc * 32 + fr, fq * 8);
#define PG8_SA(b, h) (((b) * 2 + (h)) * HTB)
#define PG8_SB(b, h) ((4 + (b) * 2 + (h)) * HTB)
#define PG8_STAGE(bufoff, gbase, voff) do { _Pragma("unroll") for (int _i = 0; _i < 2; ++_i) \
        __builtin_amdgcn_global_load_lds((const unsigned*)((const char*)(gbase) + (voff)[_i]), (LAS unsigned*)(lds + (bufoff) + ldsw + _i * 8192), 16, 0, 0); } while (0)
#define PG8_STAGEB(bufoff, gbase, voff) do { _Pragma("unroll") for (int _i = 0; _i < 2; ++_i) \
        __builtin_amdgcn_global_load_lds((const unsigned*)((const char*)(gbase) + (voff)[_i]), (LAS unsigned*)(lds + (bufoff) + ldsw + _i * 8192), 16, 0, Epi::AUXB); } while (0)
#define PG8_LDA(dst, b, h) do { _Pragma("unroll") for (int m = 0; m < MT; ++m) _Pragma("unroll") for (int k = 0; k < 2; ++k) dst[m][k] = *(const LAS bf16x8*)(lds + PG8_SA(b, h) + aoff + m * 2048 + k * 1024); } while (0)
#define PG8_LDB(dst, b, h) do { _Pragma("unroll") for (int n = 0; n < 2; ++n) _Pragma("unroll") for (int k = 0; k < 2; ++k) dst[n][k] = *(const LAS bf16x8*)(lds + PG8_SB(b, h) + boff + n * 2048 + k * 1024); } while (0)
#define PG8_MMA(ai, bj, At, Bt) do { __builtin_amdgcn_s_setprio(1); _Pragma("unroll") for (int m = 0; m < MT; ++m) _Pragma("unroll") for (int n = 0; n < 2; ++n) _Pragma("unroll") for (int k = 0; k < 2; ++k) \
        acc[ai][bj][m][n] = __builtin_amdgcn_mfma_f32_16x16x32_bf16(Bt[n][k], At[m][k], acc[ai][bj][m][n], 0, 0, 0); __builtin_amdgcn_s_setprio(0); } while (0)
#define PG8_WAIT_V(n) asm volatile("s_waitcnt vmcnt(" #n ")" ::: "memory")
#define PG8_WAIT_L(n) asm volatile("s_waitcnt lgkmcnt(" #n ")" ::: "memory")
#define PG8_BAR __builtin_amdgcn_s_barrier()
#define PG8_SCHED __builtin_amdgcn_sched_barrier(0)
    Unit cur, nxt; int ui = 0;
    if (!S.next(0, cur)) return;
    f32x4 acc[2][2][MT][2];
#pragma unroll
    for (int a = 0; a < 2; ++a)
#pragma unroll
        for (int b = 0; b < 2; ++b)
#pragma unroll
            for (int m = 0; m < MT; ++m)
#pragma unroll
                for (int n = 0; n < 2; ++n) acc[a][b][m][n] = (f32x4){0.f, 0.f, 0.f, 0.f};
    bf16x8 At[MT][2], B0[2][2], B1[2][2];
    const char* cA = (const char*)g.A + (size_t)cur.pm * tstepA; const char* cB = (const char*)g.Bt + (size_t)cur.pn * tstep;
    PG8_STAGEB(PG8_SB(0, 0), cB, voffB); PG8_STAGEB(PG8_SB(0, 1), cB + hstep, voffB); PG8_STAGE(PG8_SA(0, 0), cA, voffA); PG8_STAGE(PG8_SA(0, 1), cA + hstepA, voffA);
    if (wr == 1) PG8_BAR;
    PG8_WAIT_V(2); PG8_BAR;
    PG8_STAGEB(PG8_SB(1, 0), cB + kstep, voffB); PG8_STAGE(PG8_SA(1, 0), cA + kstep, voffA); PG8_STAGEB(PG8_SB(1, 1), cB + hstep + kstep, voffB);
    PG8_WAIT_V(6); PG8_BAR;
    for (;;) {
        const bool has_next = S.next(ui + 1, nxt);
        const char* nA = has_next ? (const char*)g.A + (size_t)nxt.pm * tstepA : cA; const char* nB = has_next ? (const char*)g.Bt + (size_t)nxt.pn * tstep : cB;
        for (int t = 0; t < nt; t += 2) {
            const bool last = (t == nt - 2);
            const char* a1 = cA + (size_t)(t + 1) * kstep;
            const char* a2 = last ? nA : cA + (size_t)(t + 2) * kstep; const char* b2 = last ? nB : cB + (size_t)(t + 2) * kstep;
            const char* a3 = a2 + kstep; const char* b3 = b2 + kstep;
            if constexpr (Epi::HAS_MID) { if (t == nt / 2) E.mid(acc, cur, wr, wc, fr, fq); }
            PG8_LDB(B0, 0, 0); PG8_LDB(B1, 0, 1); PG8_SCHED; PG8_LDA(At, 0, 0); PG8_STAGE(PG8_SA(1, 1), a1 + hstepA, voffA);
            PG8_WAIT_V(8); PG8_WAIT_L(0); PG8_BAR; PG8_MMA(0, 0, At, B0); PG8_MMA(0, 1, At, B1); PG8_BAR; PG8_SCHED;
            PG8_LDA(At, 0, 1); PG8_STAGEB(PG8_SB(0, 0), b2, voffB); PG8_STAGEB(PG8_SB(0, 1), b2 + hstep, voffB); PG8_STAGE(PG8_SA(0, 0), a2, voffA);
            PG8_WAIT_V(8); PG8_WAIT_L(0); PG8_BAR; PG8_MMA(1, 0, At, B0); PG8_MMA(1, 1, At, B1); PG8_BAR; PG8_SCHED;
            PG8_LDB(B0, 1, 0); PG8_LDB(B1, 1, 1); PG8_SCHED; PG8_LDA(At, 1, 0); PG8_STAGE(PG8_SA(0, 1), a2 + hstepA, voffA);
            PG8_WAIT_V(8); PG8_WAIT_L(0); PG8_BAR; PG8_MMA(0, 0, At, B0); PG8_MMA(0, 1, At, B1); PG8_BAR; PG8_SCHED;
            PG8_LDA(At, 1, 1); PG8_STAGEB(PG8_SB(1, 0), b3, voffB); PG8_STAGEB(PG8_SB(1, 1), b3 + hstep, voffB); PG8_STAGE(PG8_SA(1, 0), a3, voffA);
            PG8_WAIT_V(8); PG8_WAIT_L(0); PG8_BAR; PG8_MMA(1, 0, At, B0); PG8_MMA(1, 1, At, B1); PG8_BAR; PG8_SCHED;
        }
        if (wr == 0) PG8_BAR;
        E(acc, cur, wr, wc, fr, fq);
        if (!has_next) break;
#pragma unroll
        for (int a = 0; a < 2; ++a)
#pragma unroll
            for (int b = 0; b < 2; ++b)
#pragma unroll
                for (int m = 0; m < MT; ++m)
#pragma unroll
                    for (int n = 0; n < 2; ++n) acc[a][b][m][n] = (f32x4){0.f, 0.f, 0.f, 0.f};
        cur = nxt; cA = nA; cB = nB; ++ui;
        if (wr == 1) PG8_BAR;
    }
    PG8_WAIT_V(0);
    PG8_BAR;
#undef PG8_SA
#undef PG8_SB
#undef PG8_STAGE
#undef PG8_STAGEB
#undef PG8_LDA
#undef PG8_LDB
#undef PG8_MMA
#undef PG8_WAIT_V
#undef PG8_WAIT_L
#undef PG8_BAR
#undef PG8_SCHED
}
}

struct EpiProj {
    static constexpr bool PERM = true, HAS_MID = false; static constexpr int MT = 4, AUXB = 0;
    unsigned char* ws;
    __device__ __forceinline__ void operator()(const f32x4 (&acc)[2][2][4][2], const pg8::Unit& u, int wr, int wc, int fr, int fq) const {
        const int pn = u.pn;
        const int row0 = u.pm * 256 + wr * 64 + fr;
        if (pn == 74) {
            if (wc == 0 && fq < 2) {
                float* R = (float*)(ws + WS_R);
#pragma unroll
                for (int ai = 0; ai < 2; ++ai)
#pragma unroll
                    for (int m = 0; m < 4; ++m) { float* rp = R + (size_t)(row0 + ai * 128 + m * 16) * 16 + 8 * fq;
                        *(f32x4*)(rp) = acc[ai][0][m][0]; *(f32x4*)(rp + 4) = acc[ai][0][m][1]; }
            }
            return;
        }
        if (pn >= 42) {
            bf16* RT = (bf16*)(ws + WS_SGA); bf16* SB = (bf16*)(ws + WS_SGB);
            const int col0 = (pn - 42) * 128 + wc * 32 + 8 * fq;
#pragma unroll
            for (int ai = 0; ai < 2; ++ai)
#pragma unroll
                for (int m = 0; m < 4; ++m) { const size_t off = (size_t)(row0 + ai * 128 + m * 16) * DM + col0;
                    float rt[8], sb[8];
#pragma unroll
                    for (int n = 0; n < 2; ++n)
#pragma unroll
                        for (int j = 0; j < 4; ++j) { const float ea = __builtin_amdgcn_exp2f(-1.44269504089f * acc[ai][0][m][n][j]), eb = __builtin_amdgcn_exp2f(-1.44269504089f * acc[ai][1][m][n][j]);
                            sb[4 * n + j] = __builtin_amdgcn_rcpf(1.0f + eb); rt[4 * n + j] = (1.0f + eb) * __builtin_amdgcn_rcpf(1.0f + ea); }
                    v4u w; w.x = pk2(rt[0], rt[1]); w.y = pk2(rt[2], rt[3]); w.z = pk2(rt[4], rt[5]); w.w = pk2(rt[6], rt[7]);
                    __builtin_nontemporal_store(w, (v4u*)(RT + off));
                    w.x = pk2(sb[0], sb[1]); w.y = pk2(sb[2], sb[3]); w.z = pk2(sb[4], sb[5]); w.w = pk2(sb[6], sb[7]);
                    __builtin_nontemporal_store(w, (v4u*)(SB + off)); }
            return;
        }
        size_t boff; int ldc, ct, act;
        if (pn < 8)       { boff = WS_QA;  ldc = 2048; ct = pn;      act = 0; }
        else if (pn == 8) { boff = WS_KA;  ldc = 256;  ct = 0;       act = 0; }
        else if (pn == 9) { boff = WS_VA;  ldc = 256;  ct = 0;       act = 0; }
        else if (pn < 18) { boff = WS_ZA;  ldc = 2048; ct = pn - 10; act = 1; }
        else if (pn < 22) { boff = WS_QB;  ldc = 1024; ct = pn - 18; act = 0; }
        else if (pn < 26) { boff = WS_KB;  ldc = 1024; ct = pn - 22; act = 0; }
        else if (pn < 34) { boff = WS_VB;  ldc = 2048; ct = pn - 26; act = 0; }
        else              { boff = WS_ZB;  ldc = 2048; ct = pn - 34; act = 1; }
        bf16* base = (bf16*)(ws + boff);
        const int col0 = ct * 256 + wc * 32 + 8 * fq;
#pragma unroll
        for (int ai = 0; ai < 2; ++ai)
#pragma unroll
            for (int m = 0; m < 4; ++m) { bf16* rowp = base + (size_t)(row0 + ai * 128 + m * 16) * ldc + col0;
#pragma unroll
                for (int bj = 0; bj < 2; ++bj) { f32x4 v0 = acc[ai][bj][m][0], v1 = acc[ai][bj][m][1];
                    if (act != 0) {
#pragma unroll
                        for (int j = 0; j < 4; ++j) { v0[j] *= sigmoidf_(v0[j]); v1[j] *= sigmoidf_(v1[j]); }
                    }
                    v4u w; w.x = pk2(v0[0], v0[1]); w.y = pk2(v0[2], v0[3]); w.z = pk2(v1[0], v1[1]); w.w = pk2(v1[2], v1[3]);
                    __builtin_nontemporal_store(w, (v4u*)(rowp + bj * 128)); } }
    }
};
struct EpiMerge {
    static constexpr bool PERM = true, HAS_MID = true; static constexpr int MT = 3, AUXB = 0;
    const bf16* sga; const bf16* sgb; bf16* out;
    __device__ __forceinline__ void mid(f32x4 (&acc)[2][2][MT][2], const pg8::Unit& u, int wr, int wc, int fr, int fq) const {
        int row0 = u.pm * (64 * MT) + wr * (16 * MT) + fr, col0 = u.pn * 256 + wc * 32 + 8 * fq;
        asm volatile("" : "+v"(row0), "+v"(col0));
#pragma unroll
        for (int ai = 0; ai < 2; ++ai)
#pragma unroll
            for (int m = 0; m < MT; ++m) { const size_t off = (size_t)(row0 + ai * (32 * MT) + m * 16) * DM + col0;
#pragma unroll
                for (int bj = 0; bj < 2; ++bj) { const v4u a = *(const v4u*)(sga + off + bj * 128);
                    const f32x4 r0 = {bflo(a.x), bfhi(a.x), bflo(a.y), bfhi(a.y)}, r1 = {bflo(a.z), bfhi(a.z), bflo(a.w), bfhi(a.w)};
                    acc[ai][bj][m][0] *= r0; acc[ai][bj][m][1] *= r1;
                    asm volatile("" ::: "memory"); } }
    }
    __device__ __forceinline__ void operator()(const f32x4 (&acc)[2][2][MT][2], const pg8::Unit& u, int wr, int wc, int fr, int fq) const {
        const int row0 = u.pm * (64 * MT) + wr * (16 * MT) + fr, col0 = u.pn * 256 + wc * 32 + 8 * fq;
#pragma unroll
        for (int ai = 0; ai < 2; ++ai)
#pragma unroll
            for (int m = 0; m < MT; ++m) { const size_t off = (size_t)(row0 + ai * (32 * MT) + m * 16) * DM + col0;
#pragma unroll
                for (int bj = 0; bj < 2; ++bj) { const v4u b = *(const v4u*)(sgb + off + bj * 128);
                    const f32x4 v0 = acc[ai][bj][m][0], v1 = acc[ai][bj][m][1];
                    v4u w; w.x = pk2(v0[0] * bflo(b.x), v0[1] * bfhi(b.x)); w.y = pk2(v0[2] * bflo(b.y), v0[3] * bfhi(b.y));
                    w.z = pk2(v1[0] * bflo(b.z), v1[1] * bfhi(b.z)); w.w = pk2(v1[2] * bflo(b.w), v1[3] * bfhi(b.w));
                    *(v4u*)(out + off + bj * 128) = w; } }
    }
};
struct EpiOut {
    static constexpr bool PERM = false, HAS_MID = false; static constexpr int MT = 3, AUXB = 0;
    const float* xp; const float* xs; const float* mod; bf16* y; float* ssq;
    __device__ __forceinline__ void operator()(const f32x4 (&acc)[2][2][MT][2], const pg8::Unit& u, int wr, int wc, int fr, int fq) const {
        const int col0 = u.pn * 256 + wc * 32 + 4 * fq;
#pragma unroll
        for (int ai = 0; ai < 2; ++ai)
#pragma unroll
            for (int m = 0; m < MT; ++m) { const int row = u.pm * (64 * MT) + ai * (32 * MT) + wr * (16 * MT) + m * 16 + fr;
                const float* xr = (row < NPR) ? xp + (size_t)row * DM : xs + (size_t)(row - NPR) * DM;
                const int seq = (row < NPR) ? (row >> 12) : 2 + ((row - NPR) >> 3);
                const float* gp = mod + (size_t)seq * 12288 + 8192;
                float s = 0.f;
#pragma unroll
                for (int bj = 0; bj < 2; ++bj)
#pragma unroll
                    for (int n = 0; n < 2; ++n) { const int c = col0 + bj * 128 + n * 16;
                        const f32x4 xv = *(const f32x4*)(xr + c), gv = *(const f32x4*)(gp + c);
                        const f32x4 o = xv + gv * acc[ai][bj][m][n];
                        v2u w; w.x = pk2(o[0], o[1]); w.y = pk2(o[2], o[3]);
                        *(v2u*)(y + (size_t)row * DM + c) = w;
                        s += (o[0] * o[0] + o[1] * o[1]) + (o[2] * o[2] + o[3] * o[3]); }
                s += __shfl_xor(s, 16); s += __shfl_xor(s, 32);
                if (fq == 0) ssq[(size_t)row * 64 + u.pn * 4 + wc] = s;
            }
    }
};

struct Args { const float* in[19]; float* out; unsigned char* ws; int ph_lo, ph_hi, ph_rep, pad_; };
#define FIN(k) (A.in[k])
struct Frame {
    LAS unsigned char* lds;
    int tid, lane, wave, blk, G;
    float* out; unsigned char* ws;
};

#define SEQ_BARRIER() do { asm volatile("s_waitcnt lgkmcnt(0)" ::: "memory"); __builtin_amdgcn_s_barrier(); asm volatile("" ::: "memory"); } while (0)
template <bool NTS>
__device__ __forceinline__ void p0_transpose_item(const float* W, int ldw, int k0, int n_src0, bf16* WT, int ldt, int drow0, int koff, LAS float* scr, int lane) {
    f32x4 v[16];
    const float* wp = W + (size_t)(k0 + (lane >> 4)) * ldw + n_src0 + (lane & 15) * 4;
#pragma unroll
    for (int i = 0; i < 16; ++i) v[i] = __builtin_nontemporal_load((const f32x4*)(wp + (size_t)(4 * i) * ldw));
#pragma unroll
    for (int i = 0; i < 16; ++i) { LAS float* s = scr + (4 * i + (lane >> 4)) * 65 + (lane & 15) * 4; s[0] = v[i][0]; s[1] = v[i][1]; s[2] = v[i][2]; s[3] = v[i][3]; }
    LDS_WAIT(); asm volatile("" ::: "memory");
    const int c = lane & 7;
#pragma unroll
    for (int j = 0; j < 8; ++j) { const int n = (lane >> 3) + 8 * j; const LAS float* s = scr + (8 * c) * 65 + n;
        v4u o; o.x = pk2(s[0 * 65], s[1 * 65]); o.y = pk2(s[2 * 65], s[3 * 65]); o.z = pk2(s[4 * 65], s[5 * 65]); o.w = pk2(s[6 * 65], s[7 * 65]);
        if (NTS) __builtin_nontemporal_store(o, (v4u*)(WT + (size_t)(drow0 + n) * ldt + koff + k0 + 8 * c)); else *(v4u*)(WT + (size_t)(drow0 + n) * ldt + koff + k0 + 8 * c) = o; }
    LDS_WAIT(); asm volatile("" ::: "memory");
}
__device__ __forceinline__ void phase0(Frame& F, const Args& A) {
    const size_t gt = (size_t)F.blk * 512 + F.tid, NT = (size_t)F.G * 512;
    bf16* CS = (bf16*)(F.ws + WS_CS); const float* cp = FIN(5); const float* cs = FIN(6);
    for (size_t i = gt; i < (size_t)160 * DM / 4; i += NT) { const int row = (int)(i >> 10), c4 = (int)(i & 1023) * 4;
        f32x4 v = {0.f, 0.f, 0.f, 0.f};
        if (row < 2) v = *(const f32x4*)(cp + (size_t)row * DM + c4); else if (row < NMOD) v = *(const f32x4*)(cs + (size_t)(row - 2) * DM + c4);
        v2u o; o.x = pk2(v[0] * sigmoidf_(v[0]), v[1] * sigmoidf_(v[1])); o.y = pk2(v[2] * sigmoidf_(v[2]), v[3] * sigmoidf_(v[3]));
        *(v2u*)(CS + (size_t)row * DM + c4) = o; }
    { f32x4* z = (f32x4*)(F.ws + WS_MOD); const f32x4 zero = {0.f, 0.f, 0.f, 0.f}; for (size_t i = gt; i < (size_t)NMOD * 12288 / 4; i += NT) z[i] = zero; }
}
__device__ __forceinline__ void p1_modgemm(Frame& F, const Args& A) {
    const float* w_ada = FIN(7); const float* b_ada = FIN(8);
    const bf16* CS = (const bf16*)(F.ws + WS_CS); float* MOD = (float*)(F.ws + WS_MOD);
    const int kq = F.blk & 3, j = F.lane & 31, hh = F.lane >> 5;
    const int n0 = (F.blk >> 2) * 256 + F.wave * 32;
    f32x16 acc[5];
#pragma unroll
    for (int mt = 0; mt < 5; ++mt)
#pragma unroll
        for (int r = 0; r < 16; ++r) acc[mt][r] = 0.f;
    const float* wp = w_ada + (size_t)(kq * 1024 + 8 * hh) * 12288 + n0 + j;
    LAS unsigned char* AL = F.lds;
    constexpr int ALB = 160 * 144;
    const bf16* csp = CS + kq * 1024;
#define P1_ASTAGE_LOAD(dst, g) do { _Pragma("unroll") for (int i_ = 0; i_ < 3; ++i_) { int p_ = F.tid + 512 * i_; p_ = p_ < 1280 ? p_ : 1279; \
        dst[i_] = *(const GAS v4u*)((const GAS bf16*)csp + (size_t)(p_ >> 3) * DM + (g) * 64 + (p_ & 7) * 8); } } while (0)
#define P1_ASTAGE_WRITE(src, b) do { _Pragma("unroll") for (int i_ = 0; i_ < 3; ++i_) { int p_ = F.tid + 512 * i_; p_ = p_ < 1280 ? p_ : 1279; \
        *(LAS v4u*)(AL + (b) * ALB + (p_ >> 3) * 144 + (p_ & 7) * 16) = src[i_]; } } while (0)
    v4u sa[3];
    P1_ASTAGE_LOAD(sa, 0);
    asm volatile("" ::: "memory");
    float bA[32], bB[32];
    const GAS float* wu = (const GAS float*)w_ada + (size_t)(kq * 1024) * 12288 + n0;
    const int loff = (8 * hh) * 12288 + j;
#define P1_BLOAD(dst, g) do { const GAS float* wq_ = wu + (size_t)((g) * 64) * 12288; \
        _Pragma("unroll") for (int e = 0; e < 32; ++e) dst[e] = __builtin_nontemporal_load(wq_ + (size_t)((e >> 3) * 16 + (e & 7)) * 12288 + loff); } while (0)
#define P1_COMPUTE(bc, b) do { const LAS unsigned char* ab_ = AL + (b) * ALB + j * 144 + hh * 16; \
        _Pragma("unroll") for (int s4 = 0; s4 < 4; ++s4) { \
            v4u bw; bw.x = pk2(bc[8 * s4], bc[8 * s4 + 1]); bw.y = pk2(bc[8 * s4 + 2], bc[8 * s4 + 3]); bw.z = pk2(bc[8 * s4 + 4], bc[8 * s4 + 5]); bw.w = pk2(bc[8 * s4 + 6], bc[8 * s4 + 7]); \
            const bf16x8 bf = __builtin_bit_cast(bf16x8, bw); \
            _Pragma("unroll") for (int mt = 0; mt < 5; ++mt) { const bf16x8 af = *(const LAS bf16x8*)(ab_ + mt * 32 * 144 + s4 * 32); \
                acc[mt] = __builtin_amdgcn_mfma_f32_32x32x16_bf16(af, bf, acc[mt], 0, 0, 0); } \
            asm volatile("" ::: "memory"); } } while (0)
#define P1_HALF(bcur, bnext, bufcur, gnext) do { \
        P1_ASTAGE_LOAD(sa, gnext); asm volatile("" ::: "memory"); \
        P1_BLOAD(bnext, gnext); \
        asm volatile("s_waitcnt vmcnt(35)" ::: "memory"); \
        P1_COMPUTE(bcur, bufcur); \
        asm volatile("s_waitcnt vmcnt(32)" ::: "memory"); \
        P1_ASTAGE_WRITE(sa, (bufcur) ^ 1); \
        SEQ_BARRIER(); } while (0)
    P1_BLOAD(bA, 0);
    asm volatile("s_waitcnt vmcnt(32)" ::: "memory");
    P1_ASTAGE_WRITE(sa, 0);
    SEQ_BARRIER();
#pragma unroll 1
    for (int g4 = 0; g4 < 16; g4 += 2) {
        P1_HALF(bA, bB, 0, g4 + 1);
        { const int gn = (g4 + 2 < 16) ? g4 + 2 : 15; P1_HALF(bB, bA, 1, gn); }
    }
#undef P1_BLOAD
#undef P1_COMPUTE
#undef P1_HALF
#undef P1_ASTAGE_LOAD
#undef P1_ASTAGE_WRITE
    { const float bias = (kq == 0) ? b_ada[n0 + j] : 0.f;
#pragma unroll
      for (int mt = 0; mt < 5; ++mt)
#pragma unroll
          for (int r = 0; r < 16; ++r) { const int row = 32 * mt + (r & 3) + 8 * (r >> 2) + 4 * hh;
              if (row < NMOD) atomicAdd(MOD + (size_t)row * 12288 + n0 + j, acc[mt][r] + bias); } }
}
constexpr int CW_TRN = 1024, CW_TRN2 = 1088;
template <int WHICH>
__device__ __forceinline__ void transpose_queue(Frame& F, const Args& A, unsigned* ctr) {
    LAS float* scr = (LAS float*)(F.lds + F.wave * 16896);
    const float* w_in = FIN(10); const float* w_pa = FIN(15); const float* w_pb = FIN(16); const float* w_out = FIN(17);
    bf16* WB1 = (bf16*)(F.ws + WS_WB1); bf16* WB2 = (bf16*)(F.ws + WS_WB2); bf16* WB3 = (bf16*)(F.ws + WS_WB3);
    constexpr int I1 = 64 * 168, I2 = 64 * 128, IA = 32 * 64, IB = 32 * 64, IO = 64 * 64;
    constexpr int NITEMS = WHICH == 0 ? (I1 + I2) : (IA + IB + IO);
    volatile LAS unsigned* MISC = (volatile LAS unsigned*)(F.lds + MISC_OFF);
    for (;;) {
        __syncthreads();
        if (F.tid == 0) MISC[17] = __hip_atomic_fetch_add(ctr, 32u, __ATOMIC_RELAXED, __HIP_MEMORY_SCOPE_AGENT);
        __syncthreads();
        const int base = __builtin_amdgcn_readfirstlane((int)MISC[17]);
        if (base >= NITEMS) break;
#pragma unroll 1
        for (int i4 = 0; i4 < 4; ++i4) { const int it = base + i4 * 8 + F.wave; if (it >= NITEMS) break;
            int r = it;
            if (WHICH == 0) {
                if (r < I1) { const int kb = r / 168, nb = r % 168; p0_transpose_item<false>(w_in, PROJ, 64 * kb, 64 * nb, WB1, DM, 64 * nb, 0, scr, F.lane); continue; } r -= I1;
                { const int kb = r / 128, nb = r % 128, gsel = nb >> 6, nb2 = nb & 63;
                  p0_transpose_item<false>(w_in, PROJ, 64 * kb, 10768 + 64 * nb, WB1, DM, 10752 + 256 * (nb2 >> 1) + 128 * gsel + 64 * (nb2 & 1), 0, scr, F.lane); }
            } else {
                if (r < IA) { const int kb = r / 64, nb = r % 64; p0_transpose_item<true>(w_pa, DM, 64 * kb, 64 * nb, WB2, DM, 64 * nb, 0, scr, F.lane); continue; } r -= IA;
                if (r < IB) { const int kb = r / 64, nb = r % 64; p0_transpose_item<true>(w_pb, DM, 64 * kb, 64 * nb, WB2, DM, 64 * nb, 2048, scr, F.lane); continue; } r -= IB;
                { const int kb = r / 64, nb = r % 64; p0_transpose_item<true>(w_out, DM, 64 * kb, 64 * nb, WB3, DM, 64 * nb, 0, scr, F.lane); }
            }
        }
    }
}
__device__ __forceinline__ void phase1(Frame& F, const Args& A, unsigned* ctl) {
    if (F.blk < 192) p1_modgemm(F, A);
    transpose_queue<0>(F, A, ctl + CW_TRN);
    const float* w_in = FIN(10); bf16* WB1 = (bf16*)(F.ws + WS_WB1);
    const size_t gt = (size_t)F.blk * 512 + F.tid, NT = (size_t)F.G * 512;
    for (size_t i = gt; i < (size_t)16 * DM; i += NT) { const int k = (int)(i >> 4), j = (int)(i & 15); WB1[(size_t)(18944 + j) * DM + k] = f2bf(w_in[(size_t)k * PROJ + 10752 + j]); }
    { v4u* z = (v4u*)(WB1 + (size_t)18960 * DM); const v4u zero = {0u, 0u, 0u, 0u}; for (size_t i = gt; i < (size_t)240 * DM * 2 / 16; i += NT) z[i] = zero; }
}

__device__ __forceinline__ const float* xrow_ptr(const float* xp, const float* xs, int row) { return (row < NPR) ? xp + (size_t)row * DM : xs + (size_t)(row - NPR) * DM; }
__device__ __forceinline__ int wave_rows(int nrow, int gw, int ngw, int& extra) {
    const int nfull = nrow / ngw, rem = nrow % ngw;
    const int e0 = (int)(((long)gw * rem) / ngw), e1 = (int)(((long)(gw + 1) * rem) / ngw);
    extra = (e1 > e0) ? nfull * ngw + e0 : -1;
    return nfull + (e1 > e0 ? 1 : 0);
}
__device__ __forceinline__ void phase2(Frame& F, const Args& A) {
    const float* xp = FIN(0); const float* xs = FIN(1); const float* ng = FIN(9);
    const float* MOD = (const float*)(F.ws + WS_MOD); bf16* H = (bf16*)(F.ws + WS_H);
    const int gw = F.blk * NWAVES + F.wave, NGW = F.G * NWAVES, lane = F.lane;
    LAS float* G1s = (LAS float*)F.lds; LAS float* SHs = (LAS float*)(F.lds + 32768);
    __syncthreads();
    for (int i = F.tid; i < 2048; i += 512) { const int sq = i >> 10, c = (i & 1023) * 4;
        const f32x4 g = *(const f32x4*)(ng + c), a = *(const f32x4*)(MOD + (size_t)sq * 12288 + 4096 + c), b = *(const f32x4*)(MOD + (size_t)sq * 12288 + c);
        *(LAS f32x4*)(G1s + sq * 4096 + c) = g * (a + 1.0f); *(LAS f32x4*)(SHs + sq * 4096 + c) = b; }
    __syncthreads();
    int extra; const int nr = wave_rows(NROW, gw, NGW, extra);
    if (nr == 0) return;
    const int nfull = NROW / NGW;
    auto rowof = [&](int i) { const int ic = (i < nr) ? i : nr - 1; return (ic < nfull) ? gw + ic * NGW : extra; };
    auto process = [&](const f32x4 (&v)[16], int row) {
        float s = 0.f;
#pragma unroll
        for (int q = 0; q < 16; ++q) s += (v[q][0] * v[q][0] + v[q][1] * v[q][1]) + (v[q][2] * v[q][2] + v[q][3] * v[q][3]);
        const float rstd = rsqrtf(wave_sum(s) * (1.0f / DM) + EPS);
        if (row < NPR) {
            const int sq = row >> 12;
#pragma unroll
            for (int q = 0; q < 16; ++q) { const int c = 4 * (lane + 64 * q);
                const f32x4 g1 = *(const LAS f32x4*)(G1s + sq * 4096 + c), b = *(const LAS f32x4*)(SHs + sq * 4096 + c);
                const f32x4 h = (v[q] * rstd) * g1 + b;
                v2u o; o.x = pk2(h[0], h[1]); o.y = pk2(h[2], h[3]);
                *(v2u*)(H + (size_t)row * DM + c) = o; }
        } else {
            const int seq = 2 + ((row - NPR) >> 3);
            const float* sh = MOD + (size_t)seq * 12288; const float* sc = sh + 4096;
#pragma unroll
            for (int q = 0; q < 16; ++q) { const int c = 4 * (lane + 64 * q);
                const f32x4 g = *(const f32x4*)(ng + c), a = *(const f32x4*)(sc + c), b = *(const f32x4*)(sh + c);
                const f32x4 h = (v[q] * rstd * g) * (a + 1.0f) + b;
                v2u o; o.x = pk2(h[0], h[1]); o.y = pk2(h[2], h[3]);
                *(v2u*)(H + (size_t)row * DM + c) = o;
                if ((q & 3) == 3) asm volatile("" ::: "memory"); }
        }
    };
#define P2_LOAD(dst, r) do { const float* xr_ = xrow_ptr(xp, xs, (r)) + 4 * lane; _Pragma("unroll") for (int q = 0; q < 16; ++q) dst[q] = __builtin_nontemporal_load((const f32x4*)(xr_ + 256 * q)); } while (0)
    f32x4 va[16], vb[16];
    P2_LOAD(va, rowof(0));
    int i = 0;
#pragma unroll 1
    for (; i + 1 < nr; i += 2) {
        P2_LOAD(vb, rowof(i + 1));
        process(va, rowof(i));
        P2_LOAD(va, rowof(i + 2));
        process(vb, rowof(i + 1));
    }
    if (i < nr) process(va, rowof(i));
#undef P2_LOAD
}

#define MFMA16(a, b, c) __builtin_amdgcn_mfma_f32_16x16x32_bf16((a), (b), (c), 0, 0, 0)

constexpr int SWA_VS = 280;
__device__ __forceinline__ void swa_prompt_unit(Frame& F, const Args& A, int unit) {
    const int b = unit >> 7, i = (unit >> 2) & 31, g = unit & 3;
    const bf16* QA = (const bf16*)(F.ws + WS_QA); const bf16* KA = (const bf16*)(F.ws + WS_KA); const bf16* VA = (const bf16*)(F.ws + WS_VA);
    const bf16* ZA = (const bf16*)(F.ws + WS_ZA); bf16* AB = (bf16*)(F.ws + WS_AB);
    LAS unsigned char* Ks = F.lds;
    LAS bf16* VTs = (LAS bf16*)(F.lds + 36864);
    __syncthreads();
#pragma unroll
    for (int q = 0; q < 4; ++q) { const int p = F.tid + 512 * q, row = p >> 3, c = p & 7; const int tok = (i - 1) * 128 + row;
        v4u kv = {0u, 0u, 0u, 0u}, vv = {0u, 0u, 0u, 0u};
        if (tok >= 0) { const size_t off = (size_t)(b * SEQ + tok) * 256 + g * 64 + c * 8; kv = *(const v4u*)(KA + off); vv = *(const v4u*)(VA + off); }
        *(LAS v4u*)(Ks + row * 144 + c * 16) = kv;
        LAS bf16* vt = VTs + (c * 8) * SWA_VS + row;
        vt[0 * SWA_VS] = (bf16)(vv.x & 0xffff); vt[1 * SWA_VS] = (bf16)(vv.x >> 16); vt[2 * SWA_VS] = (bf16)(vv.y & 0xffff); vt[3 * SWA_VS] = (bf16)(vv.y >> 16);
        vt[4 * SWA_VS] = (bf16)(vv.z & 0xffff); vt[5 * SWA_VS] = (bf16)(vv.z >> 16); vt[6 * SWA_VS] = (bf16)(vv.w & 0xffff); vt[7 * SWA_VS] = (bf16)(vv.w >> 16); }
    if (F.tid < 192) { const int d = F.tid / 3, q = F.tid % 3; *(LAS v4u*)(VTs + d * SWA_VS + 256 + 8 * q) = (v4u){0u, 0u, 0u, 0u}; }
    __syncthreads();
    const int hq = g * 8 + F.wave, c = F.lane & 15, gg = F.lane >> 4;
    const float sink = FIN(11)[hq];
    const size_t qbase = (size_t)b * SEQ + i * 128;
    bf16x8 bq[2], bqn[2];
#pragma unroll
    for (int ks = 0; ks < 2; ++ks) bq[ks] = *(const bf16x8*)(QA + (qbase + c) * 2048 + hq * 64 + ks * 32 + 8 * gg);
#pragma unroll 1
    for (int sub = 0; sub < 8; ++sub) {
        const size_t qrow = qbase + sub * 16 + c;
        { const int sn = (sub < 7) ? sub + 1 : sub;
#pragma unroll
          for (int ks = 0; ks < 2; ++ks) bqn[ks] = *(const bf16x8*)(QA + (qbase + sn * 16 + c) * 2048 + hq * 64 + ks * 32 + 8 * gg); }
        v2u zaw[4];
#pragma unroll
        for (int nt = 0; nt < 4; ++nt) zaw[nt] = *(const v2u*)(ZA + qrow * 2048 + hq * 64 + 16 * nt + 4 * gg);
        f32x4 s[10];
        const LAS unsigned char* kp = Ks + (16 * sub + c) * 144 + 16 * gg;
#pragma unroll
        for (int x = 0; x < 9; ++x) { f32x4 a = {0.f, 0.f, 0.f, 0.f};
#pragma unroll
            for (int ks = 0; ks < 2; ++ks) { const bf16x8 ak = *(const LAS bf16x8*)(kp + x * 16 * 144 + ks * 64); a = MFMA16(ak, bq[ks], a); }
            s[x] = a; if ((x & 3) == 3) asm volatile("" ::: "memory"); }
        s[9] = (f32x4){0.f, 0.f, 0.f, 0.f};
        float m = sink;
#pragma unroll
        for (int x = 0; x < 9; ++x) { const bool tile_ok = (i > 0) || (sub + x >= 8);
#pragma unroll
            for (int r = 0; r < 4; ++r) { bool valid = tile_ok; if (x == 0) valid = valid && (4 * gg + r >= c); if (x == 8) valid = valid && (4 * gg + r <= c);
                const float v = valid ? s[x][r] * 0.125f : -1e30f; s[x][r] = v; m = fmaxf(m, v); } }
        m = fmaxf(m, __shfl_xor(m, 16)); m = fmaxf(m, __shfl_xor(m, 32));
        float sum = 0.f;
#pragma unroll
        for (int x = 0; x < 9; ++x)
#pragma unroll
            for (int r = 0; r < 4; ++r) { const float p = (s[x][r] > -1e29f) ? __expf(s[x][r] - m) : 0.f; s[x][r] = p; sum += p; }
        sum += __shfl_xor(sum, 16); sum += __shfl_xor(sum, 32);
        const float inv = 1.0f / (sum + __expf(sink - m));
        f32x4 o[4];
#pragma unroll
        for (int nt = 0; nt < 4; ++nt) o[nt] = (f32x4){0.f, 0.f, 0.f, 0.f};
        const LAS bf16* vbase = VTs + c * SWA_VS + 16 * sub + 4 * gg;
#pragma unroll
        for (int jp = 0; jp < 5; ++jp) { v4u pw; pw.x = pk2(s[2 * jp][0], s[2 * jp][1]); pw.y = pk2(s[2 * jp][2], s[2 * jp][3]); pw.z = pk2(s[2 * jp + 1][0], s[2 * jp + 1][1]); pw.w = pk2(s[2 * jp + 1][2], s[2 * jp + 1][3]);
            const bf16x8 pb = __builtin_bit_cast(bf16x8, pw);
#pragma unroll
            for (int nt = 0; nt < 4; ++nt) { const LAS bf16* vp = vbase + 16 * nt * SWA_VS + 32 * jp;
                const v2u v0 = *(const LAS v2u*)(vp), v1 = *(const LAS v2u*)(vp + 16);
                v4u vw; vw.x = v0.x; vw.y = v0.y; vw.z = v1.x; vw.w = v1.y;
                o[nt] = MFMA16(__builtin_bit_cast(bf16x8, vw), pb, o[nt]); }
            asm volatile("" ::: "memory"); }
#pragma unroll
        for (int nt = 0; nt < 4; ++nt) { v2u w; w.x = pk2(o[nt][0] * inv * bflo(zaw[nt].x), o[nt][1] * inv * bfhi(zaw[nt].x)); w.y = pk2(o[nt][2] * inv * bflo(zaw[nt].y), o[nt][3] * inv * bfhi(zaw[nt].y));
            *(v2u*)(AB + qrow * DM + hq * 64 + 16 * nt + 4 * gg) = w; }
        bq[0] = bqn[0]; bq[1] = bqn[1];
    }
}

__device__ __forceinline__ void swa_sample_unit(Frame& F, const Args& A, int unit) {
    const int n = unit >> 2, g = unit & 3;
    const bf16* QA = (const bf16*)(F.ws + WS_QA); const bf16* KA = (const bf16*)(F.ws + WS_KA); const bf16* VA = (const bf16*)(F.ws + WS_VA);
    const bf16* ZA = (const bf16*)(F.ws + WS_ZA); bf16* AB = (bf16*)(F.ws + WS_AB);
    const float* ck = FIN(2); const float* cv = FIN(3);
    LAS unsigned char* Ks = F.lds;
    LAS bf16* VTs = (LAS bf16*)(F.lds + 23040);
    const int hq = g * 8 + F.wave, c = F.lane & 15, gg = F.lane >> 4, tq = c & 7;
    const size_t qrow0 = (size_t)NPR + n * 8;
    bf16x8 bq[2]; v2u zaw[4];
#pragma unroll
    for (int ks = 0; ks < 2; ++ks) bq[ks] = *(const bf16x8*)(QA + (qrow0 + tq) * 2048 + hq * 64 + ks * 32 + 8 * gg);
#pragma unroll
    for (int nt = 0; nt < 4; ++nt) zaw[nt] = *(const v2u*)(ZA + (qrow0 + tq) * 2048 + hq * 64 + 16 * nt + 4 * gg);
    __syncthreads();
#pragma unroll
    for (int q = 0; q < 4; ++q) { const int p = F.tid + 512 * q, row = p >> 4, c4 = p & 15;
        const size_t off = ((size_t)(n * 128 + row) * 4 + g) * 64 + c4 * 4;
        const f32x4 kv = *(const f32x4*)(ck + off), vv = *(const f32x4*)(cv + off);
        v2u kw; kw.x = pk2(kv[0], kv[1]); kw.y = pk2(kv[2], kv[3]);
        *(LAS v2u*)(Ks + row * 144 + c4 * 8) = kw;
        LAS bf16* vt = VTs + (c4 * 4) * 168 + row;
        vt[0] = f2bf(vv[0]); vt[168] = f2bf(vv[1]); vt[336] = f2bf(vv[2]); vt[504] = f2bf(vv[3]);
        if (row >= 8) { const size_t oo = ((size_t)(n * 128 + row - 8) * 4 + g) * 64 + c4 * 4; *(f32x4*)(F.out + OUT_KWS + oo) = kv; *(f32x4*)(F.out + OUT_VWS + oo) = vv; } }
    if (F.tid < 256) { const int row = 128 + (F.tid >> 3), c = F.tid & 7;
        v4u kv = {0u, 0u, 0u, 0u}, vv = {0u, 0u, 0u, 0u};
        if (row < 136) { const size_t off = (size_t)(NPR + n * 8 + row - 128) * 256 + g * 64 + c * 8; kv = *(const v4u*)(KA + off); vv = *(const v4u*)(VA + off);
            const size_t oo = ((size_t)(n * 128 + row - 8) * 4 + g) * 64 + c * 8;
            *(f32x4*)(F.out + OUT_KWS + oo) = (f32x4){bflo(kv.x), bfhi(kv.x), bflo(kv.y), bfhi(kv.y)}; *(f32x4*)(F.out + OUT_KWS + oo + 4) = (f32x4){bflo(kv.z), bfhi(kv.z), bflo(kv.w), bfhi(kv.w)};
            *(f32x4*)(F.out + OUT_VWS + oo) = (f32x4){bflo(vv.x), bfhi(vv.x), bflo(vv.y), bfhi(vv.y)}; *(f32x4*)(F.out + OUT_VWS + oo + 4) = (f32x4){bflo(vv.z), bfhi(vv.z), bflo(vv.w), bfhi(vv.w)}; }
        *(LAS v4u*)(Ks + row * 144 + c * 16) = kv;
        LAS bf16* vt = VTs + (c * 8) * 168 + row;
        vt[0 * 168] = (bf16)(vv.x & 0xffff); vt[1 * 168] = (bf16)(vv.x >> 16); vt[2 * 168] = (bf16)(vv.y & 0xffff); vt[3 * 168] = (bf16)(vv.y >> 16);
        vt[4 * 168] = (bf16)(vv.z & 0xffff); vt[5 * 168] = (bf16)(vv.z >> 16); vt[6 * 168] = (bf16)(vv.w & 0xffff); vt[7 * 168] = (bf16)(vv.w >> 16); }
    __syncthreads();
    const float sink = FIN(11)[hq];
    f32x4 s[10];
#pragma unroll
    for (int kt = 0; kt < 10; ++kt) { f32x4 a = {0.f, 0.f, 0.f, 0.f};
#pragma unroll
        for (int ks = 0; ks < 2; ++ks) { const bf16x8 ak = *(const LAS bf16x8*)(Ks + (16 * kt + c) * 144 + (ks * 32 + 8 * gg) * 2); a = MFMA16(ak, bq[ks], a); }
        s[kt] = a; if ((kt & 3) == 3) asm volatile("" ::: "memory"); }
    float m = sink;
#pragma unroll
    for (int kt = 0; kt < 10; ++kt)
#pragma unroll
        for (int r = 0; r < 4; ++r) { const int kk = 16 * kt + 4 * gg + r; const bool valid = (kk >= tq) && (kk <= tq + 128) && (kk < 136);
            const float v = valid ? s[kt][r] * 0.125f : -1e30f; s[kt][r] = v; m = fmaxf(m, v); }
    m = fmaxf(m, __shfl_xor(m, 16)); m = fmaxf(m, __shfl_xor(m, 32));
    float sum = 0.f;
#pragma unroll
    for (int kt = 0; kt < 10; ++kt)
#pragma unroll
        for (int r = 0; r < 4; ++r) { const float p = (s[kt][r] > -1e29f) ? __expf(s[kt][r] - m) : 0.f; s[kt][r] = p; sum += p; }
    sum += __shfl_xor(sum, 16); sum += __shfl_xor(sum, 32);
    const float inv = 1.0f / (sum + __expf(sink - m));
    f32x4 o[4];
#pragma unroll
    for (int nt = 0; nt < 4; ++nt) o[nt] = (f32x4){0.f, 0.f, 0.f, 0.f};
#pragma unroll
    for (int j = 0; j < 5; ++j) { v4u pw; pw.x = pk2(s[2 * j][0], s[2 * j][1]); pw.y = pk2(s[2 * j][2], s[2 * j][3]); pw.z = pk2(s[2 * j + 1][0], s[2 * j + 1][1]); pw.w = pk2(s[2 * j + 1][2], s[2 * j + 1][3]);
        const bf16x8 pa = __builtin_bit_cast(bf16x8, pw);
#pragma unroll
        for (int nt = 0; nt < 4; ++nt) { const LAS bf16* vp = VTs + (16 * nt + c) * 168 + 32 * j + 4 * gg;
            const v2u v0 = *(const LAS v2u*)(vp), v1 = *(const LAS v2u*)(vp + 16);
            v4u vw; vw.x = v0.x; vw.y = v0.y; vw.z = v1.x; vw.w = v1.y;
            o[nt] = MFMA16(__builtin_bit_cast(bf16x8, vw), pa, o[nt]); }
        asm volatile("" ::: "memory"); }
    if (c < 8) {
#pragma unroll
        for (int nt = 0; nt < 4; ++nt) { v2u w; w.x = pk2(o[nt][0] * inv * bflo(zaw[nt].x), o[nt][1] * inv * bfhi(zaw[nt].x)); w.y = pk2(o[nt][2] * inv * bflo(zaw[nt].y), o[nt][3] * inv * bfhi(zaw[nt].y));
            *(v2u*)(AB + (qrow0 + c) * DM + hq * 64 + 16 * nt + 4 * gg) = w; } }
}

__device__ __forceinline__ float log_sigmoid_(float x) { return fminf(x, 0.f) - __logf(1.0f + __expf(-fabsf(x))); }

__device__ __forceinline__ void gla_prep_unit(Frame& F, const Args& A, int unit) {
    const int n = unit >> 8, h = (unit >> 6) & 3, ch = unit & 63;
    const size_t row0 = (size_t)n * SEQ + ch * 64;
    const bf16* QB = (const bf16*)(F.ws + WS_QB); const bf16* KB = (const bf16*)(F.ws + WS_KB); const bf16* VB = (const bf16*)(F.ws + WS_VB);
    const float* R = (const float*)(F.ws + WS_R); const float* w2 = FIN(12); const float* ba = FIN(13);
    bf16* QT = (bf16*)(F.ws + WS_QT) + (size_t)unit * 64 * 256; bf16* KDT = (bf16*)(F.ws + WS_KDT) + (size_t)unit * 256 * 64;
    bf16* ATT = (bf16*)(F.ws + WS_ATT) + (size_t)unit * 64 * 64; bf16* VT = (bf16*)(F.ws + WS_VT) + (size_t)unit * 512 * 64; float* DEC = (float*)(F.ws + WS_DEC) + (size_t)unit * 256;
    LAS float* Rs = (LAS float*)F.lds;
    LAS float* TOT = (LAS float*)(F.lds + 4096);
    LAS unsigned char* Vs = F.lds + 8192;
    LAS bf16* QS = (LAS bf16*)(F.lds + 8192);
    LAS bf16* KS = (LAS bf16*)(F.lds + 8192 + 33792);
    LAS float* BS = (LAS float*)(F.lds + 8192 + 67584);
    int tz = F.tid; asm volatile("" : "+v"(tz));
    v4u vreg[8], qreg[4], kreg[4]; f32x4 rreg = {0.f, 0.f, 0.f, 0.f};
#pragma unroll
    for (int q = 0; q < 8; ++q) { const int p = tz + 512 * q, row = p >> 6, c = p & 63; vreg[q] = *(const v4u*)(VB + (row0 + row) * 2048 + h * 512 + c * 8); }
#pragma unroll
    for (int q = 0; q < 4; ++q) { const int p = tz + 512 * q, row = p >> 5, c = p & 31; const size_t off = (row0 + row) * 1024 + h * 256 + c * 8; qreg[q] = *(const v4u*)(QB + off); kreg[q] = *(const v4u*)(KB + off); }
    if (tz < 256) rreg = *(const f32x4*)(R + row0 * 16 + tz * 4);
    __syncthreads();
    if (tz < 256) *(LAS f32x4*)(Rs + tz * 4) = rreg;
#pragma unroll
    for (int q = 0; q < 8; ++q) { const int p = tz + 512 * q, row = p >> 6, c = p & 63; *(LAS v4u*)(Vs + row * 1040 + c * 16) = vreg[q]; }
    __syncthreads();
    { const LAS bf16* vcol = (const LAS bf16*)Vs + tz;
#pragma unroll
      for (int t8 = 0; t8 < 8; ++t8) { unsigned e[8];
#pragma unroll
          for (int k = 0; k < 8; ++k) e[k] = vcol[(t8 * 8 + k) * 520];
          v4u o; o.x = e[0] | (e[1] << 16); o.y = e[2] | (e[3] << 16); o.z = e[4] | (e[5] << 16); o.w = e[6] | (e[7] << 16);
          *(v4u*)(VT + (size_t)tz * 64 + t8 * 8) = o; } }
    const int dk = tz & 255, half = tz >> 8;
    { float wv[16];
#pragma unroll
      for (int j = 0; j < 16; ++j) wv[j] = w2[j * 1024 + h * 256 + dk];
      const float bias = ba[h * 256 + dk];
      float run = 0.f;
#pragma unroll 4
      for (int tt = 0; tt < 32; ++tt) { const int t = half * 32 + tt; const LAS float* rr = Rs + t * 16; float x = bias;
#pragma unroll
          for (int j4 = 0; j4 < 4; ++j4) { const f32x4 rv = *(const LAS f32x4*)(rr + 4 * j4); x += rv[0] * wv[4 * j4] + rv[1] * wv[4 * j4 + 1] + rv[2] * wv[4 * j4 + 2] + rv[3] * wv[4 * j4 + 3]; }
          run += log_sigmoid_(x) * 0.0625f; BS[t * 256 + dk] = run; }
      TOT[half * 256 + dk] = run; }
    __syncthreads();
#pragma unroll
    for (int q = 0; q < 4; ++q) { const int p = tz + 512 * q, row = p >> 5, c = p & 31; *(LAS v4u*)(QS + row * 264 + c * 8) = qreg[q]; *(LAS v4u*)(KS + row * 264 + c * 8) = kreg[q]; }
    __syncthreads();
    { const float tot0 = TOT[dk], tot1 = TOT[256 + dk];
      const float off = half ? tot0 : 0.f, blast = tot0 + tot1;
#pragma unroll 1
      for (int q8 = 0; q8 < 4; ++q8) { unsigned kd[4];
#pragma unroll
          for (int e = 0; e < 8; ++e) { const int t = half * 32 + q8 * 8 + e;
              const float b = BS[t * 256 + dk] + off;
              const float q = bf2f(QS[t * 264 + dk]), k = bf2f(KS[t * 264 + dk]);
              const bf16 qt = f2bf(q * __expf(b) * 0.0625f), kt = f2bf(k * __expf(-b)); const unsigned kdv = f2bf(k * __expf(blast - b));
              QS[t * 264 + dk] = qt; KS[t * 264 + dk] = kt;
              if (e & 1) kd[e >> 1] |= kdv << 16; else kd[e >> 1] = kdv; }
          v4u o; o.x = kd[0]; o.y = kd[1]; o.z = kd[2]; o.w = kd[3]; *(v4u*)(KDT + (size_t)dk * 64 + half * 32 + 8 * q8) = o; }
      if (half == 0) DEC[dk] = __expf(blast); }
    __syncthreads();
#pragma unroll
    for (int q = 0; q < 4; ++q) { const int p = tz + 512 * q, t = p >> 5, c = p & 31, jb = c >> 2, g4 = c & 3;
        const LAS bf16* sp = QS + t * 264 + 32 * jb + 4 * g4;
        const v2u lo = *(const LAS v2u*)(sp), hi = *(const LAS v2u*)(sp + 16);
        v4u o; o.x = lo.x; o.y = lo.y; o.z = hi.x; o.w = hi.y;
        *(v4u*)(QT + (size_t)t * 256 + c * 8) = o; }
    { const int c = tz & 15, gg = (tz >> 4) & 3;
#pragma unroll
      for (int x = 0; x < 2; ++x) { const int id = F.wave * 2 + x, ti = id >> 2, si = id & 3;
          f32x4 a = {0.f, 0.f, 0.f, 0.f};
          if (si <= ti) {
#pragma unroll
              for (int ks = 0; ks < 8; ++ks) { const bf16x8 ak = *(const LAS bf16x8*)(KS + (16 * si + c) * 264 + ks * 32 + 8 * gg), bqv = *(const LAS bf16x8*)(QS + (16 * ti + c) * 264 + ks * 32 + 8 * gg);
                  a = MFMA16(ak, bqv, a); } }
          const int t = 16 * ti + c, s0 = 16 * si + 4 * gg;
          v2u o; o.x = pk2(s0 <= t ? a[0] : 0.f, s0 + 1 <= t ? a[1] : 0.f); o.y = pk2(s0 + 2 <= t ? a[2] : 0.f, s0 + 3 <= t ? a[3] : 0.f);
          *(v2u*)(ATT + (size_t)t * 64 + s0) = o; } }
}

__device__ __forceinline__ void win_prompt(Frame& F, const Args& A) {
    const bf16* KA = (const bf16*)(F.ws + WS_KA); const bf16* VA = (const bf16*)(F.ws + WS_VA);
    const size_t gt = (size_t)F.blk * 512 + F.tid, NT = (size_t)F.G * 512;
    for (size_t i = gt; i < 65536; i += NT) { const int b = (int)(i >> 15), rem = (int)(i & 32767); const size_t src = (size_t)(b * SEQ + SEQ - 128) * 256 + rem;
        F.out[OUT_KWP + i] = bf2f(KA[src]); F.out[OUT_VWP + i] = bf2f(VA[src]); }
}

constexpr int SEQ_QT = 0, SEQ_KD = 32768, SEQ_AT = 65536, SEQ_DC = 73728, SEQ_BUF = 74752;
constexpr int SEQ_CW = 2;
constexpr int SEQ_DVG = 512 / (16 * SEQ_CW);
__device__ __forceinline__ void gla_seq_unit(Frame& F, const Args& A, int unit) {
    const int nh = unit & 7, dvg = unit >> 3, n = nh >> 2, h = nh & 3;
    const bf16* QTg = (const bf16*)(F.ws + WS_QT) + (size_t)nh * 64 * 16384;
    const bf16* KDg = (const bf16*)(F.ws + WS_KDT) + (size_t)nh * 64 * 16384;
    const bf16* ATg = (const bf16*)(F.ws + WS_ATT) + (size_t)nh * 64 * 4096;
    const float* DCg = (const float*)(F.ws + WS_DEC) + (size_t)nh * 64 * 256;
    const bf16* VTg = (const bf16*)(F.ws + WS_VT) + (size_t)nh * 64 * 32768;
    __syncthreads();
    if (F.wave >= 4) {
        const int lt = F.tid - 256;
        v4u rq[2][8], rk[2][8], ra[2][2]; f32x4 rd[2] = {{0.f, 0.f, 0.f, 0.f}, {0.f, 0.f, 0.f, 0.f}};
#define SEQ_LOAD(sx, chx) do { const bf16* q_ = QTg + (size_t)(chx) * 16384; const bf16* k_ = KDg + (size_t)(chx) * 16384; const bf16* a_ = ATg + (size_t)(chx) * 4096; \
        _Pragma("unroll") for (int i = 0; i < 8; ++i) { rq[sx][i] = *(const v4u*)(q_ + (size_t)(lt + 256 * i) * 8); rk[sx][i] = *(const v4u*)(k_ + (size_t)(lt + 256 * i) * 8); } \
        _Pragma("unroll") for (int i = 0; i < 2; ++i) ra[sx][i] = *(const v4u*)(a_ + (size_t)(lt + 256 * i) * 8); \
        if (lt < 64) rd[sx] = *(const f32x4*)(DCg + (size_t)(chx) * 256 + lt * 4); } while (0)
#define SEQ_WRITE(sx, bufx) do { LAS unsigned char* b_ = F.lds + (bufx) * SEQ_BUF; \
        _Pragma("unroll") for (int i = 0; i < 8; ++i) { const int p = lt + 256 * i; \
            { const int row = p >> 5, slot = p & 31; *(LAS v4u*)(b_ + SEQ_QT + row * 512 + ((slot ^ (row & 15)) << 4)) = rq[sx][i]; } \
            { const int row = p >> 3, slot = p & 7;  *(LAS v4u*)(b_ + SEQ_KD + row * 128 + ((slot ^ ((row >> 1) & 7)) << 4)) = rk[sx][i]; } } \
        _Pragma("unroll") for (int i = 0; i < 2; ++i) { const int p = lt + 256 * i, row = p >> 3, slot = p & 7; *(LAS v4u*)(b_ + SEQ_AT + row * 128 + ((slot ^ ((row >> 1) & 7)) << 4)) = ra[sx][i]; } \
        if (lt < 64) *(LAS f32x4*)(b_ + SEQ_DC + lt * 16) = rd[sx]; } while (0)
        SEQ_LOAD(0, 0); SEQ_WRITE(0, 0); SEQ_LOAD(1, 1); SEQ_LOAD(0, 2);
        SEQ_BARRIER();
        for (int ch = 0; ch < 64; ch += 2) {
            SEQ_WRITE(1, 1); if (ch + 3 < 64) SEQ_LOAD(1, ch + 3);
            SEQ_BARRIER();
            if (ch + 2 < 64) { SEQ_WRITE(0, 0); if (ch + 4 < 64) SEQ_LOAD(0, ch + 4); }
            SEQ_BARRIER();
        }
#undef SEQ_LOAD
#undef SEQ_WRITE
    } else if (F.wave >= SEQ_CW) {
        for (int ch = 0; ch < 65; ++ch) SEQ_BARRIER();
    } else {
        const int c = F.lane & 15, gg = F.lane >> 4, sa = (c >> 1) & 7;
        const int dv0 = dvg * (16 * SEQ_CW) + F.wave * 16;
        float* OB = (float*)(F.ws + WS_OB);
        f32x4 S[16];
#pragma unroll
        for (int i = 0; i < 16; ++i) S[i] = (f32x4){0.f, 0.f, 0.f, 0.f};
        const bf16* vtp = VTg + (size_t)(dv0 + c) * 64 + 8 * gg;
        bf16x8 vf[2], vn[2];
#pragma unroll
        for (int j = 0; j < 2; ++j) vf[j] = *(const bf16x8*)(vtp + 32 * j);
        SEQ_BARRIER();
        for (int ch = 0; ch < 64; ++ch) {
            const LAS unsigned char* b_ = F.lds + (ch & 1) * SEQ_BUF;
            { const int cn = (ch + 1 < 64) ? ch + 1 : ch;
#pragma unroll
              for (int j = 0; j < 2; ++j) vn[j] = *(const bf16x8*)(vtp + (size_t)cn * 32768 + 32 * j); }
#define SEQ_LDQ(dst, jx) do { _Pragma("unroll") for (int mt = 0; mt < 4; ++mt) dst[mt] = *(const LAS bf16x8*)(b_ + SEQ_QT + (16 * mt + c) * 512 + (((4 * (jx) + gg) ^ c) << 4)); } while (0)
#define SEQ_LDK(kd_, dd_, gx) do { _Pragma("unroll") for (int e = 0; e < 2; ++e) { dd_[e] = *(const LAS f32x4*)(b_ + SEQ_DC + (16 * (2 * (gx) + e) + 4 * gg) * 4); \
            _Pragma("unroll") for (int j = 0; j < 2; ++j) kd_[e][j] = *(const LAS bf16x8*)(b_ + SEQ_KD + (16 * (2 * (gx) + e) + c) * 128 + (((4 * j + gg) ^ sa) << 4)); } } while (0)
            f32x4 o[4];
            bf16x8 af[4][2], qf[2][4];
#pragma unroll
            for (int mt = 0; mt < 4; ++mt)
#pragma unroll
                for (int j = 0; j < 2; ++j) af[mt][j] = *(const LAS bf16x8*)(b_ + SEQ_AT + (16 * mt + c) * 128 + (((4 * j + gg) ^ sa) << 4));
            SEQ_LDQ(qf[0], 0);
            __builtin_amdgcn_sched_barrier(0);
#pragma unroll
            for (int mt = 0; mt < 4; ++mt) { f32x4 a = {0.f, 0.f, 0.f, 0.f}; a = MFMA16(af[mt][0], vf[0], a); a = MFMA16(af[mt][1], vf[1], a); o[mt] = a; }
            bf16x8 kf[2][2][2]; f32x4 dd[2][2];
#pragma unroll
            for (int j = 0; j < 8; ++j) {
                if (j < 7) SEQ_LDQ(qf[(j + 1) & 1], j + 1); else SEQ_LDK(kf[0], dd[0], 0);
                v4u sw; sw.x = pk2(S[2 * j][0], S[2 * j][1]); sw.y = pk2(S[2 * j][2], S[2 * j][3]); sw.z = pk2(S[2 * j + 1][0], S[2 * j + 1][1]); sw.w = pk2(S[2 * j + 1][2], S[2 * j + 1][3]);
                const bf16x8 sb = __builtin_bit_cast(bf16x8, sw);
                __builtin_amdgcn_sched_barrier(0);
#pragma unroll
                for (int mt = 0; mt < 4; ++mt) o[mt] = MFMA16(qf[j & 1][mt], sb, o[mt]);
                __builtin_amdgcn_sched_barrier(0);
            }
#pragma unroll
            for (int g2 = 0; g2 < 8; ++g2) {
                if (g2 < 7) SEQ_LDK(kf[(g2 + 1) & 1], dd[(g2 + 1) & 1], g2 + 1);
                __builtin_amdgcn_sched_barrier(0);
#pragma unroll
                for (int e = 0; e < 2; ++e) { f32x4 a = S[2 * g2 + e] * dd[g2 & 1][e]; a = MFMA16(kf[g2 & 1][e][0], vf[0], a); a = MFMA16(kf[g2 & 1][e][1], vf[1], a); S[2 * g2 + e] = a; }
                __builtin_amdgcn_sched_barrier(0);
            }
#undef SEQ_LDQ
#undef SEQ_LDK
#pragma unroll
            for (int mt = 0; mt < 4; ++mt)
#pragma unroll
                for (int r = 0; r < 4; ++r) OB[((size_t)n * SEQ + ch * 64 + 16 * mt + 4 * gg + r) * 2048 + h * 512 + dv0 + c] = o[mt][r];
            vf[0] = vn[0]; vf[1] = vn[1];
            SEQ_BARRIER();
        }
        float* gsp = F.out + OUT_GSP + (size_t)nh * 256 * 512;
#pragma unroll
        for (int i = 0; i < 16; ++i)
#pragma unroll
            for (int r = 0; r < 4; ++r) gsp[(size_t)(16 * i + 4 * gg + r) * 512 + dv0 + c] = S[i][r];
    }
}

__device__ __forceinline__ void gla_sample_unit(Frame& F, const Args& A, int unit) {
    const int n = unit >> 2, h = unit & 3;
    const size_t row0 = (size_t)NPR + n * 8;
    const bf16* QB = (const bf16*)(F.ws + WS_QB); const bf16* KB = (const bf16*)(F.ws + WS_KB); const bf16* VB = (const bf16*)(F.ws + WS_VB); const bf16* ZB = (const bf16*)(F.ws + WS_ZB);
    const float* R = (const float*)(F.ws + WS_R); const float* w2 = FIN(12); const float* ba = FIN(13); const float* gg_ = FIN(14);
    bf16* AB = (bf16*)(F.ws + WS_AB);
    LAS float* QTs = (LAS float*)F.lds;
    LAS float* KDs = (LAS float*)(F.lds + 8192);
    LAS float* KTs = (LAS float*)(F.lds + 16384);
    LAS float* DCs = (LAS float*)(F.lds + 24576);
    LAS float* ATs = (LAS float*)(F.lds + 25600);
    LAS float* Rs  = (LAS float*)(F.lds + 25856);
    LAS float* RED = (LAS float*)(F.lds + 26624);
    int tz = F.tid; asm volatile("" : "+v"(tz));
    const int dv4 = (tz & 127) * 4, dkq = tz >> 7;
    const float* s0p = FIN(4) + (size_t)unit * 256 * 512 + (size_t)dkq * 512 + dv4;
    float* s1p = F.out + OUT_GSS + (size_t)unit * 256 * 512 + (size_t)dkq * 512 + dv4;
    const int dkp = tz & 255;
    const f32x4 rreg = *(const GAS f32x4*)((const GAS float*)R + row0 * 16 + (tz & 31) * 4);
    float wv[16];
#pragma unroll
    for (int j = 0; j < 16; ++j) wv[j] = ((const GAS float*)w2)[j * 1024 + h * 256 + dkp];
    const float bias = ((const GAS float*)ba)[h * 256 + dkp];
    bf16 qh[8], kh[8];
#pragma unroll
    for (int t = 0; t < 8; ++t) { qh[t] = ((const GAS bf16*)QB)[(row0 + t) * 1024 + h * 256 + dkp]; kh[t] = ((const GAS bf16*)KB)[(row0 + t) * 1024 + h * 256 + dkp]; }
    f32x4 sb[8];
    const GAS float* lp = (const GAS float*)s0p;
#pragma unroll
    for (int k = 0; k < 8; ++k) { sb[k] = __builtin_nontemporal_load((const GAS f32x4*)lp); lp += 2048; asm volatile("" : "+v"(lp)); }
    v2u vw[8];
    { const GAS bf16* vp = (const GAS bf16*)VB + row0 * 2048 + h * 512 + dv4;
#pragma unroll
      for (int s = 0; s < 8; ++s) vw[s] = *(const GAS v2u*)(vp + s * 2048); }
    SEQ_BARRIER();
    if (F.tid < 32) *(LAS f32x4*)(Rs + F.tid * 4) = rreg;
    SEQ_BARRIER();
    if (F.tid < 256) { const int dk = F.tid;
        float b[8]; float run = 0.f;
#pragma unroll
        for (int t = 0; t < 8; ++t) { const LAS float* rr = Rs + t * 16; float x = bias;
#pragma unroll
            for (int j4 = 0; j4 < 4; ++j4) { const f32x4 rv = *(const LAS f32x4*)(rr + 4 * j4); x += rv[0] * wv[4 * j4] + rv[1] * wv[4 * j4 + 1] + rv[2] * wv[4 * j4 + 2] + rv[3] * wv[4 * j4 + 3]; }
            run += log_sigmoid_(x) * 0.0625f; b[t] = run; asm volatile("" ::: "memory"); }
        const float blast = run;
#pragma unroll
        for (int t = 0; t < 8; ++t) { const float q = bf2f(qh[t]), k = bf2f(kh[t]);
            QTs[dk * 8 + t] = q * __expf(b[t]) * 0.0625f; KTs[dk * 8 + t] = k * __expf(-b[t]); KDs[dk * 8 + t] = k * __expf(blast - b[t]); }
        DCs[dk] = __expf(blast);
    }
    SEQ_BARRIER();
    { const int t = F.wave; float a[8];
#pragma unroll
      for (int s = 0; s < 8; ++s) a[s] = 0.f;
#pragma unroll
      for (int q = 0; q < 4; ++q) { const int dk = F.lane + 64 * q; const float qv = QTs[dk * 8 + t];
#pragma unroll
          for (int s = 0; s < 8; ++s) a[s] += qv * KTs[dk * 8 + s]; }
#pragma unroll
      for (int s = 0; s < 8; ++s) { const float v = wave_sum(a[s]); if (F.lane == 0) ATs[t * 8 + s] = (s <= t) ? v : 0.f; } }
    f32x4 vv[8];
#pragma unroll
    for (int s = 0; s < 8; ++s) { const v2u w = vw[s]; vv[s] = (f32x4){bflo(w.x), bfhi(w.x), bflo(w.y), bfhi(w.y)}; }
    f32x4 oa[8];
#pragma unroll
    for (int t = 0; t < 8; ++t) oa[t] = (f32x4){0.f, 0.f, 0.f, 0.f};
    GAS float* sp = (GAS float*)s1p;
#define SMP_BATCH(PF) do { _Pragma("unroll") for (int k = 0; k < 8; ++k) { const int dk = (bt * 8 + k) * 4 + dkq; \
            const f32x4 s0 = sb[k]; \
            const f32x4 q0 = *(const LAS f32x4*)(QTs + dk * 8), q1 = *(const LAS f32x4*)(QTs + dk * 8 + 4); \
            const f32x4 k0 = *(const LAS f32x4*)(KDs + dk * 8), k1 = *(const LAS f32x4*)(KDs + dk * 8 + 4); \
            const float d = DCs[dk]; \
            oa[0] += s0 * q0[0]; oa[1] += s0 * q0[1]; oa[2] += s0 * q0[2]; oa[3] += s0 * q0[3]; \
            oa[4] += s0 * q1[0]; oa[5] += s0 * q1[1]; oa[6] += s0 * q1[2]; oa[7] += s0 * q1[3]; \
            f32x4 sn = s0 * d; \
            sn += vv[0] * k0[0]; sn += vv[1] * k0[1]; sn += vv[2] * k0[2]; sn += vv[3] * k0[3]; \
            sn += vv[4] * k1[0]; sn += vv[5] * k1[1]; sn += vv[6] * k1[2]; sn += vv[7] * k1[3]; \
            __builtin_nontemporal_store(sn, (GAS f32x4*)sp); sp += 2048; asm volatile("" : "+v"(sp)); \
            if (PF) { sb[k] = __builtin_nontemporal_load((const GAS f32x4*)lp); lp += 2048; asm volatile("" : "+v"(lp)); }     \
            if (k & 1) asm volatile("" ::: "memory"); } } while (0)
    { int bt = 0;
#pragma unroll 1
      for (; bt < 7; ++bt) SMP_BATCH(true);
      SMP_BATCH(false); }
#undef SMP_BATCH
#pragma unroll
    for (int t = 0; t < 8; ++t) *(LAS f32x4*)(RED + ((dkq * 8 + t) * 512 + dv4)) = oa[t];
    SEQ_BARRIER();
    { const int t = F.tid >> 6, d8 = (F.tid & 63) * 8;
      float o[8];
#pragma unroll
      for (int e = 0; e < 8; ++e) o[e] = 0.f;
#pragma unroll
      for (int q = 0; q < 4; ++q) { const f32x4 a = *(const LAS f32x4*)(RED + (q * 8 + t) * 512 + d8), b = *(const LAS f32x4*)(RED + (q * 8 + t) * 512 + d8 + 4);
          o[0] += a[0]; o[1] += a[1]; o[2] += a[2]; o[3] += a[3]; o[4] += b[0]; o[5] += b[1]; o[6] += b[2]; o[7] += b[3]; }
#pragma unroll
      for (int s = 0; s < 8; ++s) { const float at = ATs[t * 8 + s]; const v4u w = *(const v4u*)(VB + (row0 + s) * 2048 + h * 512 + d8);
          o[0] += at * bflo(w.x); o[1] += at * bfhi(w.x); o[2] += at * bflo(w.y); o[3] += at * bfhi(w.y); o[4] += at * bflo(w.z); o[5] += at * bfhi(w.z); o[6] += at * bflo(w.w); o[7] += at * bfhi(w.w); }
      float ss = 0.f;
#pragma unroll
      for (int e = 0; e < 8; ++e) ss += o[e] * o[e];
      ss = wave_sum(ss);
      const float rstd = rsqrtf(ss * (1.0f / 512.0f) + EPS);
      const v4u zw = *(const v4u*)(ZB + (row0 + t) * 2048 + h * 512 + d8);
      const f32x4 g0 = *(const f32x4*)(gg_ + h * 512 + d8), g1 = *(const f32x4*)(gg_ + h * 512 + d8 + 4);
      v4u w; w.x = pk2(o[0] * rstd * g0[0] * bflo(zw.x), o[1] * rstd * g0[1] * bfhi(zw.x)); w.y = pk2(o[2] * rstd * g0[2] * bflo(zw.y), o[3] * rstd * g0[3] * bfhi(zw.y));
      w.z = pk2(o[4] * rstd * g1[0] * bflo(zw.z), o[5] * rstd * g1[1] * bfhi(zw.z)); w.w = pk2(o[6] * rstd * g1[2] * bflo(zw.w), o[7] * rstd * g1[3] * bfhi(zw.w));
      *(v4u*)(AB + (row0 + t) * DM + 2048 + h * 512 + d8) = w; }
}
__device__ __forceinline__ void gla_sample_loop(Frame& F, const Args& A, unsigned* ctr) {
    volatile LAS unsigned* MISC = (volatile LAS unsigned*)(F.lds + MISC_OFF);
    for (;;) {
        __syncthreads();
        if (F.tid == 0) MISC[16] = __hip_atomic_fetch_add(ctr, 1u, __ATOMIC_RELAXED, __HIP_MEMORY_SCOPE_AGENT);
        __syncthreads();
        const int u = __builtin_amdgcn_readfirstlane((int)MISC[16]);
        if (u >= 512) break;
        gla_sample_unit(F, A, u);
    }
}

__device__ __forceinline__ void phase6(Frame& F, const Args& A) {
    const float* OB = (const float*)(F.ws + WS_OB); const bf16* ZB = (const bf16*)(F.ws + WS_ZB); const float* gn = FIN(14); bf16* AB = (bf16*)(F.ws + WS_AB);
    const int gw = F.blk * NWAVES + F.wave, NGW = F.G * NWAVES, lane = F.lane;
    if (gw >= NPR) return;
    const int nr = (NPR - gw + NGW - 1) / NGW;
    f32x4 gr[4][2];
#pragma unroll
    for (int hh = 0; hh < 4; ++hh) { gr[hh][0] = *(const f32x4*)(gn + hh * 512 + lane * 8); gr[hh][1] = *(const f32x4*)(gn + hh * 512 + lane * 8 + 4); }
    auto rowof = [&](int i) { const int ic = (i < nr) ? i : nr - 1; return gw + ic * NGW; };
    auto process = [&](const f32x4 (&a)[4][2], const v4u (&z)[4], int row) {
#pragma unroll
        for (int hh = 0; hh < 4; ++hh) { const int col = hh * 512 + lane * 8;
            const f32x4 x0 = a[hh][0], x1 = a[hh][1];
            float ss = (x0[0] * x0[0] + x0[1] * x0[1]) + (x0[2] * x0[2] + x0[3] * x0[3]) + (x1[0] * x1[0] + x1[1] * x1[1]) + (x1[2] * x1[2] + x1[3] * x1[3]);
            ss = wave_sum(ss);
            const float rstd = rsqrtf(ss * (1.0f / 512.0f) + EPS);
            const v4u zw = z[hh];
            const f32x4 g0 = gr[hh][0], g1 = gr[hh][1];
            v4u w; w.x = pk2(x0[0] * rstd * g0[0] * bflo(zw.x), x0[1] * rstd * g0[1] * bfhi(zw.x)); w.y = pk2(x0[2] * rstd * g0[2] * bflo(zw.y), x0[3] * rstd * g0[3] * bfhi(zw.y));
            w.z = pk2(x1[0] * rstd * g1[0] * bflo(zw.z), x1[1] * rstd * g1[1] * bfhi(zw.z)); w.w = pk2(x1[2] * rstd * g1[2] * bflo(zw.w), x1[3] * rstd * g1[3] * bfhi(zw.w));
            *(v4u*)(AB + (size_t)row * DM + 2048 + col) = w; }
    };
#define P6_LOAD(a_, z_, r) do { _Pragma("unroll") for (int hh = 0; hh < 4; ++hh) { const size_t o_ = (size_t)(r) * 2048 + hh * 512 + lane * 8; \
        a_[hh][0] = *(const f32x4*)(OB + o_); a_[hh][1] = *(const f32x4*)(OB + o_ + 4); z_[hh] = *(const v4u*)(ZB + o_); } } while (0)
    f32x4 aa[4][2], ab[4][2]; v4u za[4], zb[4];
    P6_LOAD(aa, za, rowof(0));
    int i = 0;
#pragma unroll 1
    for (; i + 1 < nr; i += 2) {
        P6_LOAD(ab, zb, rowof(i + 1));
        process(aa, za, rowof(i));
        P6_LOAD(aa, za, rowof(i + 2));
        process(ab, zb, rowof(i + 1));
    }
    if (i < nr) process(aa, za, rowof(i));
#undef P6_LOAD
}

__device__ __forceinline__ void phase9(Frame& F, const Args& A) {
    const float* SSQ = (const float*)(F.ws + WS_SSQ); const float* fg = FIN(18); float* Y = F.out + OUT_Y; const bf16* XN = (const bf16*)(F.ws + WS_XN);
    const int gw = F.blk * NWAVES + F.wave, NGW = F.G * NWAVES, lane = F.lane;
    int extra; const int nr = wave_rows(NROW, gw, NGW, extra);
    if (nr == 0) return;
    const int nfull = NROW / NGW;
    f32x4 gr[8][2];
#pragma unroll
    for (int q = 0; q < 8; ++q) { const int c = 8 * (lane + 64 * q); gr[q][0] = *(const f32x4*)(fg + c); gr[q][1] = *(const f32x4*)(fg + c + 4); }
    auto rowof = [&](int i) { const int ic = (i < nr) ? i : nr - 1; return (ic < nfull) ? gw + ic * NGW : extra; };
    auto process = [&](const v4u (&v)[8], float sq, int row) {
        const float rstd = rsqrtf(wave_sum(sq) * (1.0f / DM) + EPS);
        float* yw = Y + (size_t)row * DM;
#pragma unroll
        for (int q = 0; q < 8; ++q) { const int c = 8 * (lane + 64 * q);
            const f32x4 a = {bflo(v[q].x), bfhi(v[q].x), bflo(v[q].y), bfhi(v[q].y)}, b = {bflo(v[q].z), bfhi(v[q].z), bflo(v[q].w), bfhi(v[q].w)};
            __builtin_nontemporal_store(a * rstd * gr[q][0], (f32x4*)(yw + c)); __builtin_nontemporal_store(b * rstd * gr[q][1], (f32x4*)(yw + c + 4)); }
    };
#define P9_LOAD(v_, sq_, r) do { const bf16* xr_ = XN + (size_t)(r) * DM + 8 * lane; _Pragma("unroll") for (int q = 0; q < 8; ++q) v_[q] = *(const v4u*)(xr_ + 512 * q); \
        sq_ = SSQ[(size_t)(r) * 64 + lane]; } while (0)
    v4u va[8], vb[8]; float sa, sb_;
    P9_LOAD(va, sa, rowof(0));
    int i = 0;
#pragma unroll 1
    for (; i + 1 < nr; i += 2) {
        P9_LOAD(vb, sb_, rowof(i + 1));
        process(va, sa, rowof(i));
        P9_LOAD(va, sa, rowof(i + 2));
        process(vb, sb_, rowof(i + 1));
    }
    if (i < nr) process(va, sa, rowof(i));
#undef P9_LOAD
}

constexpr int N_PHASES = 10;
constexpr int P3_NCG = 3;

__global__ void __launch_bounds__(NWAVES * 64, 2) mk_fwd(Args args) {
    extern __shared__ __attribute__((aligned(16))) unsigned char lds[];
    Frame F;
    F.lds = (LAS unsigned char*)lds;
    F.tid = threadIdx.x; F.lane = F.tid & 63; F.wave = __builtin_amdgcn_readfirstlane(F.tid >> 6);
    F.G = gridDim.x; F.blk = blockIdx.x;
    const Args& A = args;
    F.out = args.out; F.ws = args.ws;
    volatile LAS unsigned* MISC = (volatile LAS unsigned*)(F.lds + MISC_OFF);
    if (F.tid < 32) MISC[F.tid] = 0u;
    __syncthreads();
    unsigned* ctl = (unsigned*)(F.ws + WS_CTL);
    XcdBarrier bar; bar.bar = ctl + CW_BAR; bar.x = 0; bar.st = nullptr;
    if (MK_N_LAUNCHES == 1) bar = xcd_barrier_post(ctl + CW_BAR, MISC + 8);
    const int lo = args.ph_lo, hi = args.ph_hi;
#ifdef ONLY
#define IN(k) ((k) == ONLY)
#else
#define IN(k) (lo <= (k) && (k) < hi)
#endif
#define SEAM(k) do { if (IN(k) && IN((k) + 1)) xcd_barrier(bar); } while (0)
#ifndef PROBE_REPEAT
#define PROBE_REPEAT -1
#endif
#define PH(k, ...) do { if (IN(k)) { const int reps_ = (PROBE_REPEAT == (k)) ? args.ph_rep : 1; _Pragma("nounroll") for (int r_ = 0; r_ < reps_; ++r_) { { __VA_ARGS__ } if (r_ + 1 < reps_) xcd_barrier(bar); } } SEAM(k); } while (0)

    PH(0, phase0(F, A););
    PH(1, phase1(F, A, ctl););
    PH(2, phase2(F, A););
    PH(3,
        pg8::Gemm g{(const bf16*)(F.ws + WS_H), (const bf16*)(F.ws + WS_WB1), NROW, N1, DM}; pg8::GroupedOrder S; S.init(NROW, N1, F.G, F.blk, P3_NCG);
        EpiProj E{F.ws};
        pg8::gemm_phase<EpiProj, pg8::GroupedOrder>(F.lds, g, S, E);
        transpose_queue<1>(F, A, ctl + CW_TRN2);
    );
    int p5_pass = 0;
    PH(4,
        for (int u = F.blk; u < 256; u += F.G) swa_prompt_unit(F, A, u);
        for (int u = F.blk; u < 512; u += F.G) gla_prep_unit(F, A, u);
        for (int u = F.blk; u < 512; u += F.G) swa_sample_unit(F, A, u);
        win_prompt(F, A);
    );
    PH(5,
        for (int u = F.blk; u < 8 * SEQ_DVG; u += F.G) gla_seq_unit(F, A, u);
        gla_sample_loop(F, A, ctl + CW_SMP + 64 * p5_pass); ++p5_pass;
    );
    if (PROBE_REPEAT == 40) { for (int u = F.blk; u < 256; u += F.G) swa_prompt_unit(F, A, u); xcd_barrier(bar); }
    if (PROBE_REPEAT == 41) { for (int u = F.blk; u < 512; u += F.G) gla_prep_unit(F, A, u); xcd_barrier(bar); }
    if (PROBE_REPEAT == 42) { for (int u = F.blk; u < 512; u += F.G) swa_sample_unit(F, A, u); xcd_barrier(bar); }
    if (PROBE_REPEAT == 50) { for (int u = F.blk; u < 8 * SEQ_DVG; u += F.G) gla_seq_unit(F, A, u); xcd_barrier(bar); }
    if (PROBE_REPEAT == 51) { gla_sample_loop(F, A, ctl + CW_SMP + 64 * p5_pass); xcd_barrier(bar); }
    PH(6, phase6(F, A););
    PH(7,
        pg8::Gemm g{(const bf16*)(F.ws + WS_AB), (const bf16*)(F.ws + WS_WB2), NROW, DM, DM}; pg8::StaticOrder S; S.init(NROW, DM, F.G, F.blk, 192);
        EpiMerge E{(const bf16*)(F.ws + WS_SGA), (const bf16*)(F.ws + WS_SGB), (bf16*)(F.ws + WS_MERGED)};
        pg8::gemm_phase<EpiMerge>(F.lds, g, S, E);
    );
    PH(8,
        pg8::Gemm g{(const bf16*)(F.ws + WS_MERGED), (const bf16*)(F.ws + WS_WB3), NROW, DM, DM}; pg8::StaticOrder S; S.init(NROW, DM, F.G, F.blk, 192);
        EpiOut E{A.in[0], A.in[1], (const float*)(F.ws + WS_MOD), (bf16*)(F.ws + WS_XN), (float*)(F.ws + WS_SSQ)};
        pg8::gemm_phase<EpiOut>(F.lds, g, S, E);
    );
    if (IN(9)) { phase9(F, A); }
    if (PROBE_REPEAT == 900) { for (int i = 0; i < 8; ++i) xcd_barrier(bar); }
#undef IN
#undef SEAM
#undef PH
}

extern "C" void kernel_launch(void* const* d_in, const int* in_sizes, int n_in, void* d_out, int out_size, void* d_ws, size_t ws_size, hipStream_t stream) {
    static int grid = 0;
    if (grid == 0) {
        if (n_in != 19 || (size_t)out_size != OUT_TOTAL || ws_size < WS_END) { fprintf(stderr, "kernel_launch: unexpected sizes n_in %d out %d ws %zu (need %zu)\n", n_in, out_size, ws_size, (size_t)WS_END); grid = -1; return; }
        int dev = 0, cus = 0, per_cu = 0;
        if (hipGetDevice(&dev) != hipSuccess || hipDeviceGetAttribute(&cus, hipDeviceAttributeMultiprocessorCount, dev) != hipSuccess) { grid = -1; return; }
        if (hipFuncSetAttribute((const void*)mk_fwd, hipFuncAttributeMaxDynamicSharedMemorySize, LDS_BYTES) != hipSuccess) { fprintf(stderr, "kernel_launch: hipFuncSetAttribute failed\n"); grid = -1; return; }
        if (hipOccupancyMaxActiveBlocksPerMultiprocessor(&per_cu, (const void*)mk_fwd, NWAVES * 64, LDS_BYTES) != hipSuccess || per_cu < 1) fprintf(stderr, "kernel_launch: occupancy query reports %d\n", per_cu);
        (void)hipGetLastError();
        grid = cus;
    }
    if (grid < 0) return;
    (void)hipMemsetAsync((char*)d_ws + WS_CTL, 0, CTL_ZERO_BYTES, stream);
    Args a{};
    for (int i = 0; i < 19; ++i) a.in[i] = (const float*)d_in[i];
    a.out = (float*)d_out; a.ws = (unsigned char*)d_ws;
    a.ph_rep = 2; a.pad_ = 0;
    if (MK_N_LAUNCHES == 1) { a.ph_lo = 0; a.ph_hi = N_PHASES; hipLaunchKernelGGL(mk_fwd, dim3(grid), dim3(NWAVES * 64), LDS_BYTES, stream, a); }
    else for (int li = 0; li < N_PHASES; ++li) { a.ph_lo = li; a.ph_hi = li + 1; hipLaunchKernelGGL(mk_fwd, dim3(grid), dim3(NWAVES * 64), LDS_BYTES, stream, a); }
}
```
